# Optimizing an MI355X kernel written in HIP

```python
import jax
import jax.numpy as jnp
from jax import lax


D_MODEL = 1024
BATCH = 32
SEQ = 2048
DEPTH = 4

CHUNK = 64
HEAD_DIM = 64
HEADS_PER_GROUP = 4
GROUP_WIDTH = HEADS_PER_GROUP * HEAD_DIM
N_GROUPS = 4
D_MIX = N_GROUPS * GROUP_WIDTH
Q_BLOCK = 128
ROPE_THETA = 10000.0
NORM_EPS = 1e-6
NEG_INF = -1e30
KV_RANK = 128
IDX_HEADS = 4
IDX_DIM = 32
TOPK_MAX = 256
LEFT_CHUNKS = 8
MAX_REL = 128
N_EXPERTS = 32
TOP_K = 4
D_FF = D_MODEL
SWIGLU_ALPHA = 1.702
SWIGLU_LIMIT = 7.0
MOE_BLOCK = 512

A_COLS = 3 * GROUP_WIDTH + HEADS_PER_GROUP
B_COLS = GROUP_WIDTH + KV_RANK + IDX_HEADS * IDX_DIM + IDX_DIM + IDX_HEADS
C_COLS = 3 * GROUP_WIDTH
D_COLS = 3 * GROUP_WIDTH
IN_COLS = A_COLS + B_COLS + C_COLS + D_COLS

kernel_name = 'hybrid_chunk_causal_moe_trunk'


def rmsnorm(x, g):
    xf = x.astype(jnp.float32)
    y = xf * lax.rsqrt(jnp.mean(xf * xf, axis=-1, keepdims=True) + NORM_EPS)
    return (y * g.astype(jnp.float32)).astype(x.dtype)


def rope(x, pos):
    half = x.shape[-1] // 2
    inv = ROPE_THETA ** (-jnp.arange(half, dtype=jnp.float32) / half)
    ang = pos.astype(jnp.float32)[:, None] * inv[None, :]
    cos = jnp.cos(ang)[None, :, None, :]
    sin = jnp.sin(ang)[None, :, None, :]
    xf = x.astype(jnp.float32)
    x1, x2 = xf[..., :half], xf[..., half:]
    return jnp.concatenate([x1 * cos - x2 * sin, x1 * sin + x2 * cos], axis=-1).astype(x.dtype)


def merge_blocks(out):
    nb, b, blk, h, d = out.shape
    return out.transpose(1, 0, 2, 3, 4).reshape(b, nb * blk, h, d)


def forgetting_attention(q, k, v, log_f):
    S, Dh = q.shape[1], q.shape[-1]
    F = jnp.cumsum(log_f.astype(jnp.float32), axis=1).transpose(0, 2, 1)
    pos = jnp.arange(S)

    def block(i):
        q0 = i * Q_BLOCK
        qb = lax.dynamic_slice_in_dim(q, q0, Q_BLOCK, axis=1)
        Fq = lax.dynamic_slice_in_dim(F, q0, Q_BLOCK, axis=2)
        s = jnp.einsum('bqhd,bkhd->bhqk', qb, k).astype(jnp.float32) * (Dh ** -0.5)
        s = s + Fq[..., :, None] - F[..., None, :]
        qpos = q0 + jnp.arange(Q_BLOCK)
        s = jnp.where((pos[None, :] <= qpos[:, None])[None, None], s, NEG_INF)
        p = jax.nn.softmax(s, axis=-1)
        return jnp.einsum('bhqk,bkhd->bqhd', p.astype(v.dtype), v)

    return merge_blocks(lax.map(block, jnp.arange(S // Q_BLOCK)))


def dsa_attention(q, k, v, q_idx, k_idx, w_idx):
    S, Dh = q.shape[1], q.shape[-1]
    n_sel = min(TOPK_MAX, S // 4)
    pos = jnp.arange(S)
    limit = (pos // CHUNK + 1) * CHUNK

    def block(i):
        q0 = i * Q_BLOCK
        qib = lax.dynamic_slice_in_dim(q_idx, q0, Q_BLOCK, axis=1)
        wib = lax.dynamic_slice_in_dim(w_idx, q0, Q_BLOCK, axis=1).astype(jnp.float32)
        lim = lax.dynamic_slice_in_dim(limit, q0, Q_BLOCK)
        rel = jax.nn.relu(jnp.einsum('bqhd,bkd->bqhk', qib, k_idx).astype(jnp.float32) * (IDX_DIM ** -0.5))
        score = jnp.einsum('bqh,bqhk->bqk', wib, rel)
        score = jnp.where((pos[None, :] < lim[:, None])[None], score, NEG_INF)
        _, idx = lax.top_k(score, n_sel)
        valid = idx < lim[None, :, None]
        k_sel = jax.vmap(lambda kb, ib: kb[ib])(k, idx)
        v_sel = jax.vmap(lambda vb, ib: vb[ib])(v, idx)
        qb = lax.dynamic_slice_in_dim(q, q0, Q_BLOCK, axis=1)
        s = jnp.einsum('bqhd,bqnd->bhqn', qb, k_sel).astype(jnp.float32) * (Dh ** -0.5)
        s = jnp.where(valid[:, None], s, NEG_INF)
        p = jax.nn.softmax(s, axis=-1)
        return jnp.einsum('bhqn,bqnd->bqhd', p.astype(v.dtype), v_sel)

    return merge_blocks(lax.map(block, jnp.arange(S // Q_BLOCK)))


def stick_breaking_attention(q, k, v):
    S, Dh = q.shape[1], q.shape[-1]
    pos = jnp.arange(S)

    def block(i):
        q0 = i * Q_BLOCK
        qb = lax.dynamic_slice_in_dim(q, q0, Q_BLOCK, axis=1)
        z = jnp.einsum('bqhd,bkhd->bhqk', qb, k).astype(jnp.float32) * (Dh ** -0.5)
        qpos = q0 + jnp.arange(Q_BLOCK)
        mask = (pos[None, :] < qpos[:, None])[None, None]
        log_1m = jnp.where(mask, jax.nn.log_sigmoid(-z), 0.0)
        after = lax.cumsum(log_1m, axis=3, reverse=True) - log_1m
        w = jnp.where(mask, jnp.exp(jax.nn.log_sigmoid(z) + after), 0.0)
        return jnp.einsum('bhqk,bkhd->bqhd', w.astype(v.dtype), v)

    return merge_blocks(lax.map(block, jnp.arange(S // Q_BLOCK)))


def chunked_relbias_attention(q, k, v, rel_table):
    S, Dh = q.shape[1], q.shape[-1]
    pad = LEFT_CHUNKS * CHUNK
    band = pad + CHUNK
    kp = jnp.pad(k, ((0, 0), (pad, 0), (0, 0), (0, 0)))
    vp = jnp.pad(v, ((0, 0), (pad, 0), (0, 0), (0, 0)))
    j = jnp.arange(band)
    rel = j[None, :] - pad - jnp.arange(CHUNK)[:, None]
    bias = rel_table[:, jnp.clip(rel, -MAX_REL, MAX_REL) + MAX_REL].astype(jnp.float32)

    def chunk(ci):
        c0 = ci * CHUNK
        qb = lax.dynamic_slice_in_dim(q, c0, CHUNK, axis=1)
        kb = lax.dynamic_slice_in_dim(kp, c0, band, axis=1)
        vb = lax.dynamic_slice_in_dim(vp, c0, band, axis=1)
        s = jnp.einsum('bqhd,bkhd->bhqk', qb, kb).astype(jnp.float32) * (Dh ** -0.5) + bias[None]
        valid = (c0 - pad + j) >= 0
        s = jnp.where(valid[None, None, None, :], s, NEG_INF)
        p = jax.nn.softmax(s, axis=-1)
        return jnp.einsum('bhqk,bkhd->bqhd', p.astype(vb.dtype), vb)

    return merge_blocks(lax.map(chunk, jnp.arange(S // CHUNK)))


def hybrid_mixer(h, w_in, b_forget, kv_norm_g, w_uk, w_uv, rel_table, w_o):
    B, S, _ = h.shape
    heads = lambda t: t.reshape(B, S, HEADS_PER_GROUP, HEAD_DIM)
    pos = jnp.arange(S)
    proj = h @ w_in
    pa, pb, pc, pd = jnp.split(proj, [A_COLS, A_COLS + B_COLS, A_COLS + B_COLS + C_COLS], axis=-1)
    GW = GROUP_WIDTH
    qa, ka, va, fa = jnp.split(pa, [GW, 2 * GW, 3 * GW], axis=-1)
    log_f = jax.nn.log_sigmoid(fa.astype(jnp.float32) + b_forget.astype(jnp.float32))
    ya = forgetting_attention(heads(qa), heads(ka), heads(va), log_f)
    ob = [GW, GW + KV_RANK, GW + KV_RANK + IDX_HEADS * IDX_DIM, GW + KV_RANK + IDX_HEADS * IDX_DIM + IDX_DIM]
    qb, lat, qi, ki, wi = jnp.split(pb, ob, axis=-1)
    lat = rmsnorm(lat, kv_norm_g)
    kb = rope((lat @ w_uk)[:, :, None, :], pos)[:, :, 0, :]
    vb = lat @ w_uv
    qb = rope(heads(qb), pos)
    qi = rope(qi.reshape(B, S, IDX_HEADS, IDX_DIM), pos)
    ki = rope(ki[:, :, None, :], pos)[:, :, 0, :]
    wi = wi * (IDX_HEADS ** -0.5)
    yb = dsa_attention(qb, kb, vb, qi, ki, wi)
    qc, kc, vc = jnp.split(pc, [GW, 2 * GW], axis=-1)
    yc = stick_breaking_attention(heads(qc), heads(kc), heads(vc))
    qd, kd, vd = jnp.split(pd, [GW, 2 * GW], axis=-1)
    yd = chunked_relbias_attention(heads(qd), heads(kd), heads(vd), rel_table)
    y = jnp.concatenate([ya.reshape(B, S, GW), yb.reshape(B, S, GW), yc.reshape(B, S, GW), yd.reshape(B, S, GW)], axis=-1)
    return y @ w_o


def clamped_swiglu(gu):
    glu, lin = jnp.split(gu, 2, axis=-1)
    glu = jnp.minimum(glu, SWIGLU_LIMIT)
    lin = jnp.clip(lin, -SWIGLU_LIMIT, SWIGLU_LIMIT)
    return glu * jax.nn.sigmoid(SWIGLU_ALPHA * glu) * (lin + 1.0)


def moe_ffn(h, w_router, b_router, w_gu, b_gu, w_dn, b_dn):
    B, S, D = h.shape
    T = B * S
    A = T * TOP_K
    hf = h.reshape(T, D)
    logits = (hf @ w_router).astype(jnp.float32) + b_router.astype(jnp.float32)
    top_vals, top_idx = lax.top_k(logits, TOP_K)
    gates = jax.nn.softmax(top_vals, axis=-1)
    flat_e = top_idx.reshape(A)
    flat_tok = jnp.arange(A, dtype=jnp.int32) // TOP_K
    flat_g = gates.reshape(A)
    order = jnp.argsort(flat_e, stable=True)
    se = flat_e[order]
    counts = jnp.bincount(flat_e, length=N_EXPERTS)
    start = jnp.cumsum(counts) - counts
    pcounts = (counts + MOE_BLOCK - 1) // MOE_BLOCK * MOE_BLOCK
    pend = jnp.cumsum(pcounts)
    pstart = pend - pcounts
    dest = pstart[se] + jnp.arange(A) - start[se]
    n_blocks = -(-A // MOE_BLOCK) + N_EXPERTS
    P = n_blocks * MOE_BLOCK
    row_tok = jnp.full((P,), T, jnp.int32).at[dest].set(flat_tok[order])
    row_g = jnp.zeros((P,), jnp.float32).at[dest].set(flat_g[order])
    blk_e = jnp.minimum(jnp.searchsorted(pend, jnp.arange(n_blocks) * MOE_BLOCK, side='right'), N_EXPERTS - 1)
    h_pad = jnp.concatenate([hf, jnp.zeros((1, D), hf.dtype)], axis=0)

    def step(acc, inp):
        rows, g, e = inp
        xb = h_pad[rows]
        y = clamped_swiglu(xb @ w_gu[e] + b_gu[e]) @ w_dn[e] + b_dn[e]
        return acc.at[rows].add((g[:, None] * y.astype(jnp.float32)).astype(acc.dtype)), None

    acc0 = jnp.zeros((T + 1, D), h.dtype)
    acc, _ = lax.scan(step, acc0, (row_tok.reshape(n_blocks, MOE_BLOCK), row_g.reshape(n_blocks, MOE_BLOCK), blk_e))
    return acc[:T].reshape(B, S, D)


def setup_inputs(seed: int = 0) -> dict:
    key = jax.random.key(seed)
    ks = jax.random.split(key, 20)
    nrm = lambda k, shape, s: jax.random.normal(k, shape, jnp.float32) * s
    return {
        'x': nrm(ks[0], (BATCH, SEQ, D_MODEL), 1.0),
        'c': nrm(ks[1], (BATCH, D_MODEL), 1.0),
        'w_ada': nrm(ks[2], (DEPTH, D_MODEL, 6 * D_MODEL), 0.5 * D_MODEL ** -0.5),
        'b_ada': nrm(ks[3], (DEPTH, 6 * D_MODEL), 0.02),
        'norm1_g': 1.0 + nrm(ks[4], (DEPTH, D_MODEL), 0.05),
        'norm2_g': 1.0 + nrm(ks[5], (DEPTH, D_MODEL), 0.05),
        'w_in': nrm(ks[6], (DEPTH, D_MODEL, IN_COLS), D_MODEL ** -0.5),
        'b_forget': 2.0 + nrm(ks[7], (DEPTH, HEADS_PER_GROUP), 0.5),
        'kv_norm_g': 1.0 + nrm(ks[8], (DEPTH, KV_RANK), 0.05),
        'w_uk': nrm(ks[9], (DEPTH, KV_RANK, HEAD_DIM), KV_RANK ** -0.5),
        'w_uv': nrm(ks[10], (DEPTH, KV_RANK, HEAD_DIM), KV_RANK ** -0.5),
        'rel_bias': nrm(ks[11], (DEPTH, HEADS_PER_GROUP, 2 * MAX_REL + 1), 0.5),
        'w_o': nrm(ks[12], (DEPTH, D_MIX, D_MODEL), D_MIX ** -0.5),
        'w_router': nrm(ks[13], (DEPTH, D_MODEL, N_EXPERTS), D_MODEL ** -0.5),
        'b_router': nrm(ks[14], (DEPTH, N_EXPERTS), 0.01),
        'w_gu': nrm(ks[15], (DEPTH, N_EXPERTS, D_MODEL, 2 * D_FF), D_MODEL ** -0.5),
        'b_gu': nrm(ks[16], (DEPTH, N_EXPERTS, 2 * D_FF), 0.01),
        'w_dn': nrm(ks[17], (DEPTH, N_EXPERTS, D_FF, D_MODEL), D_FF ** -0.5),
        'b_dn': nrm(ks[18], (DEPTH, N_EXPERTS, D_MODEL), 0.01),
        'final_g': 1.0 + nrm(ks[19], (D_MODEL,), 0.05),
    }


def reference(x, c, w_ada, b_ada, norm1_g, norm2_g, w_in, b_forget, kv_norm_g, w_uk, w_uv, rel_bias, w_o,
              w_router, b_router, w_gu, b_gu, w_dn, b_dn, final_g):
    c_act = jax.nn.silu(c)
    for l in range(DEPTH):
        mod = c_act @ w_ada[l] + b_ada[l]
        sh1, sc1, g1, sh2, sc2, g2 = [m[:, None, :] for m in jnp.split(mod, 6, axis=-1)]
        h = rmsnorm(x, norm1_g[l]) * (1.0 + sc1) + sh1
        x = x + g1 * hybrid_mixer(h, w_in[l], b_forget[l], kv_norm_g[l], w_uk[l], w_uv[l], rel_bias[l], w_o[l])
        h = rmsnorm(x, norm2_g[l]) * (1.0 + sc2) + sh2
        x = x + g2 * moe_ffn(h, w_router[l], b_router[l], w_gu[l], b_gu[l], w_dn[l], b_dn[l])
    return rmsnorm(x, final_g)
```

```cpp
#include <hip/hip_runtime.h>
#include <cstdio>
#include <cstdint>

#define GAS __attribute__((address_space(1)))
#define LAS __attribute__((address_space(3)))
typedef unsigned short bf16;
typedef unsigned u32x4 __attribute__((ext_vector_type(4)));
typedef unsigned u32x2 __attribute__((ext_vector_type(2)));
typedef float f32x4 __attribute__((ext_vector_type(4)));
typedef float f32x2 __attribute__((ext_vector_type(2)));
typedef short bf16x8 __attribute__((ext_vector_type(8)));
typedef __bf16 bf16x2_t __attribute__((ext_vector_type(2)));

constexpr int DM = 1024, NB = 32, SEQ = 2048, NL = 4, T = NB * SEQ;
constexpr int NP = 3072;
constexpr int C_QA = 0, C_KA = 256, C_VA = 512, C_QC = 768, C_KC = 1024, C_VC = 1280, C_QD = 1536, C_KD = 1792, C_VD = 2048,
              C_QB = 2304, C_LAT = 2560, C_QI = 2688, C_KI = 2816, C_WI = 2848, C_FA = 2852;
constexpr int IN_COLS = 2856;
constexpr int NE = 32, NPAIR = T * 4, PMAX = NPAIR + NE * 256, MAXRT = PMAX / 256;
constexpr int NTB = 512;
constexpr float LOG2E = 1.4426950408889634f;
constexpr float SC2 = 0.125f * LOG2E;
constexpr float RS32 = 0.17677669529663687f;

constexpr size_t MiB = 1u << 20;
constexpr size_t WS_CTL = 0, CTL_ZERO_BYTES = 1 * MiB;
constexpr size_t WS_MOD = 1 * MiB;
constexpr size_t WS_ROPE = 4 * MiB;
constexpr size_t WS_WRT = 5 * MiB;
constexpr size_t WS_TOKE = 6 * MiB, WS_TOKG = 7 * MiB, WS_COUNTS = 8 * MiB, WS_TILEE = 8 * MiB + 65536;
constexpr size_t WS_ROWDST = 9 * MiB, WS_ROWGATE = 11 * MiB, WS_THR = 13 * MiB, WS_LF = 14 * MiB;
constexpr size_t WS_KB = 16 * MiB, WS_VBT = 24 * MiB;
constexpr size_t WS_H8 = 3536 * MiB;
constexpr size_t WS_WIN = 32 * MiB, WS_WO = 56 * MiB, WS_WGU = 64 * MiB, WS_WDN = 576 * MiB;
constexpr size_t WS_X = 832 * MiB, WS_H = 1088 * MiB, WS_H2LO = 1216 * MiB, WS_PROJ = 1344 * MiB, WS_VT = 1728 * MiB, WS_Y = 1824 * MiB;
constexpr size_t WS_XS = 1952 * MiB, WS_ACT = 2480 * MiB, WS_SLOT = 3008 * MiB, WS_MASK = 3520 * MiB, WS_END = 3600 * MiB;
constexpr int CW_BAR = 4096;

constexpr int RING_BYTES = 131072;
constexpr int LDSCTL_OFF = RING_BYTES + 1024, MISC_OFF = LDSCTL_OFF + 320;
constexpr int LDS_BYTES = 147456, TE_LDS = 145408, GTAB_LDS = 135168;

struct Params {
    const float *x, *c, *w_ada, *b_ada, *norm1_g, *norm2_g, *w_in, *b_forget, *kv_norm_g, *w_uk, *w_uv, *rel_bias, *w_o,
                *w_router, *b_router, *w_gu, *b_gu, *w_dn, *b_dn, *final_g;
    float* out; unsigned char* ws;
};

typedef const Params __attribute__((address_space(4)))* KP;
__device__ __forceinline__ KP kp_fresh() { KP k = (KP)__builtin_amdgcn_kernarg_segment_ptr(); asm volatile("" : "+s"(k)); return k; }
__device__ __forceinline__ int opaque_tid(int wv) {
    int l; asm volatile("v_mbcnt_lo_u32_b32 %0, -1, 0\n\tv_mbcnt_hi_u32_b32 %0, -1, %0" : "=v"(l)); asm volatile("" : "+s"(wv)); return (wv << 6) | l; }
#define LDS_WAIT() asm volatile("s_waitcnt lgkmcnt(0)" ::: "memory")
#define VM_WAIT() asm volatile("s_waitcnt vmcnt(0)" ::: "memory")
__device__ __forceinline__ unsigned f2bf(float f) { unsigned u = __builtin_bit_cast(unsigned, f); return (u + 0x7fffu + ((u >> 16) & 1u)) >> 16; }
__device__ __forceinline__ float bf2f(unsigned b) { return __builtin_bit_cast(float, b << 16); }
__device__ __forceinline__ unsigned pk2(float lo, float hi) { f32x2 v = {lo, hi}; bf16x2_t b = __builtin_convertvector(v, bf16x2_t); return __builtin_bit_cast(unsigned, b); }
__device__ __forceinline__ float dpp_shr_f(float v, const int ctrl_is  ) {
    int r;
    if (ctrl_is == 1) r = __builtin_amdgcn_update_dpp(0, __builtin_bit_cast(int, v), 0x111, 0xf, 0xf, true);
    else if (ctrl_is == 2) r = __builtin_amdgcn_update_dpp(0, __builtin_bit_cast(int, v), 0x112, 0xf, 0xf, true);
    else if (ctrl_is == 4) r = __builtin_amdgcn_update_dpp(0, __builtin_bit_cast(int, v), 0x114, 0xf, 0xf, true);
    else r = __builtin_amdgcn_update_dpp(0, __builtin_bit_cast(int, v), 0x118, 0xf, 0xf, true);
    return __builtin_bit_cast(float, r);
}
__device__ __forceinline__ float rdl_f(float v, int l) { return __builtin_bit_cast(float, __builtin_amdgcn_readlane(__builtin_bit_cast(int, v), l)); }
__device__ __forceinline__ float row_scan(float v) { v += dpp_shr_f(v, 1); v += dpp_shr_f(v, 2); v += dpp_shr_f(v, 4); v += dpp_shr_f(v, 8); return v; }
__device__ __forceinline__ float wave_sum(float v) { v = row_scan(v); return (rdl_f(v, 15) + rdl_f(v, 31)) + (rdl_f(v, 47) + rdl_f(v, 63)); }
struct U2 { unsigned a, b; };
__device__ __forceinline__ U2 pl16(unsigned x) { U2 r; r.a = x; r.b = x; asm volatile("s_nop 1\n\tv_permlane16_swap_b32 %0, %1" : "+v"(r.a), "+v"(r.b)); return r; }
__device__ __forceinline__ U2 pl32(unsigned x) { U2 r; r.a = x; r.b = x; asm volatile("s_nop 1\n\tv_permlane32_swap_b32 %0, %1" : "+v"(r.a), "+v"(r.b)); return r; }
__device__ __forceinline__ float xor16_f(float v, int lane) { const U2 r = pl16(__builtin_bit_cast(unsigned, v)); return __builtin_bit_cast(float, (lane & 16) ? r.a : r.b); }
__device__ __forceinline__ float xor32_f(float v, int lane) { const U2 r = pl32(__builtin_bit_cast(unsigned, v)); return __builtin_bit_cast(float, (lane & 32) ? r.a : r.b); }
__device__ __forceinline__ float max_x16x32(float v) {
    U2 r = pl16(__builtin_bit_cast(unsigned, v)); v = fmaxf(__builtin_bit_cast(float, r.a), __builtin_bit_cast(float, r.b));
    r = pl32(__builtin_bit_cast(unsigned, v)); return fmaxf(__builtin_bit_cast(float, r.a), __builtin_bit_cast(float, r.b)); }
__device__ __forceinline__ float sum_x16x32(float v) {
    U2 r = pl16(__builtin_bit_cast(unsigned, v)); v = __builtin_bit_cast(float, r.a) + __builtin_bit_cast(float, r.b);
    r = pl32(__builtin_bit_cast(unsigned, v)); return __builtin_bit_cast(float, r.a) + __builtin_bit_cast(float, r.b); }
__device__ __forceinline__ float max3f(float a, float b, float c) { float r; asm("v_max3_f32 %0, %1, %2, %3" : "=v"(r) : "v"(a), "v"(b), "v"(c)); return r; }
__device__ __forceinline__ unsigned lds_add(LAS unsigned* p, unsigned v) { return __hip_atomic_fetch_add(p, v, __ATOMIC_RELAXED, __HIP_MEMORY_SCOPE_WORKGROUP); }
__device__ __forceinline__ f32x4 zero4() { float z = 0.f; asm volatile("" : "+v"(z)); return (f32x4){z, z, z, z}; }
typedef __bf16 bf16x2n __attribute__((ext_vector_type(2)));
__device__ __forceinline__ float dot2bf(unsigned w, float c) { const bf16x2n v = __builtin_bit_cast(bf16x2n, w); return __builtin_amdgcn_fdot2_f32_bf16(v, v, c, false); }
__device__ __forceinline__ float ex2(float x) { return __builtin_amdgcn_exp2f(x); }
__device__ __forceinline__ float lg2(float x) { return __builtin_amdgcn_logf(x); }

#define XB_TMO      128
#define XB_XCNT(j)  (256  + 64 * (j))
#define XB_XSUB(j)  (1280 + 64 * (j))
#define XB_XGEN(j)  (2304 + 64 * (j))
#define XB_TOP      3328
#define XB_TOPGEN   3392
#define XCD_BAR_WORDS 3456
#define XB_SPIN_CAP (1u << 21)
__device__ __forceinline__ unsigned xb_ld(unsigned* p)              { return __hip_atomic_load(p, __ATOMIC_RELAXED, __HIP_MEMORY_SCOPE_AGENT); }
__device__ __forceinline__ unsigned xb_add(unsigned* p, unsigned v) { return __hip_atomic_fetch_add(p, v, __ATOMIC_RELAXED, __HIP_MEMORY_SCOPE_AGENT); }
__device__ __forceinline__ unsigned xb_xcc_id() { return (unsigned)__builtin_amdgcn_s_getreg((3 << 11) | 20) & 0xFu; }
#define XB_SPIN(cond, bar) do { unsigned _sp = 0; while (cond) { __builtin_amdgcn_s_sleep(1); \
    if ((++_sp & 255u) == 0u) { if (xb_ld(&(bar)[XB_TMO])) break; if (_sp > XB_SPIN_CAP) { atomicAdd(&(bar)[XB_TMO], 1u); break; } } } } while (0)
struct XcdBarrier { unsigned* bar; unsigned x; volatile LAS unsigned* st; int wv; };
__device__ __forceinline__ XcdBarrier xcd_barrier_post(unsigned* bar, volatile LAS unsigned* st) {
    XcdBarrier b; b.bar = bar; b.x = xb_xcc_id(); b.st = st;
    if (threadIdx.x == 0) (void)xb_add(&bar[XB_XCNT(b.x)], 1u);
    return b;
}
__device__ __forceinline__ void xcd_barrier_complete(unsigned* bar, unsigned x, unsigned& nloc, unsigned& nx) {
    const unsigned G = gridDim.x * gridDim.y * gridDim.z;
    unsigned sum, cnt, mine, sp = 0u;
    for (;;) {
        sum = 0u; cnt = 0u; mine = 0u;
#pragma unroll
        for (unsigned j = 0; j < 16; ++j) { const unsigned c = xb_ld(&bar[XB_XCNT(j)]); sum += c; cnt += (c > 0u) ? 1u : 0u; mine = (j == x) ? c : mine; }
        if (sum == G) break;
        __builtin_amdgcn_s_sleep(1);
        if ((++sp & 255u) == 0u) { if (xb_ld(&bar[XB_TMO])) break; if (sp > XB_SPIN_CAP) { atomicAdd(&bar[XB_TMO], 1u); break; } }
    }
    nloc = mine > 0u ? mine : 1u; nx = cnt > 0u ? cnt : 1u;
}
__device__ __forceinline__ void xcd_barrier(const XcdBarrier& b) {
    asm volatile("s_waitcnt vmcnt(0)" ::: "memory");
    __syncthreads();
    if (opaque_tid(b.wv) == 0) {
        unsigned* bar = b.bar; asm volatile("" : "+s"(bar));
        unsigned bx = b.x; asm volatile("" : "+s"(bx));
        __builtin_amdgcn_s_waitcnt(0);
        unsigned nloc = b.st[0], nx = b.st[1];
        if (nloc == 0u) { xcd_barrier_complete(bar, bx, nloc, nx); b.st[0] = nloc; b.st[1] = nx; }
        const unsigned old = xb_add(&bar[XB_XSUB(bx)], 1u);
        const unsigned gen = old / nloc;
        if (old + 1u == (gen + 1u) * nloc) {
            __builtin_amdgcn_fence(__ATOMIC_RELEASE, "agent");
            asm volatile("s_waitcnt vmcnt(0)" ::: "memory");
            const unsigned og = xb_add(&bar[XB_TOP], 1u);
            const unsigned tg = og / nx;
            if (og + 1u == (tg + 1u) * nx) xb_add(&bar[XB_TOPGEN], 1u);
            else XB_SPIN(xb_ld(&bar[XB_TOPGEN]) == tg, bar);
            __builtin_amdgcn_fence(__ATOMIC_ACQUIRE, "agent");
            xb_add(&bar[XB_XGEN(bx)], 1u);
            asm volatile("s_waitcnt vmcnt(0)" ::: "memory");
        } else {
            XB_SPIN(xb_ld(&bar[XB_XGEN(bx)]) == gen, bar);
            __builtin_amdgcn_fence(__ATOMIC_ACQUIRE, "agent");
            asm volatile("s_waitcnt vmcnt(0)" ::: "memory");
        }
    }
    __syncthreads();
}

namespace pg8 {
constexpr int BM = 256, BK = 64, HALF = 128, HTB = HALF * BK * 2, NXCD = 8, WGM = 8, KD = 1024;
constexpr size_t HSTEP = (size_t)HALF * KD * 2, TSTEP = 2 * HSTEP, KSTEP = (size_t)BK * 2;
__host__ __device__ __forceinline__ int lds_byte(int r, int c) { const int st = (r >> 4) * 2 + (c >> 5), rr = r & 15, cc = c & 31, ob = rr * 64 + cc * 2; return st * 1024 + (ob ^ (((ob >> 9) & 1) << 5)); }
__host__ __device__ __forceinline__ void stage_rc(int b, int& R, int& C) { const int st = b / 1024, sb = b % 1024, swz = sb ^ (((sb >> 9) & 1) << 5); R = (st >> 1) * 16 + swz / 64; C = (st & 1) * 32 + (swz % 64) / 2; }
__host__ __device__ __forceinline__ int perm32(int rho) { const int n = rho >> 4, i = rho & 15; return 8 * (i >> 2) + 4 * n + (i & 3); }
struct Unit { int pm, pn, e; };
struct Order {
    int nM, nN, nwg, G, c;
    __device__ void init(int nM_, int nN_, int G_, int c_) { nM = nM_; nN = nN_; nwg = nM * nN; G = G_; c = c_; }
    __device__ bool tile(int i, int& pm, int& pn) const {
        const long L = (long)i * G + c; if (L >= nwg) return false;
        int wgid = (int)L; { const int q = nwg / NXCD, r = nwg % NXCD, xcd = wgid % NXCD, off = wgid / NXCD; wgid = (xcd < r ? xcd * (q + 1) : r * (q + 1) + (xcd - r) * q) + off; }
        const int nig = WGM * nN, gid = wgid / nig, fm = gid * WGM, gsz = (nM - fm) < WGM ? (nM - fm) : WGM;
        pm = fm + ((wgid % nig) % gsz); pn = (wgid % nig) / gsz; return true;
    }
};
struct SchedDense {
    static constexpr bool GATHER = false, LA = false;
    Order o; const char* A; const char* B;
    __device__ __forceinline__ bool next(int i, Unit& u) const { u.e = 0; return o.tile(i, u.pm, u.pn); }
    __device__ __forceinline__ const char* aptr(const Unit& u) const { return A + (size_t)u.pm * TSTEP; }
    __device__ __forceinline__ const char* bptr(const Unit& u) const { return B + (size_t)u.pn * TSTEP; }
};
struct SchedDense8 {
    static constexpr bool GATHER = false, LA = false;
    Order o; const char* A; const char* B;
    __device__ __forceinline__ bool next(int i, Unit& u) const { u.e = 0; return o.tile(i, u.pm, u.pn); }
    __device__ __forceinline__ const char* aptr(const Unit& u) const { return A + (size_t)u.pm * (TSTEP / 2); }
    __device__ __forceinline__ const char* bptr(const Unit& u) const { return B + (size_t)u.pn * (TSTEP / 2); }
};
struct SchedMoe {
    static constexpr bool GATHER = false, LA = true;
    __device__ __forceinline__ bool idx(int i, Unit& u) const { return o.tile(i, u.pm, u.pn); }
    __device__ __forceinline__ int e_raw(const Unit& u) const { return tile_e[u.pm]; }
    Order o; const char* A; const char* B; const int* tile_e; size_t estride;
    __device__ __forceinline__ bool next(int i, Unit& u) const { if (!o.tile(i, u.pm, u.pn)) return false; u.e = __builtin_amdgcn_readfirstlane(tile_e[u.pm]); return true; }
    __device__ __forceinline__ const char* aptr(const Unit& u) const { return A + (size_t)u.pm * (TSTEP / 2); }
    __device__ __forceinline__ const char* bptr(const Unit& u) const { return B + (size_t)u.e * estride + (size_t)u.pn * (TSTEP / 2); }
};
struct SchedMoeG {
    static constexpr bool GATHER = true, LA = true;
    Order o; const char* A; const char* B; const int* tile_e; size_t estride; const int* rowdst;
    __device__ __forceinline__ bool idx(int i, Unit& u) const { return o.tile(i, u.pm, u.pn); }
    __device__ __forceinline__ int e_raw(const Unit& u) const { return tile_e[u.pm]; }
    __device__ __forceinline__ bool next(int i, Unit& u) const { if (!o.tile(i, u.pm, u.pn)) return false; u.e = __builtin_amdgcn_readfirstlane(tile_e[u.pm]); return true; }
    __device__ __forceinline__ const char* aptr(const Unit&) const { return A; }
    __device__ __forceinline__ const char* bptr(const Unit& u) const { return B + (size_t)u.e * estride + (size_t)u.pn * (TSTEP / 2); }
};
typedef int v8i __attribute__((ext_vector_type(8)));
__device__ __forceinline__ int fp8x4(float a, float b, float c, float d) {
    float hi = 448.f; asm volatile("" : "+v"(hi));
    a = __builtin_amdgcn_fmed3f(a, -hi, hi); b = __builtin_amdgcn_fmed3f(b, -hi, hi); c = __builtin_amdgcn_fmed3f(c, -hi, hi); d = __builtin_amdgcn_fmed3f(d, -hi, hi);
    int r = __builtin_amdgcn_cvt_pk_fp8_f32(a, b, 0, false); r = __builtin_amdgcn_cvt_pk_fp8_f32(c, d, r, true); return r;
}
__host__ __device__ __forceinline__ int x8(int rr) { return ((rr >> 1) & 1) | (((rr >> 3) & 1) << 2); }
__device__ __forceinline__ unsigned cvt_pk_bf16(float lo, float hi) { unsigned r; asm volatile("v_cvt_pk_bf16_f32 %0, %1, %2" : "=v"(r) : "v"(lo), "v"(hi)); return r; }

struct EpiProj {
    static constexpr bool DMAFILL = false; static constexpr int TABW = 0, TAB_OFF = 0; __device__ __forceinline__ void fill_load(const Unit&, int, unsigned (&)[2]) const {} __device__ __forceinline__ void fill_store(LAS unsigned*, int, const unsigned (&)[2]) const {}
    static constexpr bool PERM = true;
    bf16* O; int ldc; bf16* VT;
    __device__ __forceinline__ static bool vt_unit(const Unit& u) { return u.pn == 2 || u.pn == 5 || u.pn == 8; }
    __device__ __forceinline__ void operator()(const f32x4 (&acc)[2][2][4][2], const Unit& u, int wr, int wc, int fr, int fq) const {
        if (vt_unit(u)) {
            const int g = (u.pn - 2) / 3, tok0 = u.pm * BM + wc * 32 + 8 * fq, b = tok0 >> 11, t0 = tok0 & 2047;
            bf16* vb = VT + ((size_t)(g * NB + b) * 256 + wr * 64 + fr) * SEQ + t0;
#pragma unroll
            for (int ai = 0; ai < 2; ++ai)
#pragma unroll
                for (int m = 0; m < 4; ++m)
#pragma unroll
                    for (int bj = 0; bj < 2; ++bj) { const f32x4 v0 = acc[ai][bj][m][0], v1 = acc[ai][bj][m][1];
                        u32x4 w; w.x = cvt_pk_bf16(v0[0], v0[1]); w.y = cvt_pk_bf16(v0[2], v0[3]); w.z = cvt_pk_bf16(v1[0], v1[1]); w.w = cvt_pk_bf16(v1[2], v1[3]);
                        *(u32x4*)(vb + (size_t)(ai * HALF + m * 16) * SEQ + bj * HALF) = w; }
            return;
        }
        const int row0 = u.pm * BM + wr * 64 + fr, col0 = u.pn * BM + wc * 32 + 8 * fq;
#pragma unroll
        for (int ai = 0; ai < 2; ++ai)
#pragma unroll
            for (int m = 0; m < 4; ++m) { bf16* rowp = O + (size_t)(row0 + ai * HALF + m * 16) * ldc + col0;
#pragma unroll
                for (int bj = 0; bj < 2; ++bj) { const f32x4 v0 = acc[ai][bj][m][0], v1 = acc[ai][bj][m][1];
                    u32x4 w; w.x = cvt_pk_bf16(v0[0], v0[1]); w.y = cvt_pk_bf16(v0[2], v0[3]); w.z = cvt_pk_bf16(v1[0], v1[1]); w.w = cvt_pk_bf16(v1[2], v1[3]);
                    *(u32x4*)(rowp + bj * HALF) = w; } }
    }
};
struct EpiResid {
    static constexpr bool DMAFILL = false; static constexpr int TABW = 0, TAB_OFF = 0; __device__ __forceinline__ void fill_load(const Unit&, int, unsigned (&)[2]) const {} __device__ __forceinline__ void fill_store(LAS unsigned*, int, const unsigned (&)[2]) const {}
    static constexpr bool PERM = true; __device__ __forceinline__ static bool vt_unit(const Unit&) { return false; }
    const float* xin_f32; bf16* X; const float* gate;
    __device__ __forceinline__ void operator()(const f32x4 (&acc)[2][2][4][2], const Unit& u, int wr, int wc, int fr, int fq) const {
        const int row0 = u.pm * BM + wr * 64 + fr, col0 = u.pn * BM + wc * 32 + 8 * fq;
        const float* g = gate + (size_t)((u.pm * BM) >> 11) * 6144 + col0;
        f32x4 gv[2][2];
#pragma unroll
        for (int bj = 0; bj < 2; ++bj)
#pragma unroll
            for (int n = 0; n < 2; ++n) gv[bj][n] = *(const f32x4*)(g + bj * HALF + 4 * n);
#pragma unroll
        for (int ai = 0; ai < 2; ++ai)
#pragma unroll
            for (int m = 0; m < 4; ++m) { const size_t ro = (size_t)(row0 + ai * HALF + m * 16) * DM + col0;
#pragma unroll
                for (int bj = 0; bj < 2; ++bj) {
                    f32x4 x0, x1;
                    if (xin_f32) { x0 = *(const f32x4*)(xin_f32 + ro + bj * HALF); x1 = *(const f32x4*)(xin_f32 + ro + bj * HALF + 4); }
                    else { const u32x4 w = *(const u32x4*)(X + ro + bj * HALF);
                        x0 = (f32x4){__builtin_bit_cast(float, w.x << 16), __builtin_bit_cast(float, w.x & 0xffff0000u), __builtin_bit_cast(float, w.y << 16), __builtin_bit_cast(float, w.y & 0xffff0000u)};
                        x1 = (f32x4){__builtin_bit_cast(float, w.z << 16), __builtin_bit_cast(float, w.z & 0xffff0000u), __builtin_bit_cast(float, w.w << 16), __builtin_bit_cast(float, w.w & 0xffff0000u)}; }
                    const f32x4 v0 = x0 + gv[bj][0] * acc[ai][bj][m][0], v1 = x1 + gv[bj][1] * acc[ai][bj][m][1];
                    u32x4 o; o.x = cvt_pk_bf16(v0[0], v0[1]); o.y = cvt_pk_bf16(v0[2], v0[3]); o.z = cvt_pk_bf16(v1[0], v1[1]); o.w = cvt_pk_bf16(v1[2], v1[3]);
                    *(u32x4*)(X + ro + bj * HALF) = o; } }
    }
};
__device__ __forceinline__ float swiglu1(float g, float l) {
    g = fminf(g, 7.0f); l = fminf(fmaxf(l, -7.0f), 7.0f);
    const float s = __builtin_amdgcn_rcpf(1.0f + __builtin_amdgcn_exp2f(-1.702f * LOG2E * g));
    return g * s * (l + 1.0f);
}
__device__ __forceinline__ int arow(int m, int fr) { return (m >> 1) * 32 + 8 * (fr >> 2) + 4 * (m & 1) + (fr & 3); }
struct EpiProj8 {
    static constexpr bool DMAFILL = false; static constexpr int TABW = 0, TAB_OFF = 0; __device__ __forceinline__ void fill_load(const Unit&, int, unsigned (&)[2]) const {} __device__ __forceinline__ void fill_store(LAS unsigned*, int, const unsigned (&)[2]) const {}
    static constexpr bool PERM = true;
    bf16* O; int ldc; bf16* VT;
    __device__ __forceinline__ static bool vt_unit(const Unit& u) { return u.pn == 2 || u.pn == 5 || u.pn == 8; }
    __device__ __forceinline__ void operator()(const f32x4 (&acc)[2][2][4][2], const Unit& u, int wr, int wc, int fr, int fq) const {
        if (vt_unit(u)) {
            const int g = (u.pn - 2) / 3, tok0 = u.pm * BM + wc * 32 + 8 * fq, b = tok0 >> 11, t0 = tok0 & 2047;
            bf16* vb = VT + ((size_t)(g * NB + b) * 256 + wr * 64) * SEQ + t0;
#pragma unroll
            for (int ai = 0; ai < 2; ++ai)
#pragma unroll
                for (int m = 0; m < 4; ++m)
#pragma unroll
                    for (int bj = 0; bj < 2; ++bj) { const f32x4 v0 = acc[ai][bj][m][0] * 0.015625f, v1 = acc[ai][bj][m][1] * 0.015625f;
                        u32x4 w; w.x = cvt_pk_bf16(v0[0], v0[1]); w.y = cvt_pk_bf16(v0[2], v0[3]); w.z = cvt_pk_bf16(v1[0], v1[1]); w.w = cvt_pk_bf16(v1[2], v1[3]);
                        *(u32x4*)(vb + (size_t)(ai * HALF + arow(m, fr)) * SEQ + bj * HALF) = w; }
            return;
        }
        const int row0 = u.pm * BM + wr * 64, col0 = u.pn * BM + wc * 32 + 8 * fq;
#pragma unroll
        for (int ai = 0; ai < 2; ++ai)
#pragma unroll
            for (int m = 0; m < 4; ++m) { bf16* rowp = O + (size_t)(row0 + ai * HALF + arow(m, fr)) * ldc + col0;
#pragma unroll
                for (int bj = 0; bj < 2; ++bj) { const f32x4 v0 = acc[ai][bj][m][0] * 0.015625f, v1 = acc[ai][bj][m][1] * 0.015625f;
                    u32x4 w; w.x = cvt_pk_bf16(v0[0], v0[1]); w.y = cvt_pk_bf16(v0[2], v0[3]); w.z = cvt_pk_bf16(v1[0], v1[1]); w.w = cvt_pk_bf16(v1[2], v1[3]);
                    *(u32x4*)(rowp + bj * HALF) = w; } }
    }
};
__device__ __forceinline__ void swap16(unsigned& a, unsigned& b) { asm volatile("s_nop 1\n\tv_permlane16_swap_b32 %0, %1" : "+v"(a), "+v"(b)); }
struct EpiSwiglu {
    static constexpr bool PERM = true; __device__ __forceinline__ static bool vt_unit(const Unit&) { return false; }
    unsigned char* O; const float* bias;
    static constexpr bool DMAFILL = false; static constexpr int TABW = 256, TAB_OFF = 143360;
    __device__ __forceinline__ void fill_load(const Unit& u, int tid, unsigned (&v)[2]) const { const int t = tid & 255;
        v[0] = __builtin_bit_cast(unsigned, bias[(size_t)u.e * 2048 + (t < 128 ? u.pn * HALF + t : 1024 + u.pn * HALF + (t - 128))]); v[1] = 0u; }
    __device__ __forceinline__ void fill_store(LAS unsigned* tab, int tid, const unsigned (&v)[2]) const { tab[tid & 255] = v[0]; }
    __device__ __forceinline__ void operator()(const f32x4 (&acc)[2][2][4][2], const Unit& u, int wr, int wc, int fr, int fq, const LAS unsigned* tab) const {
        const int row0 = u.pm * BM + wr * 64, colw = u.pn * HALF + wc * 32 + 8 * (fq & ~1), odd = fq & 1;
        f32x4 bv[2][2];
#pragma unroll
        for (int bj = 0; bj < 2; ++bj)
#pragma unroll
            for (int n = 0; n < 2; ++n) { bv[bj][n] = *(const LAS f32x4*)(tab + bj * 128 + wc * 32 + 8 * fq + 4 * n); if (bj == 1) bv[bj][n] = bv[bj][n] * 4.0f + 4.0f; }
#pragma unroll
        for (int ai = 0; ai < 2; ++ai)
#pragma unroll
            for (int mp = 0; mp < 2; ++mp) { u32x2 wp[2];
#pragma unroll
              for (int mm = 0; mm < 2; ++mm) { const int m = 2 * mp + mm;
                int wq[2];
#pragma unroll
                for (int n = 0; n < 2; ++n) { const f32x4 g4 = acc[ai][0][m][n] * 0.015625f + bv[0][n], l4 = acc[ai][1][m][n] * 0.0625f + bv[1][n];
                    f32x2 r2[2];
#pragma unroll
                    for (int hh = 0; hh < 2; ++hh) {
                        f32x2 g = {fminf(g4[2 * hh], 7.0f), fminf(g4[2 * hh + 1], 7.0f)};
                        f32x2 l = {__builtin_amdgcn_fmed3f(l4[2 * hh], -24.0f, 32.0f), __builtin_amdgcn_fmed3f(l4[2 * hh + 1], -24.0f, 32.0f)};
                        const f32x2 ea = g * (-1.702f * LOG2E);
                        const f32x2 den = (f32x2){__builtin_amdgcn_exp2f(ea[0]), __builtin_amdgcn_exp2f(ea[1])} + 1.0f;
                        const f32x2 sg = {__builtin_amdgcn_rcpf(den[0]), __builtin_amdgcn_rcpf(den[1])};
                        r2[hh] = (g * sg) * l; }
                    int w = __builtin_amdgcn_cvt_pk_fp8_f32(r2[0][0], r2[0][1], 0, false); wq[n] = __builtin_amdgcn_cvt_pk_fp8_f32(r2[1][0], r2[1][1], w, true); }
                wp[mm].x = (unsigned)wq[0]; wp[mm].y = (unsigned)wq[1]; }
              unsigned ax = wp[0].x, ay = wp[0].y, bx = wp[1].x, by = wp[1].y;
              swap16(ax, bx); swap16(ay, by);
              *(u32x4*)(O + (size_t)(row0 + ai * HALF + arow(2 * mp + odd, fr)) * DM + colw) = (u32x4){ax, ay, bx, by}; }
    }
};
struct EpiDown {
    static constexpr bool PERM = true; __device__ __forceinline__ static bool vt_unit(const Unit&) { return false; }
    unsigned char* O; const float* bias; const int* dst; const float* gate;
    static constexpr int TABW = 768, TAB_OFF = 135168;
    static constexpr bool DMAFILL = true;
    __device__ __forceinline__ void fill_dma(const Unit& u, LAS unsigned* tab, int tid) const { const int wv = __builtin_amdgcn_readfirstlane(tid >> 6), t = tid & 255;
        if (wv < 4) { __builtin_amdgcn_global_load_lds((const unsigned*)(bias + (size_t)u.e * 1024 + u.pn * BM + t), tab + wv * 64, 4, 0, 0);
                      __builtin_amdgcn_global_load_lds((const unsigned*)(dst + u.pm * BM + t), tab + 256 + wv * 64, 4, 0, 0); }
        else __builtin_amdgcn_global_load_lds((const unsigned*)(gate + u.pm * BM + t), tab + 512 + (wv - 4) * 64, 4, 0, 0); }
    __device__ __forceinline__ void fill_load(const Unit& u, int tid, unsigned (&v)[2]) const { const int t = tid & 255;
        const float* p0 = (tid < 256) ? bias + (size_t)u.e * 1024 + u.pn * BM + t : gate + u.pm * BM + t;
        v[0] = __builtin_bit_cast(unsigned, *p0); v[1] = (unsigned)dst[u.pm * BM + t]; }
    __device__ __forceinline__ void fill_store(LAS unsigned* tab, int tid, const unsigned (&v)[2]) const { tab[tid + (tid < 256 ? 0 : 256)] = v[0]; tab[256 + (tid & 255)] = v[1]; }
    __device__ __forceinline__ void operator()(const f32x4 (&acc)[2][2][4][2], const Unit& u, int wr, int wc, int fr, int fq, const LAS unsigned* tab) const {
        const int colw = u.pn * BM + wc * 32 + 8 * (fq & ~1), odd = fq & 1;
        f32x4 bv[2][2];
#pragma unroll
        for (int bj = 0; bj < 2; ++bj)
#pragma unroll
            for (int n = 0; n < 2; ++n) bv[bj][n] = *(const LAS f32x4*)(tab + bj * HALF + wc * 32 + 8 * fq + 4 * n);
#pragma unroll
        for (int ai = 0; ai < 2; ++ai)
#pragma unroll
            for (int mp = 0; mp < 2; ++mp) { u32x2 wp[2][2];
#pragma unroll
                for (int mm = 0; mm < 2; ++mm) { const int m = 2 * mp + mm; const int rl = wr * 64 + ai * HALF + arow(m, fr); const float gt = __builtin_bit_cast(float, tab[512 + rl]) * 32.0f;
#pragma unroll
                    for (int bj = 0; bj < 2; ++bj) { const f32x4 v0 = (acc[ai][bj][m][0] * 0.00390625f + bv[bj][0]) * gt, v1 = (acc[ai][bj][m][1] * 0.00390625f + bv[bj][1]) * gt;
                        wp[mm][bj].x = (unsigned)fp8x4(v0[0], v0[1], v0[2], v0[3]); wp[mm][bj].y = (unsigned)fp8x4(v1[0], v1[1], v1[2], v1[3]); } }
                const int d = (int)tab[256 + wr * 64 + ai * HALF + arow(2 * mp + odd, fr)];
                unsigned char* rowp = O + (size_t)(d < 0 ? T * 4 : d) * DM + colw;
#pragma unroll
                for (int bj = 0; bj < 2; ++bj) { unsigned ax = wp[0][bj].x, ay = wp[0][bj].y, bx = wp[1][bj].x, by = wp[1][bj].y;
                    swap16(ax, bx); swap16(ay, by);
                    *(u32x4*)(rowp + bj * HALF) = (u32x4){ax, ay, bx, by}; } }
    }
};

struct EpiResid8 {
    static constexpr bool DMAFILL = false; static constexpr int TABW = 0, TAB_OFF = 0; __device__ __forceinline__ void fill_load(const Unit&, int, unsigned (&)[2]) const {} __device__ __forceinline__ void fill_store(LAS unsigned*, int, const unsigned (&)[2]) const {}
    static constexpr bool PERM = true; __device__ __forceinline__ static bool vt_unit(const Unit&) { return false; }
    const float* xin_f32; bf16* X; const float* gate;
    __device__ __forceinline__ void operator()(const f32x4 (&acc)[2][2][4][2], const Unit& u, int wr, int wc, int fr, int fq) const {
        const int row0 = u.pm * BM + wr * 64, col0 = u.pn * BM + wc * 32 + 8 * fq;
        const float* g = gate + (size_t)((u.pm * BM) >> 11) * 6144 + col0;
        f32x4 gv[2][2];
#pragma unroll
        for (int bj = 0; bj < 2; ++bj)
#pragma unroll
            for (int n = 0; n < 2; ++n) gv[bj][n] = *(const f32x4*)(g + bj * HALF + 4 * n) * 0.001953125f;
#pragma unroll
        for (int ai = 0; ai < 2; ++ai)
#pragma unroll
            for (int m = 0; m < 4; ++m) { const size_t ro = (size_t)(row0 + ai * HALF + arow(m, fr)) * DM + col0;
#pragma unroll
                for (int bj = 0; bj < 2; ++bj) {
                    f32x4 x0, x1;
                    if (xin_f32) { x0 = *(const f32x4*)(xin_f32 + ro + bj * HALF); x1 = *(const f32x4*)(xin_f32 + ro + bj * HALF + 4); }
                    else { const u32x4 w = *(const u32x4*)(X + ro + bj * HALF);
                        x0 = (f32x4){__builtin_bit_cast(float, w.x << 16), __builtin_bit_cast(float, w.x & 0xffff0000u), __builtin_bit_cast(float, w.y << 16), __builtin_bit_cast(float, w.y & 0xffff0000u)};
                        x1 = (f32x4){__builtin_bit_cast(float, w.z << 16), __builtin_bit_cast(float, w.z & 0xffff0000u), __builtin_bit_cast(float, w.w << 16), __builtin_bit_cast(float, w.w & 0xffff0000u)}; }
                    const f32x4 v0 = x0 + gv[bj][0] * acc[ai][bj][m][0], v1 = x1 + gv[bj][1] * acc[ai][bj][m][1];
                    u32x4 o; o.x = cvt_pk_bf16(v0[0], v0[1]); o.y = cvt_pk_bf16(v0[2], v0[3]); o.z = cvt_pk_bf16(v1[0], v1[1]); o.w = cvt_pk_bf16(v1[2], v1[3]);
                    *(u32x4*)(X + ro + bj * HALF) = o; } }
    }
};

template <class Epi, class Sched, bool FP8 = false>
__device__ __forceinline__ void gemm_phase(LAS unsigned char* lds, const Sched& S, const Epi& E, int wave_s) {
    const int tid = opaque_tid(wave_s), wid = __builtin_amdgcn_readfirstlane(tid >> 6), lane = tid & 63, wr = wid >> 2, wc = wid & 3, fr = lane & 15, fq = lane >> 4;
    constexpr int K = KD, nt = FP8 ? K / 128 : K / BK;
    unsigned voffA[2], voffB[2];
#pragma unroll
    for (int i = 0; i < 2; ++i) {
        if (FP8) { const int q = (tid * 16 + i * 8192) >> 4, st = q >> 7, rr = (q >> 3) & 15, s16 = (q & 7) ^ x8(rr); const int R = st * 16 + rr, Rb = (R & ~31) + perm32(R & 31);
            voffA[i] = voffB[i] = (unsigned)(Rb * K + s16 * 16); }
        else { int R, C; stage_rc(tid * 16 + i * 8192, R, C); const int Rb = Epi::PERM ? ((R & ~31) + perm32(R & 31)) : R;
            voffA[i] = (unsigned)(R * K + C) * 2u; voffB[i] = (unsigned)(Rb * K + C) * 2u; } }
    constexpr size_t kstep = KSTEP, hstep = FP8 ? HSTEP / 2 : HSTEP;
    constexpr bool GATHER = Sched::GATHER;
#define PG8_GTAB ((LAS unsigned*)(lds + GTAB_LDS) + opaque_tid(wave_s) * 2)
    const unsigned ldsw = (unsigned)wid * 1024u;
    const int aoff = FP8 ? ((wr * 64 + fr) * 8 + ((fq * 2) ^ x8(fr))) * 16 : lds_byte(wr * 64 + fr, fq * 8), boff = FP8 ? ((wc * 32 + fr) * 8 + ((fq * 2) ^ x8(fr))) * 16 : lds_byte(wc * 32 + fr, fq * 8);
    const int poff = FP8 ? ((((fq * 2 + 1) ^ x8(fr)) - ((fq * 2) ^ x8(fr))) * 16) : 1024;
    const LAS unsigned char* pa0 = lds + aoff; const LAS unsigned char* pa1 = lds + aoff + poff; const LAS unsigned char* pb0 = lds + 65536 + boff; const LAS unsigned char* pb1 = lds + 65536 + boff + poff;
    asm volatile("" : "+v"(pa0), "+v"(pa1), "+v"(pb0), "+v"(pb1));

#define PG8_SA(b, h) (((b) * 2 + (h)) * HTB)
#define PG8_SB(b, h) ((4 + (b) * 2 + (h)) * HTB)
#define PG8_VOFFB (FP8 ? voffA : voffB)
#define PG8_STAGE(bufoff, gbase, voff) do { _Pragma("unroll") for (int _i = 0; _i < 2; ++_i) { unsigned _v = (voff)[_i]; asm volatile("" : "+v"(_v));     \
        __builtin_amdgcn_global_load_lds((const unsigned*)((const char*)(gbase) + _v), (LAS unsigned*)(lds + (bufoff) + ldsw + _i * 8192), 16, 0, 0); } } while (0)
#define PG8_STAGE_A(bufoff, gbase, h, par) do { if constexpr (GATHER) { const unsigned _w = PG8_GTAB[(par) * 1024 + (h)]; _Pragma("unroll") for (int _i = 0; _i < 2; ++_i) { \
            unsigned _v = ((_w >> (16 * _i)) & 0xffffu) * 1024u + (voffA[_i] & 1023u); asm volatile("" : "+v"(_v)); \
            __builtin_amdgcn_global_load_lds((const unsigned*)((const char*)(gbase) + _v), (LAS unsigned*)(lds + (bufoff) + ldsw + _i * 8192), 16, 0, 0); } } \
        else PG8_STAGE(bufoff, (gbase) + (h) * hstep, voffA); } while (0)
#define PG8_GLOAD(u, g) do { if constexpr (GATHER) { _Pragma("unroll") for (int _h = 0; _h < 2; ++_h) _Pragma("unroll") for (int _i = 0; _i < 2; ++_i) { \
            unsigned _vo = voffA[_i]; asm volatile("" : "+v"(_vo)); (g)[_h * 2 + _i] = S.rowdst[(u).pm * BM + _h * HALF + (int)(_vo >> 10)]; } } } while (0)
#define PG8_GSTORE(par, g) do { if constexpr (GATHER) { _Pragma("unroll") for (int _h = 0; _h < 2; ++_h) { unsigned _w = 0; _Pragma("unroll") for (int _i = 0; _i < 2; ++_i) { \
            const int _d = (g)[_h * 2 + _i]; _w |= (unsigned)(_d < 0 ? 0 : (_d >> 2)) << (16 * _i); } PG8_GTAB[(par) * 1024 + _h] = _w; } } } while (0)
#define PG8_GFILL(u, par) do { if constexpr (GATHER) { _Pragma("unroll") for (int _h = 0; _h < 2; ++_h) { unsigned _w = 0; _Pragma("unroll") for (int _i = 0; _i < 2; ++_i) { \
            unsigned _vo = voffA[_i]; asm volatile("" : "+v"(_vo));     \
            const int _d = S.rowdst[(u).pm * BM + _h * HALF + (int)(_vo >> 10)]; _w |= (unsigned)(_d < 0 ? 0 : (_d >> 2)) << (16 * _i); } PG8_GTAB[(par) * 1024 + _h] = _w; } } } while (0)
#define PG8_LDA(dst, b, h) do { _Pragma("unroll") for (int m = 0; m < 4; ++m) _Pragma("unroll") for (int k = 0; k < 2; ++k) dst[m][k] = *(const LAS bf16x8*)((k ? pa1 : pa0) + PG8_SA(b, h) + m * 2048); } while (0)
#define PG8_LDB(dst, b, h) do { _Pragma("unroll") for (int n = 0; n < 2; ++n) _Pragma("unroll") for (int k = 0; k < 2; ++k) dst[n][k] = *(const LAS bf16x8*)((k ? pb1 : pb0) + (PG8_SB(b, h) - 65536) + n * 2048); } while (0)
#define PG8_V8(f) __builtin_shufflevector(__builtin_bit_cast(u32x4, (f)[0]), __builtin_bit_cast(u32x4, (f)[1]), 0, 1, 2, 3, 4, 5, 6, 7)
#define PG8_MMA(ai, bj, At, Bt) do { __builtin_amdgcn_s_setprio(1); \
        if constexpr (FP8) { _Pragma("unroll") for (int m = 0; m < 4; ++m) _Pragma("unroll") for (int n = 0; n < 2; ++n) \
            acc[ai][bj][m][n] = __builtin_amdgcn_mfma_scale_f32_16x16x128_f8f6f4(__builtin_bit_cast(v8i, PG8_V8(Bt[n])), __builtin_bit_cast(v8i, PG8_V8(At[m])), acc[ai][bj][m][n], 0, 0, 0, 0, 0, 0); } \
        else { _Pragma("unroll") for (int m = 0; m < 4; ++m) _Pragma("unroll") for (int n = 0; n < 2; ++n) _Pragma("unroll") for (int k = 0; k < 2; ++k) \
            acc[ai][bj][m][n] = __builtin_amdgcn_mfma_f32_16x16x32_bf16(Bt[n][k], At[m][k], acc[ai][bj][m][n], 0, 0, 0); } \
        __builtin_amdgcn_s_setprio(0); } while (0)
#define PG8_WAIT_V(n) asm volatile("s_waitcnt vmcnt(" #n ")" ::: "memory")
#define PG8_WAIT_L(n) asm volatile("s_waitcnt lgkmcnt(" #n ")" ::: "memory")
#define PG8_BAR __builtin_amdgcn_s_barrier()
#define PG8_SCHED __builtin_amdgcn_sched_barrier(0)
    Unit cur, nxt; int ui = 0;
    if (!S.next(0, cur)) return;
    f32x4 acc[2][2][4][2];
    { float z0 = 0.f; asm volatile("" : "+v"(z0));
#pragma unroll
    for (int a = 0; a < 2; ++a)
#pragma unroll
        for (int b = 0; b < 2; ++b)
#pragma unroll
            for (int m = 0; m < 4; ++m)
#pragma unroll
                for (int n = 0; n < 2; ++n) acc[a][b][m][n] = (f32x4){z0, z0, z0, z0}; }
    bf16x8 At[4][2], B0[2][2], B1[2][2];
    const char* cA = Epi::vt_unit(cur) ? S.bptr(cur) : S.aptr(cur); const char* cB = Epi::vt_unit(cur) ? S.aptr(cur) : S.bptr(cur);
    int cpar = 0;
    PG8_GFILL(cur, 0);
    if constexpr (Sched::LA && GATHER) { Unit t1; if (S.idx(1, t1)) PG8_GFILL(t1, 1); }
    {
        PG8_STAGE(PG8_SB(0, 0), cB, PG8_VOFFB); PG8_STAGE(PG8_SB(0, 1), cB + hstep, PG8_VOFFB); PG8_STAGE_A(PG8_SA(0, 0), cA, 0, 0); PG8_STAGE_A(PG8_SA(0, 1), cA, 1, 0);
        if (wr == 1) PG8_BAR;
        PG8_WAIT_V(2); PG8_BAR;
        PG8_STAGE(PG8_SB(1, 0), cB + kstep, PG8_VOFFB); PG8_STAGE_A(PG8_SA(1, 0), cA + kstep, 0, 0); PG8_STAGE(PG8_SB(1, 1), cB + hstep + kstep, PG8_VOFFB);
        PG8_WAIT_V(6); PG8_BAR;
    }
    constexpr bool LA = Sched::LA;
    bool has_next = false;
    nxt = cur;
    if constexpr (LA) {
        has_next = S.next(1, nxt);
        if constexpr (Epi::TABW > 0) { unsigned fv[2]; const int tz = opaque_tid(wave_s); E.fill_load(cur, tz, fv); E.fill_store((LAS unsigned*)(lds + Epi::TAB_OFF), tz, fv); }
    }
    for (;;) {
        if constexpr (!LA) {
        has_next = S.next(ui + 1, nxt);
        if constexpr (Epi::TABW > 0) { unsigned fv[2]; const int tz = opaque_tid(wave_s); E.fill_load(cur, tz, fv); E.fill_store((LAS unsigned*)(lds + Epi::TAB_OFF) + (ui & 1) * Epi::TABW, tz, fv); }
        }
        const bool nvt = has_next && Epi::vt_unit(nxt);
        const char* nA = has_next ? (nvt ? S.bptr(nxt) : S.aptr(nxt)) : cA; const char* nB = has_next ? (nvt ? S.aptr(nxt) : S.bptr(nxt)) : cB;
        if constexpr (!LA) { if (has_next) PG8_GFILL(nxt, cpar ^ 1); }
        const int npar = has_next ? (cpar ^ 1) : cpar;
#pragma unroll 1
        for (int t = 0; t < nt; t += 2) {
            const bool last = (t == nt - 2);
            const char* a1 = cA + (size_t)(t + 1) * kstep;
            const char* a2 = last ? nA : cA + (size_t)(t + 2) * kstep; const char* b2 = last ? nB : cB + (size_t)(t + 2) * kstep;
            const char* a3 = a2 + kstep; const char* b3 = b2 + kstep;
            const int p2 = last ? npar : cpar;
            PG8_LDB(B0, 0, 0); PG8_LDB(B1, 0, 1); PG8_SCHED; PG8_LDA(At, 0, 0); PG8_STAGE_A(PG8_SA(1, 1), a1, 1, cpar);
            PG8_WAIT_V(8); PG8_WAIT_L(0); PG8_BAR; PG8_MMA(0, 0, At, B0); PG8_MMA(0, 1, At, B1); PG8_BAR; PG8_SCHED;
            PG8_LDA(At, 0, 1); PG8_STAGE(PG8_SB(0, 0), b2, PG8_VOFFB); PG8_STAGE(PG8_SB(0, 1), b2 + hstep, PG8_VOFFB); PG8_STAGE_A(PG8_SA(0, 0), a2, 0, p2);
            PG8_WAIT_V(8); PG8_WAIT_L(0); PG8_BAR; PG8_MMA(1, 0, At, B0); PG8_MMA(1, 1, At, B1); PG8_BAR; PG8_SCHED;
            PG8_LDB(B0, 1, 0); PG8_LDB(B1, 1, 1); PG8_SCHED; PG8_LDA(At, 1, 0); PG8_STAGE_A(PG8_SA(0, 1), a2, 1, p2);
            PG8_WAIT_V(8); PG8_WAIT_L(0); PG8_BAR; PG8_MMA(0, 0, At, B0); PG8_MMA(0, 1, At, B1); PG8_BAR; PG8_SCHED;
            PG8_LDA(At, 1, 1); PG8_STAGE(PG8_SB(1, 0), b3, PG8_VOFFB); PG8_STAGE(PG8_SB(1, 1), b3 + hstep, PG8_VOFFB); PG8_STAGE_A(PG8_SA(1, 0), a3, 0, p2);
            PG8_WAIT_V(8); PG8_WAIT_L(0); PG8_BAR; PG8_MMA(1, 0, At, B0); PG8_MMA(1, 1, At, B1); PG8_BAR; PG8_SCHED;
        }
        Unit nx2 = nxt; bool has_n2 = false; int e2 = 0; unsigned fv2[2] = {0u, 0u}; int g4[4] = {0, 0, 0, 0};
        if constexpr (LA) has_n2 = has_next && S.idx(ui + 2, nx2);
        if (wr == 0) PG8_BAR;
        constexpr bool DMAT = LA && !GATHER && Epi::DMAFILL;
        if constexpr (DMAT) { __builtin_amdgcn_global_load_lds((const unsigned*)(S.tile_e + nx2.pm), (LAS unsigned*)(lds + TE_LDS + ldsw / 4), 4, 0, 0);
                              E.fill_dma(nxt, (LAS unsigned*)(lds + Epi::TAB_OFF) + ((ui + 1) & 1) * Epi::TABW, opaque_tid(wave_s)); }
        else if constexpr (LA) { e2 = S.e_raw(nx2); PG8_GLOAD(nx2, g4); if constexpr (Epi::TABW > 0) E.fill_load(nxt, opaque_tid(wave_s), fv2); }
        { const int tz = opaque_tid(wave_s); const int l2 = tz & 63, w2 = __builtin_amdgcn_readfirstlane(tz >> 6); if constexpr (Epi::TABW > 0) E(acc, cur, w2 >> 2, w2 & 3, l2 & 15, l2 >> 4, (const LAS unsigned*)(lds + Epi::TAB_OFF) + (ui & 1) * Epi::TABW); else E(acc, cur, w2 >> 2, w2 & 3, l2 & 15, l2 >> 4); }
        if (!has_next) break;
        { float z0 = 0.f; asm volatile("" : "+v"(z0));
#pragma unroll
        for (int a = 0; a < 2; ++a)
#pragma unroll
            for (int b = 0; b < 2; ++b)
#pragma unroll
                for (int m = 0; m < 4; ++m)
#pragma unroll
                    for (int n = 0; n < 2; ++n) acc[a][b][m][n] = (f32x4){z0, z0, z0, z0}; }
        if constexpr (DMAT) { asm volatile("s_waitcnt vmcnt(8)" ::: "memory");
                              const int ev = *(const LAS int*)(lds + TE_LDS + ldsw / 4); if (has_n2) nx2.e = __builtin_amdgcn_readfirstlane(ev); }
        else if constexpr (LA) { asm volatile("" : "+v"(e2), "+v"(g4[0]), "+v"(g4[1]), "+v"(g4[2]), "+v"(g4[3]), "+v"(fv2[0]), "+v"(fv2[1]));
                            if (has_n2) { nx2.e = __builtin_amdgcn_readfirstlane(e2); PG8_GSTORE(cpar, g4); }
                            if constexpr (Epi::TABW > 0) E.fill_store((LAS unsigned*)(lds + Epi::TAB_OFF) + ((ui + 1) & 1) * Epi::TABW, opaque_tid(wave_s), fv2); }
        cur = nxt; cA = nA; cB = nB; ++ui; cpar = npar;
        if constexpr (LA) { nxt = nx2; has_next = has_n2; }
        if (wr == 1) PG8_BAR;
    }
    PG8_WAIT_V(0);
    PG8_BAR;
#undef PG8_SA
#undef PG8_SB
#undef PG8_STAGE
#undef PG8_STAGE_A
#undef PG8_GTAB
#undef PG8_GFILL
#undef PG8_GLOAD
#undef PG8_GSTORE
#undef PG8_VOFFB
#undef PG8_LDA
#undef PG8_LDB
#undef PG8_MMA
#undef PG8_V8
#undef PG8_WAIT_V
#undef PG8_WAIT_L
#undef PG8_BAR
#undef PG8_SCHED
}
}

struct Frame {
    LAS unsigned char* lds;
    int tid, lane, wave, vcu, G, vcu0, G0, wave0;
};
__device__ __forceinline__ int opq_s(int v) { asm volatile("" : "+s"(v)); return v; }

__device__ __forceinline__ int win_src_col(int d) {
    if (d < 768) return d;
    if (d < 1536) return 1320 + (d - 768);
    if (d < 2304) return 2088 + (d - 1536);
    if (d < 2560) return 772 + (d - 2304);
    if (d < 2688) return 1028 + (d - 2560);
    if (d < 2816) return 1156 + (d - 2688);
    if (d < 2848) return 1284 + (d - 2816);
    if (d < 2852) return 1316 + (d - 2848);
    if (d < 2856) return 768 + (d - 2852);
    return -1;
}
__device__ __forceinline__ void tr_item(const float* W, int ldw, bf16* WT, int k0, int d0, int sc, LAS float* scr, int lane) {
#pragma unroll 8
    for (int i = 0; i < 32; ++i) { const int kk = 2 * i + (lane >> 5); scr[kk * 33 + (lane & 31)] = sc >= 0 ? __builtin_nontemporal_load(&W[(size_t)(k0 + kk) * ldw + sc]) : 0.f; }
    LDS_WAIT(); asm volatile("" ::: "memory");
    const int c = lane & 7;
#pragma unroll
    for (int j = 0; j < 4; ++j) { const int n = (lane >> 3) + 8 * j; const LAS float* s = scr + (8 * c) * 33 + n;
        u32x4 o; o.x = pk2(s[0 * 33], s[1 * 33]); o.y = pk2(s[2 * 33], s[3 * 33]); o.z = pk2(s[4 * 33], s[5 * 33]); o.w = pk2(s[6 * 33], s[7 * 33]);
        *(u32x4*)(WT + (size_t)(d0 + n) * 1024 + k0 + 8 * c) = o; }
    LDS_WAIT(); asm volatile("" ::: "memory");
}
__device__ __forceinline__ void tr_item8(const float* W, int ldw, unsigned char* WT, int k0, int d0, int sc, LAS float* scr, int lane) {
#pragma unroll 8
    for (int i = 0; i < 32; ++i) { const int kk = 2 * i + (lane >> 5); scr[kk * 33 + (lane & 31)] = sc >= 0 ? __builtin_nontemporal_load(&W[(size_t)(k0 + kk) * ldw + sc]) * 64.0f : 0.f; }
    LDS_WAIT(); asm volatile("" ::: "memory");
    const int c = lane & 7;
#pragma unroll
    for (int j = 0; j < 4; ++j) { const int n = (lane >> 3) + 8 * j; const LAS float* s = scr + (8 * c) * 33 + n;
        u32x2 o; o.x = (unsigned)pg8::fp8x4(s[0 * 33], s[1 * 33], s[2 * 33], s[3 * 33]); o.y = (unsigned)pg8::fp8x4(s[4 * 33], s[5 * 33], s[6 * 33], s[7 * 33]);
        *(u32x2*)(WT + (size_t)(d0 + n) * 1024 + k0 + 8 * c) = o; }
    LDS_WAIT(); asm volatile("" ::: "memory");
}
__device__ __forceinline__ void sincos_d(float angf, float& cs, float& sn) {
    const double a = (double)angf;
    const double q = __builtin_rint(a * 0.63661977236758134308);
    const double r = __builtin_fma(-q, 1.57079632679489661923, a) - q * 6.123233995736766e-17;
    const double r2 = r * r;
    double s = -1.0 / 39916800.0; s = s * r2 + 1.0 / 362880.0; s = s * r2 - 1.0 / 5040.0; s = s * r2 + 1.0 / 120.0; s = s * r2 - 1.0 / 6.0; s = s * r2 * r + r;
    double c = 1.0 / 479001600.0; c = c * r2 - 1.0 / 3628800.0; c = c * r2 + 1.0 / 40320.0; c = c * r2 - 1.0 / 720.0; c = c * r2 + 1.0 / 24.0; c = c * r2 - 0.5; c = c * r2 + 1.0;
    const int qi = ((int)q) & 3;
    const double cc = (qi == 0) ? c : (qi == 1) ? -s : (qi == 2) ? -c : s;
    const double ss = (qi == 0) ? s : (qi == 1) ? c : (qi == 2) ? -s : -c;
    cs = (float)cc; sn = (float)ss;
}
__device__ __forceinline__ void p0_prologue(KP Pq, Frame& F) {
    F.tid = opaque_tid(F.wave0); F.lane = F.tid & 63; F.wave = opq_s(F.wave0); F.vcu = opq_s(F.vcu0); F.G = opq_s(F.G0); const KP P = kp_fresh(); (void)Pq;
    unsigned char* ws = P->ws;
    LAS float* scr = (LAS float*)(F.lds + F.wave * 16384);
    const int gw = F.vcu * 8 + F.wave, NGW = F.G * 8;
    constexpr int N_WIN = NL * 16 * 96, N_WO = NL * 16 * 32, N_GU = NL * NE * 16 * 64, N_DN = NL * NE * 16 * 32;
    constexpr int N_ALL = N_WIN + N_WO + N_GU + N_DN;
    auto decode = [&](int it, const float*& W, int& ldw, unsigned char*& WT, int& k0, int& d0, int& sc) {
        int r = it;
        if (r < N_WIN) { const int l = r / 1536, rr = r % 1536, kb = rr / 96, db = rr % 96;
            W = P->w_in + (size_t)l * 1024 * IN_COLS; ldw = IN_COLS; WT = (unsigned char*)(ws + WS_WIN) + (size_t)l * NP * 1024; k0 = kb * 64; d0 = db * 32; sc = win_src_col(db * 32 + (F.lane & 31)); return; }
        r -= N_WIN;
        if (r < N_WO) { const int l = r / 512, rr = r % 512, kb = rr / 32, db = rr % 32;
            W = P->w_o + (size_t)l * 1024 * 1024; ldw = 1024; WT = (unsigned char*)(ws + WS_WO) + (size_t)l * 1024 * 1024; k0 = kb * 64; d0 = db * 32; sc = db * 32 + (F.lane & 31); return; }
        r -= N_WO;
        if (r < N_GU) { const int le = r / 1024, rr = r % 1024, kb = rr / 64, db = rr % 64;
            const int pn = db >> 3, w = db & 7; const int src = (w < 4) ? (pn * 128 + w * 32) : (1024 + pn * 128 + (w - 4) * 32);
            W = P->w_gu + (size_t)le * 1024 * 2048; ldw = 2048; WT = (unsigned char*)(ws + WS_WGU) + (size_t)le * 2048 * 1024; k0 = kb * 64; d0 = db * 32; sc = src + (F.lane & 31); return; }
        r -= N_GU;
        { const int le = r / 512, rr = r % 512, kb = rr / 32, db = rr % 32;
            W = P->w_dn + (size_t)le * 1024 * 1024; ldw = 1024; WT = (unsigned char*)(ws + WS_WDN) + (size_t)le * 1024 * 1024; k0 = kb * 64; d0 = db * 32; sc = db * 32 + (F.lane & 31); }
    };
    auto fetch = [&](const float* W, int ldw, int k0, int sc, float (&v)[32]) {
        const float* wp = W + (size_t)(k0 + (F.lane >> 5)) * ldw + (sc >= 0 ? sc : 0);
#pragma unroll
        for (int i = 0; i < 32; ++i) v[i] = __builtin_nontemporal_load(wp + (size_t)(2 * i) * ldw);
    };
    if (gw < N_ALL) {
        const float* W; int ldw, k0, d0, sc; unsigned char* WT; float va[32];
        decode(gw, W, ldw, WT, k0, d0, sc); fetch(W, ldw, k0, sc, va);
        for (int it = gw; it < N_ALL; it += NGW) {
            const float* W2 = W; int ldw2 = ldw, k02 = k0, d02 = d0, sc2 = sc; unsigned char* WT2 = WT; float vb[32];
            const bool more = it + NGW < N_ALL;
            if (more) decode(it + NGW, W2, ldw2, WT2, k02, d02, sc2);
            fetch(W2, ldw2, k02, sc2, vb);
            const float sm = (sc >= 0) ? 64.0f : 0.f;
#pragma unroll
            for (int i = 0; i < 32; ++i) { const int kk = 2 * i + (F.lane >> 5); scr[kk * 33 + (F.lane & 31)] = va[i] * sm; }
            LDS_WAIT(); asm volatile("" ::: "memory");
            const int c = F.lane & 7;
#pragma unroll
            for (int j = 0; j < 4; ++j) { const int n = (F.lane >> 3) + 8 * j; const LAS float* sp = scr + (8 * c) * 33 + n;
                u32x2 o; o.x = (unsigned)pg8::fp8x4(sp[0 * 33], sp[1 * 33], sp[2 * 33], sp[3 * 33]); o.y = (unsigned)pg8::fp8x4(sp[4 * 33], sp[5 * 33], sp[6 * 33], sp[7 * 33]);
                *(u32x2*)(WT + (size_t)(d0 + n) * 1024 + k0 + 8 * c) = o; }
            LDS_WAIT(); asm volatile("" ::: "memory");
            W = W2; ldw = ldw2; k0 = k02; d0 = d02; sc = sc2; WT = WT2;
#pragma unroll
            for (int i = 0; i < 32; ++i) va[i] = vb[i];
        }
    }
    const int gt = F.vcu * 512 + F.tid, NGT = F.G * 512;
    for (int i = gt; i < NL * 32 * 1024; i += NGT) { const int l = i >> 15, e = (i >> 10) & 31, k = i & 1023;
        const float w = P->w_router[((size_t)l * 1024 + k) * 32 + e]; const unsigned hi = f2bf(w); const unsigned lo = f2bf(w - bf2f(hi));
        ((bf16*)(ws + WS_WRT))[i] = (bf16)hi; ((bf16*)(ws + WS_WRT))[NL * 32 * 1024 + i] = (bf16)lo; }
    float* rt = (float*)(ws + WS_ROPE);
    for (int i = gt; i < SEQ * 48; i += NGT) { const int t = i / 48, j = i % 48;
        const int half = j < 32 ? 32 : 16, ii = j < 32 ? j : j - 32;
        const float inv = (float)exp(-9.210340371976184 * (double)ii / (double)half);
        const float ang = (float)t * inv; float cs, sn; sincos_d(ang, cs, sn);
        if (j < 32) { rt[t * 32 + ii] = cs; rt[SEQ * 32 + t * 32 + ii] = sn; }
        else { rt[SEQ * 64 + t * 16 + ii] = cs; rt[SEQ * 64 + SEQ * 16 + t * 16 + ii] = sn; } }
    __syncthreads();
    {
        LAS float* cact = (LAS float*)(F.lds);
        LAS float* red = (LAS float*)(F.lds + 32768);
        float* mod = (float*)(ws + WS_MOD);
        for (int it = F.vcu; it < NL * 48; it += F.G) {
            const int l = it / 48, cg = it % 48, cj = F.tid & 127, kq = F.tid >> 7, col = cg * 128 + cj;
            float acc[32];
#pragma unroll
            for (int b = 0; b < 32; ++b) acc[b] = 0.f;
            for (int kc = 0; kc < 8; ++kc) {
                __syncthreads();
#pragma unroll
                for (int i = 0; i < 8; ++i) { const int idx = F.tid + 512 * i, b = idx & 31, kk = idx >> 5; const float v = P->c[b * 1024 + kc * 128 + kk];
                    cact[kk * 32 + b] = v * __builtin_amdgcn_rcpf(1.0f + ex2(-v * LOG2E)); }
                __syncthreads();
                for (int k2 = 0; k2 < 32; ++k2) { const int kk = kq * 32 + k2; const float w = P->w_ada[((size_t)l * 1024 + kc * 128 + kk) * 6144 + col];
#pragma unroll
                    for (int b4 = 0; b4 < 8; ++b4) { const f32x4 cv = *(const LAS f32x4*)(cact + kk * 32 + 4 * b4);
                        const f32x2 lo = (f32x2){cv[0], cv[1]} * w + (f32x2){acc[4 * b4], acc[4 * b4 + 1]}, hi = (f32x2){cv[2], cv[3]} * w + (f32x2){acc[4 * b4 + 2], acc[4 * b4 + 3]};
                        acc[4 * b4] = lo[0]; acc[4 * b4 + 1] = lo[1]; acc[4 * b4 + 2] = hi[0]; acc[4 * b4 + 3] = hi[1]; } }
            }
#pragma unroll
            for (int b = 0; b < 32; ++b) red[(kq * 32 + b) * 128 + cj] = acc[b];
            __syncthreads();
#pragma unroll
            for (int i = 0; i < 8; ++i) { const int idx = F.tid + 512 * i, b = idx >> 7, c2 = idx & 127;
                const float s = red[(0 * 32 + b) * 128 + c2] + red[(1 * 32 + b) * 128 + c2] + red[(2 * 32 + b) * 128 + c2] + red[(3 * 32 + b) * 128 + c2];
                mod[((size_t)l * 32 + b) * 6144 + cg * 128 + c2] = s + P->b_ada[l * 6144 + cg * 128 + c2]; }
            __syncthreads();
        }
    }
}

__device__ __forceinline__ void bf8_to_f(const u32x4 w, float (&o)[8]) {
    o[0] = __builtin_bit_cast(float, w.x << 16); o[1] = __builtin_bit_cast(float, w.x & 0xffff0000u); o[2] = __builtin_bit_cast(float, w.y << 16); o[3] = __builtin_bit_cast(float, w.y & 0xffff0000u);
    o[4] = __builtin_bit_cast(float, w.z << 16); o[5] = __builtin_bit_cast(float, w.z & 0xffff0000u); o[6] = __builtin_bit_cast(float, w.w << 16); o[7] = __builtin_bit_cast(float, w.w & 0xffff0000u);
}
template <int MODE>
__device__ __forceinline__ void norm_phase(KP Pq, Frame& F, int l) {
    F.tid = opaque_tid(F.wave0); F.lane = F.tid & 63; F.wave = opq_s(F.wave0); F.vcu = opq_s(F.vcu0); F.G = opq_s(F.G0); const KP P = kp_fresh(); (void)Pq;
    unsigned char* ws = P->ws;
    const float* mod = (const float*)(ws + WS_MOD);
    bf16* X = (bf16*)(ws + WS_X);
    unsigned char* H = (unsigned char*)(ws + WS_H);
    const unsigned char* SL = (const unsigned char*)(ws + WS_SLOT);
    const int gw = F.vcu * 8 + F.wave, NGW = F.G * 8, lane = F.lane;
    for (int tok0 = gw * 2; tok0 < T; tok0 += NGW * 2) {
        const int b = tok0 >> 11;
        float v[2][2][8];
#pragma unroll
        for (int tt = 0; tt < 2; ++tt)
#pragma unroll
            for (int j = 0; j < 2; ++j) { const size_t off = (size_t)(tok0 + tt) * DM + 8 * lane + 512 * j;
                if (MODE == 0) { const f32x4 a = *(const f32x4*)(P->x + off), c = *(const f32x4*)(P->x + off + 4);
                    v[tt][j][0] = a[0]; v[tt][j][1] = a[1]; v[tt][j][2] = a[2]; v[tt][j][3] = a[3]; v[tt][j][4] = c[0]; v[tt][j][5] = c[1]; v[tt][j][6] = c[2]; v[tt][j][7] = c[3]; }
                else bf8_to_f(*(const u32x4*)(X + off), v[tt][j]); }
        if (MODE == 1 || MODE == 2) {
            const float* g2 = mod + ((size_t)((MODE == 1 ? l - 1 : NL - 1) * 32 + b)) * 6144 + 5 * 1024;
#pragma unroll
            for (int j = 0; j < 2; ++j) {
                const f32x4 ga = *(const f32x4*)(g2 + 8 * lane + 512 * j), gb = *(const f32x4*)(g2 + 8 * lane + 512 * j + 4);
#pragma unroll
                for (int tt = 0; tt < 2; ++tt) {
                    u32x2 w[4];
#pragma unroll
                    for (int k = 0; k < 4; ++k) w[k] = *(const u32x2*)(SL + ((size_t)(tok0 + tt) * 4 + k) * DM + 8 * lane + 512 * j);
                    float sacc[8] = {0.f, 0.f, 0.f, 0.f, 0.f, 0.f, 0.f, 0.f};
#pragma unroll
                    for (int k = 0; k < 4; ++k) {
                        const f32x2 a0 = __builtin_amdgcn_cvt_pk_f32_fp8((int)w[k].x, false), a1 = __builtin_amdgcn_cvt_pk_f32_fp8((int)w[k].x, true), a2 = __builtin_amdgcn_cvt_pk_f32_fp8((int)w[k].y, false), a3 = __builtin_amdgcn_cvt_pk_f32_fp8((int)w[k].y, true);
                        sacc[0] += a0[0]; sacc[1] += a0[1]; sacc[2] += a1[0]; sacc[3] += a1[1]; sacc[4] += a2[0]; sacc[5] += a2[1]; sacc[6] += a3[0]; sacc[7] += a3[1]; }
#pragma unroll
                    for (int i = 0; i < 8; ++i) v[tt][j][i] += (i < 4 ? ga[i] : gb[i - 4]) * (sacc[i] * 0.03125f);
                    if (MODE == 1) { u32x4 o; o.x = pk2(v[tt][j][0], v[tt][j][1]); o.y = pk2(v[tt][j][2], v[tt][j][3]); o.z = pk2(v[tt][j][4], v[tt][j][5]); o.w = pk2(v[tt][j][6], v[tt][j][7]);
                        *(u32x4*)(X + (size_t)(tok0 + tt) * DM + 8 * lane + 512 * j) = o; bf8_to_f(o, v[tt][j]); }
                }
            }
        }
        float rstd[2];
#pragma unroll
        for (int tt = 0; tt < 2; ++tt) { float ss = 0.f;
#pragma unroll
            for (int j = 0; j < 2; ++j)
#pragma unroll
                for (int i = 0; i < 8; i += 2) ss += v[tt][j][i] * v[tt][j][i] + v[tt][j][i + 1] * v[tt][j][i + 1];
            rstd[tt] = __builtin_amdgcn_rsqf(wave_sum(ss) * (1.0f / DM) + 1e-6f); }
        if (MODE == 2) {
#pragma unroll
            for (int j = 0; j < 2; ++j) { const f32x4 ga = *(const f32x4*)(P->final_g + 8 * lane + 512 * j), gb = *(const f32x4*)(P->final_g + 8 * lane + 512 * j + 4);
#pragma unroll
                for (int tt = 0; tt < 2; ++tt) { float* o = P->out + (size_t)(tok0 + tt) * DM + 8 * lane + 512 * j;
                    *(f32x4*)o = (f32x4){v[tt][j][0], v[tt][j][1], v[tt][j][2], v[tt][j][3]} * rstd[tt] * ga; *(f32x4*)(o + 4) = (f32x4){v[tt][j][4], v[tt][j][5], v[tt][j][6], v[tt][j][7]} * rstd[tt] * gb; } }
        } else {
            const float* gn = P->norm1_g + l * DM;
            const float* mb = mod + ((size_t)(l * 32 + b)) * 6144;
#pragma unroll
            for (int j = 0; j < 2; ++j) {
                const int c0 = 8 * lane + 512 * j;
                float g8[8], sh8[8], sc8[8];
                { const f32x4 a = *(const f32x4*)(gn + c0), c = *(const f32x4*)(gn + c0 + 4), d = *(const f32x4*)(mb + c0), e = *(const f32x4*)(mb + c0 + 4), f = *(const f32x4*)(mb + 1024 + c0), g = *(const f32x4*)(mb + 1024 + c0 + 4);
#pragma unroll
                  for (int i = 0; i < 4; ++i) { g8[i] = a[i]; g8[4 + i] = c[i]; sh8[i] = d[i]; sh8[4 + i] = e[i]; sc8[i] = f[i] + 1.0f; sc8[4 + i] = g[i] + 1.0f; } }
#pragma unroll
                for (int tt = 0; tt < 2; ++tt) { float h[8];
#pragma unroll
                    for (int i = 0; i < 8; ++i) h[i] = (v[tt][j][i] * rstd[tt] * g8[i]) * sc8[i] + sh8[i];
                    u32x2 o; o.x = (unsigned)pg8::fp8x4(h[0], h[1], h[2], h[3]); o.y = (unsigned)pg8::fp8x4(h[4], h[5], h[6], h[7]);
                    *(u32x2*)(H + (size_t)(tok0 + tt) * DM + c0) = o; }
            }
        }
    }
}

template <bool DRY> __device__ __forceinline__ void prep_phase(KP Pq, Frame& F, int l) {
    F.tid = opaque_tid(F.wave0); F.lane = F.tid & 63; F.wave = opq_s(F.wave0); F.vcu = opq_s(F.vcu0); F.G = opq_s(F.G0); const KP P = kp_fresh(); (void)Pq;
    unsigned char* ws = P->ws;
    bf16* PR = (bf16*)(ws + WS_PROJ);
    bf16* KB = (bf16*)(ws + WS_KB); bf16* VBT = (bf16*)(ws + WS_VBT);
    float* LF = (float*)(ws + WS_LF);
    const float* rt = (const float*)(ws + WS_ROPE);
    const float* cos64 = rt, * sin64 = rt + SEQ * 32, * cos32 = rt + SEQ * 64, * sin32 = rt + SEQ * 64 + SEQ * 16;
    LAS bf16* ltile = (LAS bf16*)(F.lds);
    LAS bf16* vst = (LAS bf16*)(F.lds + 32768);
    const int tid = F.tid, lane = F.lane, wv = F.wave, fr = lane & 15, fq = lane >> 4;
    const int half = wv >> 2, p = wv & 1, th = (wv >> 1) & 1;
    bf16x8 wf[2][4];
    { const float* W = (half ? P->w_uv : P->w_uk) + l * 8192;
#pragma unroll
      for (int dd = 0; dd < 2; ++dd)
#pragma unroll
          for (int ks = 0; ks < 4; ++ks) { float f[8];
#pragma unroll
              for (int j = 0; j < 8; ++j) f[j] = W[(ks * 32 + fq * 8 + j) * 64 + (p + 2 * dd) * 16 + fr];
              u32x4 w; w.x = pk2(f[0], f[1]); w.y = pk2(f[2], f[3]); w.z = pk2(f[4], f[5]); w.w = pk2(f[6], f[7]); wf[dd][ks] = __builtin_bit_cast(bf16x8, w); } }
    const f32x2 kg = *(const f32x2*)(P->kv_norm_g + l * 128 + 2 * lane);
    for (int u = F.vcu; u < T / 64; u += F.G) {
        const int tok0 = u * 64, b = u >> 5, t0 = (u & 31) * 64;
        __syncthreads();
        {
            const int tl = tid >> 3, sub = tid & 7, t = t0 + tl;
            bf16* row = PR + (size_t)(tok0 + tl) * NP;
            {
                const f32x4 cs = *(const f32x4*)(cos64 + t * 32 + sub * 4), sn = *(const f32x4*)(sin64 + t * 32 + sub * 4);
                u32x2 a[4], c[4];
#pragma unroll
                for (int hh = 0; hh < 4; ++hh) { a[hh] = *(const u32x2*)(row + C_QB + hh * 64 + sub * 4); c[hh] = *(const u32x2*)(row + C_QB + hh * 64 + 32 + sub * 4); }
#pragma unroll
                for (int hh = 0; hh < 4; ++hh) {
                    const float x10 = bf2f(a[hh].x & 0xffffu), x11 = bf2f(a[hh].x >> 16), x12 = bf2f(a[hh].y & 0xffffu), x13 = bf2f(a[hh].y >> 16);
                    const float x20 = bf2f(c[hh].x & 0xffffu), x21 = bf2f(c[hh].x >> 16), x22 = bf2f(c[hh].y & 0xffffu), x23 = bf2f(c[hh].y >> 16);
                    u32x2 o1, o2;
                    o1.x = pk2(x10 * cs[0] - x20 * sn[0], x11 * cs[1] - x21 * sn[1]); o1.y = pk2(x12 * cs[2] - x22 * sn[2], x13 * cs[3] - x23 * sn[3]);
                    o2.x = pk2(x10 * sn[0] + x20 * cs[0], x11 * sn[1] + x21 * cs[1]); o2.y = pk2(x12 * sn[2] + x22 * cs[2], x13 * sn[3] + x23 * cs[3]);
                    if (!DRY) { *(u32x2*)(row + C_QB + hh * 64 + sub * 4) = o1; *(u32x2*)(row + C_QB + hh * 64 + 32 + sub * 4) = o2; }
                    else if (o1.x == 0x12345678u && o2.y == 0x9abcdef0u) LF[0] = 0.f;
                }
            }
            {
                const int ih = sub >> 1, i8 = (sub & 1) * 8;
                const f32x4 cs0 = *(const f32x4*)(cos32 + t * 16 + i8), cs1 = *(const f32x4*)(cos32 + t * 16 + i8 + 4), sn0 = *(const f32x4*)(sin32 + t * 16 + i8), sn1 = *(const f32x4*)(sin32 + t * 16 + i8 + 4);
                bf16* bq = row + C_QI + ih * 32 + i8; bf16* bk = row + C_KI + i8;
                const u32x4 qa = *(const u32x4*)bq, qc = *(const u32x4*)(bq + 16);
                u32x4 ka = qa, kc = qc;
                if (sub < 2) { ka = *(const u32x4*)bk; kc = *(const u32x4*)(bk + 16); }
#pragma unroll
                for (int which = 0; which < 2; ++which) {
                    float x1[8], x2[8]; bf8_to_f(which ? ka : qa, x1); bf8_to_f(which ? kc : qc, x2);
                    float o1[8], o2[8];
#pragma unroll
                    for (int i = 0; i < 8; ++i) { const float cc = (i < 4) ? cs0[i & 3] : cs1[i & 3], ss = (i < 4) ? sn0[i & 3] : sn1[i & 3]; o1[i] = x1[i] * cc - x2[i] * ss; o2[i] = x1[i] * ss + x2[i] * cc; }
                    u32x4 w1, w2; w1.x = pk2(o1[0], o1[1]); w1.y = pk2(o1[2], o1[3]); w1.z = pk2(o1[4], o1[5]); w1.w = pk2(o1[6], o1[7]);
                    w2.x = pk2(o2[0], o2[1]); w2.y = pk2(o2[2], o2[3]); w2.z = pk2(o2[4], o2[5]); w2.w = pk2(o2[6], o2[7]);
                    if (!DRY) { if (which == 0) { *(u32x4*)bq = w1; *(u32x4*)(bq + 16) = w2; } else if (sub < 2) { *(u32x4*)bk = w1; *(u32x4*)(bk + 16) = w2; } }
                    else if (w1.x == 0x12345678u && w2.y == 0x9abcdef0u) LF[0] = 0.f;
                }
            }
            if (sub == 2) {
                const u32x2 w = *(const u32x2*)(row + C_FA);
                const float fa[4] = {bf2f(w.x & 0xffffu), bf2f(w.x >> 16), bf2f(w.y & 0xffffu), bf2f(w.y >> 16)};
#pragma unroll
                for (int hh = 0; hh < 4; ++hh) { const float z = fa[hh] + P->b_forget[l * 4 + hh];
                    LF[((size_t)(b * 4 + hh)) * SEQ + t] = fminf(z, 0.f) - 0.6931471805599453f * lg2(1.0f + ex2(-fabsf(z) * LOG2E)); }
            }
        }
        {
            unsigned lw[8];
#pragma unroll
            for (int i = 0; i < 8; ++i) lw[i] = *(const unsigned*)(PR + (size_t)(tok0 + wv * 8 + i) * NP + C_LAT + 2 * lane);
#pragma unroll
            for (int i = 0; i < 8; ++i) { const float a0 = bf2f(lw[i] & 0xffffu), a1 = bf2f(lw[i] >> 16);
                const float rstd = __builtin_amdgcn_rsqf(wave_sum(a0 * a0 + a1 * a1) * (1.0f / 128.0f) + 1e-6f);
                *(LAS unsigned*)(ltile + (wv * 8 + i) * 136 + 2 * lane) = pk2(a0 * rstd * kg[0], a1 * rstd * kg[1]); }
        }
        __syncthreads();
        {
            f32x4 acc[2][2];
#pragma unroll
            for (int dd = 0; dd < 2; ++dd)
#pragma unroll
                for (int tt = 0; tt < 2; ++tt) acc[dd][tt] = zero4();
#pragma unroll
            for (int tt = 0; tt < 2; ++tt)
#pragma unroll
                for (int ks = 0; ks < 4; ++ks) { const bf16x8 bfr = *(const LAS bf16x8*)(ltile + ((2 * th + tt) * 16 + fr) * 136 + ks * 32 + fq * 8);
#pragma unroll
                    for (int dd = 0; dd < 2; ++dd) acc[dd][tt] = __builtin_amdgcn_mfma_f32_16x16x32_bf16(wf[dd][ks], bfr, acc[dd][tt], 0, 0, 0); }
#pragma unroll
            for (int tt = 0; tt < 2; ++tt) { const int tl = (2 * th + tt) * 16 + fr, t = t0 + tl;
                if (half == 0) {
                    const int d1 = p * 16 + fq * 4;
                    const f32x4 cs = *(const f32x4*)(cos64 + t * 32 + d1), sn = *(const f32x4*)(sin64 + t * 32 + d1);
                    const f32x4 x1 = acc[0][tt], x2 = acc[1][tt];
                    const f32x4 o1 = x1 * cs - x2 * sn, o2 = x1 * sn + x2 * cs;
                    u32x2 w1, w2; w1.x = pk2(o1[0], o1[1]); w1.y = pk2(o1[2], o1[3]); w2.x = pk2(o2[0], o2[1]); w2.y = pk2(o2[2], o2[3]);
                    *(u32x2*)(KB + (size_t)(tok0 + tl) * 64 + d1) = w1; *(u32x2*)(KB + (size_t)(tok0 + tl) * 64 + 32 + d1) = w2;
                } else {
#pragma unroll
                    for (int dd = 0; dd < 2; ++dd)
#pragma unroll
                        for (int j = 0; j < 4; ++j) vst[((p + 2 * dd) * 16 + fq * 4 + j) * 72 + tl] = (bf16)f2bf(acc[dd][tt][j]);
                }
            }
        }
        __syncthreads();
        { const int d = tid >> 3, oct = tid & 7;
          *(u32x4*)(VBT + ((size_t)(b * 64 + d)) * SEQ + t0 + oct * 8) = *(const LAS u32x4*)(vst + d * 72 + oct * 8); }
    }
    __syncthreads();
}

__device__ __forceinline__ void idx_scores(const bf16x8 (&kif)[2], const bf16x8 (&qif)[4], const float (&wq)[4], unsigned (&sk)[8]) {
#pragma unroll
    for (int t = 0; t < 2; ++t) {
        const f32x4 z = {0.f, 0.f, 0.f, 0.f};
        const f32x4 a0 = __builtin_amdgcn_mfma_f32_16x16x32_bf16(kif[t], qif[0], z, 0, 0, 0);
        const f32x4 a1 = __builtin_amdgcn_mfma_f32_16x16x32_bf16(kif[t], qif[1], z, 0, 0, 0);
        const f32x4 a2 = __builtin_amdgcn_mfma_f32_16x16x32_bf16(kif[t], qif[2], z, 0, 0, 0);
        const f32x4 a3 = __builtin_amdgcn_mfma_f32_16x16x32_bf16(kif[t], qif[3], z, 0, 0, 0);
#pragma unroll
        for (int j = 0; j < 4; ++j) {
            const float r0 = fmaxf(a0[j], 0.f), r1 = fmaxf(a1[j], 0.f), r2 = fmaxf(a2[j], 0.f), r3 = fmaxf(a3[j], 0.f);
            float v = wq[0] * r0; v = __builtin_fmaf(wq[1], r1, v); v = __builtin_fmaf(wq[2], r2, v); v = __builtin_fmaf(wq[3], r3, v);
            unsigned u = __builtin_bit_cast(unsigned, v); u = (u == 0x80000000u) ? 0u : u;
            sk[t * 4 + j] = (u & 0x80000000u) ? ~u : (u | 0x80000000u);
        }
    }
}

__device__ __forceinline__ unsigned wave_total(unsigned c) {
    c += (unsigned)__builtin_amdgcn_update_dpp(0, (int)c, 0x111, 0xf, 0xf, true);
    c += (unsigned)__builtin_amdgcn_update_dpp(0, (int)c, 0x112, 0xf, 0xf, true);
    c += (unsigned)__builtin_amdgcn_update_dpp(0, (int)c, 0x114, 0xf, 0xf, true);
    c += (unsigned)__builtin_amdgcn_update_dpp(0, (int)c, 0x118, 0xf, 0xf, true);
    return (unsigned)__builtin_amdgcn_readlane((int)c, 15) + (unsigned)__builtin_amdgcn_readlane((int)c, 31) + (unsigned)__builtin_amdgcn_readlane((int)c, 47) + (unsigned)__builtin_amdgcn_readlane((int)c, 63);
}
__device__ __forceinline__ unsigned bfi32(unsigned m, unsigned a, unsigned b) { return (m & a) | (~m & b); }
__device__ __forceinline__ void bit_transpose32(unsigned (&a)[32]) {
#pragma unroll
    for (int i = 0; i < 32; ++i) if (!(i & 16)) { const unsigned lo = a[i], hi = a[i + 16]; a[i] = __builtin_amdgcn_perm(hi, lo, 0x05040100u); a[i + 16] = __builtin_amdgcn_perm(hi, lo, 0x07060302u); }
#pragma unroll
    for (int i = 0; i < 32; ++i) if (!(i & 8)) { const unsigned lo = a[i], hi = a[i + 8]; a[i] = __builtin_amdgcn_perm(hi, lo, 0x06020400u); a[i + 8] = __builtin_amdgcn_perm(hi, lo, 0x07030501u); }
#pragma unroll
    for (int i = 0; i < 32; ++i) if (!(i & 4)) { const unsigned lo = a[i], hi = a[i + 4]; a[i] = bfi32(0x0f0f0f0fu, lo, hi << 4); a[i + 4] = bfi32(0x0f0f0f0fu, lo >> 4, hi); }
#pragma unroll
    for (int i = 0; i < 32; ++i) if (!(i & 2)) { const unsigned lo = a[i], hi = a[i + 2]; a[i] = bfi32(0x33333333u, lo, hi << 2); a[i + 2] = bfi32(0x33333333u, lo >> 2, hi); }
#pragma unroll
    for (int i = 0; i < 32; ++i) if (!(i & 1)) { const unsigned lo = a[i], hi = a[i + 1]; a[i] = bfi32(0x55555555u, lo, hi << 1); a[i + 1] = bfi32(0x55555555u, lo >> 1, hi); }
}
__device__ __forceinline__ unsigned low_n_set(unsigned eq, int n) {
    unsigned I = 0u;
#pragma unroll
    for (int bit = 16; bit >= 1; bit >>= 1) { const unsigned cand = I + (unsigned)bit; if ((int)__builtin_popcount(eq & ((1u << cand) - 1u)) < n) I = cand; }
    const unsigned r = eq & (I >= 31u ? 0xffffffffu : ((2u << I) - 1u));
    return (n <= 0) ? 0u : (n >= (int)__builtin_popcount(eq)) ? eq : r;
}
__device__ __forceinline__ unsigned tie_take(unsigned eq, unsigned need, int lane) {
    const unsigned e = (unsigned)__builtin_popcount(eq);
    unsigned c = e;
    c += (unsigned)__builtin_amdgcn_update_dpp(0, (int)c, 0x111, 0xf, 0xf, true);
    c += (unsigned)__builtin_amdgcn_update_dpp(0, (int)c, 0x112, 0xf, 0xf, true);
    c += (unsigned)__builtin_amdgcn_update_dpp(0, (int)c, 0x114, 0xf, 0xf, true);
    c += (unsigned)__builtin_amdgcn_update_dpp(0, (int)c, 0x118, 0xf, 0xf, true);
    const unsigned t0 = (unsigned)__builtin_amdgcn_readlane((int)c, 15), t1 = (unsigned)__builtin_amdgcn_readlane((int)c, 31), t2 = (unsigned)__builtin_amdgcn_readlane((int)c, 47);
    const unsigned pre = c - e + (lane >= 16 ? t0 : 0u) + (lane >= 32 ? t1 : 0u) + (lane >= 48 ? t2 : 0u);
    return low_n_set(eq, (int)need - (int)pre);
}
template <int VAR> __device__ __forceinline__ void sel_phase(KP Pq, Frame& F) {
    F.tid = opaque_tid(F.wave0); F.lane = F.tid & 63; F.wave = opq_s(F.wave0); F.vcu = opq_s(F.vcu0); F.G = opq_s(F.G0); const KP P = kp_fresh(); (void)Pq;
    unsigned char* ws = P->ws;
    const bf16* PR = (const bf16*)(ws + WS_PROJ);
    unsigned long long* MASK = (unsigned long long*)(ws + WS_MASK);
    LAS unsigned* keys = (LAS unsigned*)(F.lds);
    constexpr int KST = 2052;
    const int lane = F.lane, fr = lane & 15, fq = lane >> 4, wv = F.wave;
    bf16x8 pq[4], pk[2]; unsigned pw[2];
    auto sel_fetch = [&](int u2) {
        const int c2 = 31 - (u2 >> 7), b2 = (u2 >> 2) & 31, q2 = u2 & 3;
        const bf16* qr = PR + ((size_t)b2 * SEQ + c2 * 64 + q2 * 16 + fr) * NP;
#pragma unroll
        for (int ih = 0; ih < 4; ++ih) pq[ih] = *(const bf16x8*)(qr + C_QI + ih * 32 + fq * 8);
        pw[0] = *(const unsigned*)(qr + C_WI); pw[1] = *(const unsigned*)(qr + C_WI + 2);
        const bf16* kb2 = PR + ((size_t)b2 * SEQ + (fr >> 2) * 8 + (fr & 3)) * NP + C_KI + fq * 8;
        pk[0] = *(const bf16x8*)(kb2 + (size_t)(wv * 32) * NP); pk[1] = *(const bf16x8*)(kb2 + (size_t)(wv * 32 + 4) * NP);
    };
    if (F.vcu < NB * 28 * 4) sel_fetch(F.vcu);
    for (int u = F.vcu; u < NB * 28 * 4; u += F.G) {
        const int c = 31 - (u >> 7), b = (u >> 2) & 31, qt0 = u & 3;
        const int L = (c + 1) * 64, nsteps = L / 32, nr = c + 1;
        const size_t rowb = (size_t)b * SEQ;
        for (int qt = qt0; qt == qt0; ++qt) {
            __syncthreads();
            {
                bf16x8 qif[4]; float wq[4];
#pragma unroll
                for (int ih = 0; ih < 4; ++ih) { qif[ih] = pq[ih]; wq[ih] = bf2f((pw[ih >> 1] >> (16 * (ih & 1))) & 0xffffu) * (0.5f * RS32); }
                const bf16* kbase = PR + (rowb + (fr >> 2) * 8 + (fr & 3)) * NP + C_KI + fq * 8;
                bf16x8 kif[2], kin[2];
                int s = wv;
                kif[0] = pk[0]; kif[1] = pk[1];
                for (; s < (VAR == 2 ? 0 : nsteps); s += 8) {
                    const int sn = s + 8;
                    if (sn < nsteps) { kin[0] = *(const bf16x8*)(kbase + (size_t)(sn * 32) * NP); kin[1] = *(const bf16x8*)(kbase + (size_t)(sn * 32 + 4) * NP); }
                    unsigned sk[8]; idx_scores(kif, qif, wq, sk);
                    LAS unsigned* dst = keys + fr * KST + s * 32; const int x = (s >> 1) & 7;
                    *(LAS u32x4*)(dst + 4 * ((2 * fq) ^ x)) = (u32x4){sk[0], sk[1], sk[2], sk[3]}; *(LAS u32x4*)(dst + 4 * ((2 * fq + 1) ^ x)) = (u32x4){sk[4], sk[5], sk[6], sk[7]};
                    kif[0] = kin[0]; kif[1] = kin[1];
                }
            }
            __syncthreads();
            if (u + F.G < NB * 28 * 4) sel_fetch(u + F.G);
            {
                unsigned pA[32], pB[32];
                const int sw = (lane >> 1) & 7;
                const LAS unsigned* krA = keys + (wv * 2) * KST + 32 * lane; const LAS unsigned* krB = krA + KST;
#pragma unroll
                for (int cc = 0; cc < 8; ++cc) { const u32x4 v = *(const LAS u32x4*)(krA + 4 * (cc ^ sw)); pA[4 * cc] = v.x; pA[4 * cc + 1] = v.y; pA[4 * cc + 2] = v.z; pA[4 * cc + 3] = v.w; }
#pragma unroll
                for (int cc = 0; cc < 8; ++cc) { const u32x4 v = *(const LAS u32x4*)(krB + 4 * (cc ^ sw)); pB[4 * cc] = v.x; pB[4 * cc + 1] = v.y; pB[4 * cc + 2] = v.z; pB[4 * cc + 3] = v.w; }
                bit_transpose32(pA); bit_transpose32(pB);
                unsigned eqA = (lane < nsteps) ? 0xffffffffu : 0u, eqB = eqA, gtA = 0u, gtB = 0u;
                unsigned GA = 0u, GB = 0u;
#define SEL_BIT(b) if (!done) { \
                    const unsigned xA = eqA & pA[b], xB = eqB & pB[b]; \
                    const unsigned tot = wave_total((unsigned)__builtin_popcount(xA) | ((unsigned)__builtin_popcount(xB) << 16)); \
                    const unsigned nA = GA + (tot & 0xffffu), nB = GB + (tot >> 16); \
                    const unsigned kA = (nA > 256u) ? 0u : 0xffffffffu, kB = (nB > 256u) ? 0u : 0xffffffffu; \
                    gtA |= xA & kA; eqA = xA ^ (eqA & kA); GA = (nA > 256u) ? GA : nA; \
                    gtB |= xB & kB; eqB = xB ^ (eqB & kB); GB = (nB > 256u) ? GB : nB; \
                    if (((b) & 1) == 0) done = (GA == 256u) && (GB == 256u); }
                bool done = false;
                SEL_BIT(31) SEL_BIT(30) SEL_BIT(29) SEL_BIT(28) SEL_BIT(27) SEL_BIT(26) SEL_BIT(25) SEL_BIT(24) SEL_BIT(23) SEL_BIT(22) SEL_BIT(21) SEL_BIT(20) SEL_BIT(19) SEL_BIT(18) SEL_BIT(17) SEL_BIT(16)
                SEL_BIT(15) SEL_BIT(14) SEL_BIT(13) SEL_BIT(12) SEL_BIT(11) SEL_BIT(10) SEL_BIT(9) SEL_BIT(8) SEL_BIT(7) SEL_BIT(6) SEL_BIT(5) SEL_BIT(4) SEL_BIT(3) SEL_BIT(2) SEL_BIT(1) SEL_BIT(0)
#undef SEL_BIT
                const bool exA = (GA == 256u), exB = (GB == 256u);
                if (!exA) gtA |= tie_take(eqA, 256u - GA, lane);
                if (!exB) gtB |= tie_take(eqB, 256u - GB, lane);
                unsigned* M32 = (unsigned*)MASK + (rowb + c * 64 + qt * 16 + wv * 2) * 64 + lane;
                { u32x4 q0 = __builtin_bit_cast(u32x4, pq[0]), q1 = __builtin_bit_cast(u32x4, pq[1]), q2 = __builtin_bit_cast(u32x4, pq[2]), q3 = __builtin_bit_cast(u32x4, pq[3]), k0 = __builtin_bit_cast(u32x4, pk[0]), k1 = __builtin_bit_cast(u32x4, pk[1]);
                  asm volatile("" : "+v"(q0), "+v"(q1), "+v"(q2), "+v"(q3), "+v"(k0), "+v"(k1), "+v"(pw[0]), "+v"(pw[1]));
                  pq[0] = __builtin_bit_cast(bf16x8, q0); pq[1] = __builtin_bit_cast(bf16x8, q1); pq[2] = __builtin_bit_cast(bf16x8, q2); pq[3] = __builtin_bit_cast(bf16x8, q3); pk[0] = __builtin_bit_cast(bf16x8, k0); pk[1] = __builtin_bit_cast(bf16x8, k1); }
                M32[0] = gtA; M32[64] = gtB;
            }
        }
    }
    __syncthreads();
}

constexpr int ATT_KBUF = 0, ATT_VBUF = 16384, ATT_NF = 32768, ATT_FLAG = 40960, ATT_RELT = 49152, RELW = 768, RELO = 640;
__device__ __forceinline__ int kswz(int row) { return ((row >> 3) & 3) * 2 + ((row >> 1) & 1); }
__device__ __forceinline__ int vswz(int row) { return (row >> 1) & 7; }
struct AttnPre { bf16x8 qf[2][2]; u32x4 k0, v0, k1, v1; };
template <int KIND>
__device__ __forceinline__ void attn_fetch(unsigned char* ws, int b, int h, int blk, int tid, AttnPre& R) {
    const int lane = tid & 63, wv = __builtin_amdgcn_readfirstlane(tid >> 6), fr = lane & 15, fq = lane >> 4;
    const size_t rowb = (size_t)b * SEQ;
    constexpr int QCOL = (KIND == 0) ? C_QA : (KIND == 1) ? C_QB : (KIND == 2) ? C_QC : C_QD;
    constexpr int KCOL = (KIND == 0) ? C_KA : (KIND == 2) ? C_KC : C_KD;
    constexpr int VG = (KIND == 0) ? 0 : (KIND == 2) ? 1 : 2;
    constexpr unsigned KPB = (KIND == 1) ? 128u : (unsigned)NP * 2u;
    const char* PRb = (const char*)(ws + WS_PROJ) + rowb * NP * 2;
    const int qw = (KIND == 1) ? blk * 64 + (wv & 3) * 16 : blk * 256 + wv * 32;
    const int hw = (KIND == 1) ? (wv >> 2) * 2 : h;
#pragma unroll
    for (int qi = 0; qi < 2; ++qi)
#pragma unroll
        for (int ks = 0; ks < 2; ++ks) {
            if (KIND == 1) R.qf[qi][ks] = *(const bf16x8*)(PRb + (unsigned)((qw + fr) * NP + QCOL + (hw + qi) * 64 + ks * 32 + fq * 8) * 2u);
            else R.qf[qi][ks] = *(const bf16x8*)(PRb + (unsigned)((qw + 16 * qi + fr) * NP + QCOL + hw * 64 + ks * 32 + fq * 8) * 2u);
        }
    const char* Kb; const char* Vtb;
    if (KIND == 1) { Kb = (const char*)(ws + WS_KB) + rowb * 128; Vtb = (const char*)(ws + WS_VBT) + (size_t)b * 64 * SEQ * 2; }
    else { Kb = PRb + (KCOL + h * 64) * 2; Vtb = (const char*)(ws + WS_VT) + ((size_t)((VG * NB + b) * 4 + h) * 64) * SEQ * 2; }
    const int srow = tid >> 3, ssl = tid & 7;
    const unsigned kgoff = (unsigned)srow * KPB + (unsigned)((ssl ^ kswz(srow)) * 16);
    const unsigned vgoff = (unsigned)(srow * SEQ * 2) + (unsigned)((ssl ^ vswz(srow)) * 16);
    int s_first, s_last, s_dir;
    if (KIND == 0) { s_first = 0; s_last = blk * 4 + 3; s_dir = 1; }
    else if (KIND == 1) { s_first = 0; s_last = blk; s_dir = 1; }
    else if (KIND == 2) { s_first = blk * 4 + 3; s_last = 0; s_dir = -1; }
    else { s_first = blk * 4 - 8 < 0 ? 0 : blk * 4 - 8; s_last = blk * 4 + 3; s_dir = 1; }
    R.k0 = *(const u32x4*)(Kb + (size_t)(s_first * 64) * KPB + kgoff); R.v0 = *(const u32x4*)(Vtb + (size_t)(s_first * 128) + vgoff);
    R.k1 = R.k0; R.v1 = R.v0;
    if (s_first != s_last) { R.k1 = *(const u32x4*)(Kb + (size_t)((s_first + s_dir) * 64) * KPB + kgoff); R.v1 = *(const u32x4*)(Vtb + (size_t)((s_first + s_dir) * 128) + vgoff); }
}
template <int KIND>
__device__ __forceinline__ void attn_wg(unsigned char* ws, int b, int h, int blk, LAS unsigned char* lds, int wave_s, AttnPre& pre, bool hn, int nb, int nh, int nblk) {
    const int tid = opaque_tid(wave_s), lane = tid & 63, wv = __builtin_amdgcn_readfirstlane(tid >> 6);
    const int fr = lane & 15, fq = lane >> 4;
    const size_t rowb = (size_t)b * SEQ;
    constexpr int QCOL = (KIND == 0) ? C_QA : (KIND == 1) ? C_QB : (KIND == 2) ? C_QC : C_QD;
    constexpr int KCOL = (KIND == 0) ? C_KA : (KIND == 2) ? C_KC : C_KD;
    constexpr int YCOL = (KIND == 0) ? 0 : (KIND == 1) ? 256 : (KIND == 2) ? 512 : 768;
    constexpr int VG = (KIND == 0) ? 0 : (KIND == 2) ? 1 : 2;
    constexpr unsigned KPB = (KIND == 1) ? 128u : (unsigned)NP * 2u;
    const char* PRb = (const char*)(ws + WS_PROJ) + rowb * NP * 2;
    const int qw = (KIND == 1) ? blk * 64 + (wv & 3) * 16 : blk * 256 + wv * 32;
    const int hw = (KIND == 1) ? (wv >> 2) * 2 : h;
    bf16x8 qf[2][2];
#pragma unroll
    for (int qi = 0; qi < 2; ++qi)
#pragma unroll
        for (int ks = 0; ks < 2; ++ks) qf[qi][ks] = pre.qf[qi][ks];
    const char* Kb; const char* Vtb;
    if (KIND == 1) { Kb = (const char*)(ws + WS_KB) + rowb * 128; Vtb = (const char*)(ws + WS_VBT) + (size_t)b * 64 * SEQ * 2; }
    else { Kb = PRb + (KCOL + h * 64) * 2; Vtb = (const char*)(ws + WS_VT) + ((size_t)((VG * NB + b) * 4 + h) * 64) * SEQ * 2; }
    const int srow = tid >> 3, ssl = tid & 7;
    const unsigned kgoff = (unsigned)srow * KPB + (unsigned)((ssl ^ kswz(srow)) * 16);
    const unsigned vgoff = (unsigned)(srow * SEQ * 2) + (unsigned)((ssl ^ vswz(srow)) * 16);
    LAS unsigned char* kst = lds + ATT_KBUF + tid * 16; LAS unsigned char* vst = lds + ATT_VBUF + tid * 16;
    const int krow0 = (fr >> 2) * 8 + (fr & 3);
    const int kro0 = krow0 * 128 + ((fq ^ kswz(krow0)) * 16), kro1 = krow0 * 128 + (((4 + fq) ^ kswz(krow0)) * 16);
    const int vro0 = fr * 128 + ((fq ^ vswz(fr)) * 16), vro1 = fr * 128 + (((4 + fq) ^ vswz(fr)) * 16);
    const unsigned char* mrow = (const unsigned char*)(ws + WS_MASK) + (rowb + qw + fr) * 256;
    const bool sel_all = (KIND != 1) || (blk < 4);
    LAS float* nf = (LAS float*)(lds + ATT_NF);
    const LAS float* relt = (const LAS float*)(lds + ATT_RELT);
    LAS unsigned* flags = (LAS unsigned*)(lds + ATT_FLAG);
    int s_first, s_last, s_dir;
    if (KIND == 0) { s_first = 0; s_last = blk * 4 + 3; s_dir = 1; }
    else if (KIND == 1) { s_first = 0; s_last = blk; s_dir = 1; }
    else if (KIND == 2) { s_first = blk * 4 + 3; s_last = 0; s_dir = -1; }
    else { s_first = blk * 4 - 8 < 0 ? 0 : blk * 4 - 8; s_last = blk * 4 + 3; s_dir = 1; }
    u32x4 kreg = pre.k1, vreg = pre.v1;
    __syncthreads();
    { const u32x4 k0 = pre.k0, v0 = pre.v0; *(LAS u32x4*)(kst) = k0; *(LAS u32x4*)(vst) = v0; }
    bool fetched = false;
    f32x4 O[2][4];
#pragma unroll
    for (int qi = 0; qi < 2; ++qi)
#pragma unroll
        for (int dt = 0; dt < 4; ++dt) O[qi][dt] = zero4();
    float NINF = -INFINITY; unsigned ONE2 = 0x3f803f80u; asm volatile("" : "+v"(NINF), "+v"(ONE2));
    float mrun[2], mref[2]; f32x4 Ol[2];
#pragma unroll
    for (int qi = 0; qi < 2; ++qi) { mrun[qi] = (KIND == 2) ? 0.f : NINF; mref[qi] = 0.f; Ol[qi] = zero4(); }
    bf16x8 ones8;
    { u32x4 o1; o1.x = ONE2; o1.y = ONE2; o1.z = ONE2; o1.w = ONE2; ones8 = __builtin_bit_cast(bf16x8, o1); }
    const bool hi1 = (fq & 1) == 0, hi2 = (fq & 2) == 0;
    bool wdone = false;
    __syncthreads();
    int s = s_first, cur = 0;
    for (;;) {
        const bool has_next = (s != s_last);
        if (!has_next && hn) { attn_fetch<(KIND + 1) & 3>(ws, nb, nh, nblk, tid, pre); fetched = true; }
        unsigned long long mbits = ~0ull;
        if (KIND == 1 && !sel_all) mbits = *(const unsigned long long*)(mrow + s * 8);
        const LAS unsigned char* kbuf = lds + ATT_KBUF + cur * 8192; const LAS unsigned char* vbuf = lds + ATT_VBUF + cur * 8192;
#pragma unroll
        for (int jj2 = 0; jj2 < 2; ++jj2) {
            const int j = (KIND == 2) ? 1 - jj2 : jj2;
            const int kb0 = s * 64 + j * 32;
            bool active;
            if (KIND == 0) active = (kb0 <= qw + 31);
            else if (KIND == 1) active = true;
            else if (KIND == 2) active = (kb0 <= qw + 30) && !wdone;
            else { const int c0 = qw & ~63; active = (kb0 >= c0 - 512) && (kb0 < c0 + 64); }
            if (active) {
                bf16x8 kf[2][2], vf[4];
#pragma unroll
                for (int t = 0; t < 2; ++t) { kf[t][0] = *(const LAS bf16x8*)(kbuf + j * 4096 + t * 512 + kro0); kf[t][1] = *(const LAS bf16x8*)(kbuf + j * 4096 + t * 512 + kro1); }
#pragma unroll
                for (int dt = 0; dt < 4; ++dt) vf[dt] = *(const LAS bf16x8*)(vbuf + dt * 2048 + (j ? vro1 : vro0));
                const unsigned selmask = (unsigned)(mbits >> (j * 32 + fq * 8)) & 0xffu;
                unsigned pmask[4];
                if (KIND == 1) {
#pragma unroll
                    for (int i = 0; i < 4; ++i) { const unsigned lo = (unsigned)((int)(selmask << (31 - 2 * i)) >> 31), hi = (unsigned)((int)(selmask << (30 - 2 * i)) >> 31); pmask[i] = bfi32(0x0000ffffu, lo, hi); }
                }
                float bias[8];
                if (KIND == 0) { const f32x4 b0 = *(const LAS f32x4*)(nf + kb0 + fq * 8), b1 = *(const LAS f32x4*)(nf + kb0 + fq * 8 + 4);
#pragma unroll
                    for (int jx = 0; jx < 4; ++jx) { bias[jx] = b0[jx]; bias[4 + jx] = b1[jx]; } }
                const bool diag = (KIND == 0 || KIND == 2) && (kb0 + 31 >= qw);
#pragma unroll
                for (int qi = 0; qi < 2; ++qi) {
                    f32x4 st[2];
#pragma unroll
                    for (int t = 0; t < 2; ++t) { st[t] = __builtin_amdgcn_mfma_f32_16x16x32_bf16(kf[t][0], qf[qi][0], (f32x4){0.f, 0.f, 0.f, 0.f}, 0, 0, 0);
                        st[t] = __builtin_amdgcn_mfma_f32_16x16x32_bf16(kf[t][1], qf[qi][1], st[t], 0, 0, 0); }
                    const int q = (KIND == 1) ? (qw + fr) : (qw + 16 * qi + fr);
                    bf16x8 pb;
                    if (KIND == 2) {
                        float w[8], sg[8], qv[8];
                        const float carry = mrun[qi];
#pragma unroll
                        for (int jj = 0; jj < 8; ++jj) { const bool valid = !diag || (kb0 + fq * 8 + jj < q);
                            const float a = ex2(fminf(st[jj >> 2][jj & 3] * (-SC2), 120.0f));
                            const float s1 = __builtin_amdgcn_rcpf(1.0f + a);
                            sg[jj] = valid ? s1 : 0.f; qv[jj] = valid ? a * s1 : 1.0f; }
                        float suf[8]; suf[7] = 1.0f;
#pragma unroll
                        for (int jj = 6; jj >= 0; --jj) suf[jj] = suf[jj + 1] * qv[jj + 1];
                        const float tot = lg2(suf[0] * qv[0]);
                        const float t1 = xor16_f(tot, lane), t2 = xor32_f(tot, lane), t3 = xor16_f(t2, lane);
                        const float hi = (hi1 ? t1 : 0.f) + (hi2 ? t2 : 0.f) + (hi2 ? t3 : 0.f);
                        const float eb = ex2(carry + hi);
#pragma unroll
                        for (int jj = 0; jj < 8; ++jj) w[jj] = (sg[jj] * suf[jj]) * eb;
                        mrun[qi] = carry + ((tot + t1) + (t2 + t3));
                        u32x4 pw; pw.x = pk2(w[0], w[1]); pw.y = pk2(w[2], w[3]); pw.z = pk2(w[4], w[5]); pw.w = pk2(w[6], w[7]);
                        pb = __builtin_bit_cast(bf16x8, pw);
                    } else {
                        f32x2 xv[4];
                        const f32x2 r0 = {st[0][0], st[0][1]}, r1 = {st[0][2], st[0][3]}, r2 = {st[1][0], st[1][1]}, r3 = {st[1][2], st[1][3]};
                        const bool farb = (KIND == 3) && (kb0 + 31 + 128 <= qw);
                        const bool rawp = (KIND == 1) || farb;
                        const float cb = farb ? relt[h * RELW] : 0.f;
                        float p[8];
                        if (rawp) {
                            const float ms0 = (KIND == 3) ? mref[qi] - cb : mref[qi];
                            xv[0] = r0 * SC2 - ms0; xv[1] = r1 * SC2 - ms0; xv[2] = r2 * SC2 - ms0; xv[3] = r3 * SC2 - ms0;
                            const float dmx = max3f(max3f(xv[0][0], xv[0][1], xv[1][0]), max3f(xv[1][1], xv[2][0], xv[2][1]), max3f(xv[3][0], xv[3][1], xv[3][1]));
                            if (__any(dmx > ((mrun[qi] == NINF) ? NINF : 16.0f))) {
                                const float mx = max_x16x32(dmx + mref[qi]);
                                const float mnew = fmaxf(mrun[qi], mx);
                                const float mns = (mnew == NINF) ? 0.f : mnew;
                                const float alpha = ex2(mrun[qi] - mns);
                                const float dm = mns - mref[qi];
                                xv[0] = xv[0] - dm; xv[1] = xv[1] - dm; xv[2] = xv[2] - dm; xv[3] = xv[3] - dm;
                                mrun[qi] = mnew; mref[qi] = mns; Ol[qi] = Ol[qi] * alpha;
#pragma unroll
                                for (int dt = 0; dt < 4; ++dt) O[qi][dt] = O[qi][dt] * alpha;
                            }
#pragma unroll
                            for (int i = 0; i < 4; ++i) { p[2 * i] = ex2(xv[i][0]); p[2 * i + 1] = ex2(xv[i][1]); }
                        } else {
                            if (KIND == 0) {
                                xv[0] = r0 * SC2 + (f32x2){bias[0], bias[1]}; xv[1] = r1 * SC2 + (f32x2){bias[2], bias[3]}; xv[2] = r2 * SC2 + (f32x2){bias[4], bias[5]}; xv[3] = r3 * SC2 + (f32x2){bias[6], bias[7]};
                                if (diag) {
#pragma unroll
                                    for (int jj = 0; jj < 8; ++jj) if (kb0 + fq * 8 + jj > q) xv[jj >> 1][jj & 1] = NINF;
                                }
                            } else {
                                float bt[8];
#pragma unroll
                                for (int jj = 0; jj < 8; ++jj) bt[jj] = relt[h * RELW + RELO + (kb0 + fq * 8 - q) + jj];
                                xv[0] = r0 * SC2 + (f32x2){bt[0], bt[1]}; xv[1] = r1 * SC2 + (f32x2){bt[2], bt[3]}; xv[2] = r2 * SC2 + (f32x2){bt[4], bt[5]}; xv[3] = r3 * SC2 + (f32x2){bt[6], bt[7]};
                            }
                            const float mxl = max3f(max3f(xv[0][0], xv[0][1], xv[1][0]), max3f(xv[1][1], xv[2][0], xv[2][1]), max3f(xv[3][0], xv[3][1], xv[3][1]));
                            if (__any(mxl > mrun[qi] + ((KIND == 0) ? 96.0f : 16.0f))) {
                                const float mx = max_x16x32(mxl);
                                const float mnew = fmaxf(mrun[qi], mx);
                                const float mns = (mnew == NINF) ? 0.f : mnew;
                                const float alpha = ex2(mrun[qi] - mns);
                                mrun[qi] = mnew; mref[qi] = mns; Ol[qi] = Ol[qi] * alpha;
#pragma unroll
                                for (int dt = 0; dt < 4; ++dt) O[qi][dt] = O[qi][dt] * alpha;
                            }
                            const float msafe = mref[qi];
#pragma unroll
                            for (int i = 0; i < 4; ++i) { const f32x2 d = xv[i] - msafe; p[2 * i] = ex2(d[0]); p[2 * i + 1] = ex2(d[1]); }
                        }
                        u32x4 pw; pw.x = pk2(p[0], p[1]); pw.y = pk2(p[2], p[3]); pw.z = pk2(p[4], p[5]); pw.w = pk2(p[6], p[7]);
                        if (KIND == 1) { pw.x &= pmask[0]; pw.y &= pmask[1]; pw.z &= pmask[2]; pw.w &= pmask[3]; }
                        pb = __builtin_bit_cast(bf16x8, pw);
                        Ol[qi] = __builtin_amdgcn_mfma_f32_16x16x32_bf16(ones8, pb, Ol[qi], 0, 0, 0);
                    }
#pragma unroll
                    for (int dt = 0; dt < 4; ++dt) O[qi][dt] = __builtin_amdgcn_mfma_f32_16x16x32_bf16(vf[dt], pb, O[qi][dt], 0, 0, 0);
                }
                if (KIND == 2) { const bool dn = (mrun[0] < -151.f) && (mrun[1] < -151.f); if (__all(dn)) wdone = true; }
            }
        }
        if (!has_next) break;
        if (KIND == 2) { if (lane == 0) flags[cur * 8 + wv] = wdone ? 1u : 0u; }
        *(LAS u32x4*)(kst + (cur ^ 1) * 8192) = kreg; *(LAS u32x4*)(vst + (cur ^ 1) * 8192) = vreg;
        if (s + s_dir != s_last) { kreg = *(const u32x4*)(Kb + (size_t)((s + 2 * s_dir) * 64) * KPB + kgoff); vreg = *(const u32x4*)(Vtb + (size_t)((s + 2 * s_dir) * 128) + vgoff); }
        __syncthreads();
        if (KIND == 2) {
            const unsigned f = flags[cur * 8 + (lane & 7)];
            if (__all(f != 0u)) break;
        }
        s += s_dir; cur ^= 1;
    }
    if (hn && !fetched) attn_fetch<(KIND + 1) & 3>(ws, nb, nh, nblk, tid, pre);
    if (hn) { u32x4 q0 = __builtin_bit_cast(u32x4, pre.qf[0][0]), q1 = __builtin_bit_cast(u32x4, pre.qf[0][1]), q2 = __builtin_bit_cast(u32x4, pre.qf[1][0]), q3 = __builtin_bit_cast(u32x4, pre.qf[1][1]);
        asm volatile("" : "+v"(q0), "+v"(q1), "+v"(q2), "+v"(q3), "+v"(pre.k0), "+v"(pre.v0), "+v"(pre.k1), "+v"(pre.v1));
        pre.qf[0][0] = __builtin_bit_cast(bf16x8, q0); pre.qf[0][1] = __builtin_bit_cast(bf16x8, q1); pre.qf[1][0] = __builtin_bit_cast(bf16x8, q2); pre.qf[1][1] = __builtin_bit_cast(bf16x8, q3); }
    unsigned char* Y = (unsigned char*)(ws + WS_Y);
#pragma unroll
    for (int qi = 0; qi < 2; ++qi) {
        float inv = 1.0f;
        if (KIND != 2) inv = __builtin_amdgcn_rcpf(Ol[qi][0]);
        const int q = (KIND == 1) ? (qw + fr) : (qw + 16 * qi + fr);
        const int hh = (KIND == 1) ? hw + qi : h;
        unsigned char* yr = Y + (rowb + q) * DM + YCOL + hh * 64 + fq * 4;
        inv *= 8.0f;
#pragma unroll
        for (int dt = 0; dt < 4; ++dt) { const f32x4 o = O[qi][dt] * inv; *(unsigned*)(yr + dt * 16) = (unsigned)pg8::fp8x4(o[0], o[1], o[2], o[3]); }
    }
}

__device__ __forceinline__ void attn_phase(KP Pq, Frame& F, int l) {
    F.tid = opaque_tid(F.wave0); F.lane = F.tid & 63; F.wave = opq_s(F.wave0); F.vcu = opq_s(F.vcu0); F.G = opq_s(F.G0); const KP P = kp_fresh(); (void)Pq;
    LAS float* relt = (LAS float*)(F.lds + ATT_RELT);
    unsigned char* ws = P->ws;
    __syncthreads();
    for (int i = F.tid; i < 4 * RELW; i += 512) { const int hh = i / RELW; int rel = i % RELW - RELO; rel = rel < -128 ? -128 : (rel > 128 ? 128 : rel); relt[i] = P->rel_bias[(l * 4 + hh) * 257 + rel + 128] * LOG2E; }
    __syncthreads();
    for (int vu = F.vcu; vu < 256; vu += F.G) {
        {
            LAS float* nf = (LAS float*)(F.lds + ATT_NF); LAS float* wsum = (LAS float*)(F.lds + ATT_FLAG + 256);
            __syncthreads();
            const f32x4 x = *(const f32x4*)((const float*)(ws + WS_LF) + (size_t)(vu >> 1) * SEQ + 4 * F.tid);
            const float s4 = (x[0] + x[1]) + (x[2] + x[3]);
            float incl = row_scan(s4);
            { const float T0 = rdl_f(incl, 15), T1 = rdl_f(incl, 31), T2 = rdl_f(incl, 47), T3 = rdl_f(incl, 63);
              incl += ((F.lane >= 16) ? T0 : 0.f) + ((F.lane >= 32) ? T1 : 0.f) + ((F.lane >= 48) ? T2 : 0.f);
              if (F.lane == 0) wsum[F.wave] = ((T0 + T1) + (T2 + T3)); }
            __syncthreads();
            float off = 0.f;
            for (int w2 = 0; w2 < F.wave; ++w2) off += wsum[w2];
            float pref = off + (incl - s4); f32x4 o;
            pref += x[0]; o[0] = -pref * LOG2E; pref += x[1]; o[1] = -pref * LOG2E; pref += x[2]; o[2] = -pref * LOG2E; pref += x[3]; o[3] = -pref * LOG2E;
            *(LAS f32x4*)(nf + 4 * F.tid) = o;
            __syncthreads();
        }
        auto unit_of = [&](int s2, int& kb, int& kh, int& kblk) { const int kind2 = (s2 + vu) & 3, j2 = s2 >> 2;
            if (kind2 == 1) { const int r = vu & 7; kb = vu >> 3; kh = 0; kblk = (j2 == 0) ? r : (j2 == 1) ? 31 - r : (j2 == 2) ? 15 - r : 16 + r; }
            else { const int bh = vu >> 1, o = vu & 1; kb = bh >> 2; kh = bh & 3; kblk = (j2 == 0) ? o : (j2 == 1) ? 7 - o : (j2 == 2) ? 2 + o : 5 - o; } };
        AttnPre A;
        { int b0, h0, k0; unit_of(0, b0, h0, k0); const int kind0 = vu & 3, tid0 = opaque_tid(F.wave0);
          if (kind0 == 0) attn_fetch<0>(ws, b0, h0, k0, tid0, A); else if (kind0 == 1) attn_fetch<1>(ws, b0, h0, k0, tid0, A); else if (kind0 == 2) attn_fetch<2>(ws, b0, h0, k0, tid0, A); else attn_fetch<3>(ws, b0, h0, k0, tid0, A); }
        for (int s = 0; s < 16; ++s) {
            const int kind = (s + vu) & 3;
            int b, h, blk, nb = 0, nh = 0, nblk = 0; unit_of(s, b, h, blk);
            const bool hn = s < 15; if (hn) unit_of(s + 1, nb, nh, nblk);
            if (kind == 0) attn_wg<0>(ws, b, h, blk, F.lds, F.wave0, A, hn, nb, nh, nblk);
            else if (kind == 1) attn_wg<1>(ws, b, h, blk, F.lds, F.wave0, A, hn, nb, nh, nblk);
            else if (kind == 2) attn_wg<2>(ws, b, h, blk, F.lds, F.wave0, A, hn, nb, nh, nblk);
            else attn_wg<3>(ws, b, h, blk, F.lds, F.wave0, A, hn, nb, nh, nblk);
        }
    }
    __syncthreads();
}

__device__ __forceinline__ void norm2_router_phase(KP Pq, Frame& F, int l) {
    F.tid = opaque_tid(F.wave0); F.lane = F.tid & 63; F.wave = opq_s(F.wave0); F.vcu = opq_s(F.vcu0); F.G = opq_s(F.G0); const KP P = kp_fresh(); (void)Pq;
    unsigned char* ws = P->ws;
    const bf16* X = (const bf16*)(ws + WS_X);
    const float* mod = (const float*)(ws + WS_MOD);
    unsigned char* H8 = (unsigned char*)(ws + WS_H8);
    const bf16* WH = (const bf16*)(ws + WS_WRT) + (size_t)l * 32 * 1024; const bf16* WL = WH + NL * 32 * 1024;
    int* TOKE = (int*)(ws + WS_TOKE); float* TOKG = (float*)(ws + WS_TOKG); int* COUNTS = (int*)(ws + WS_COUNTS);
    LAS float* lg = (LAS float*)(F.lds) + F.wave * (32 * 33);
    LAS unsigned* cnt = (LAS unsigned*)(F.lds + 40960);
    LAS float* GS = (LAS float*)(F.lds + 49152);
    LAS float* SH = GS + 1024;
    const int lane = F.lane, fr = lane & 15, fq = lane >> 4;
    const float* gn = P->norm2_g + l * DM;
    for (int tb = F.vcu; tb < NTB / 2; tb += F.G) {
        const int bb = (tb * 256) >> 11;
        __syncthreads();
        if (F.tid < 64) cnt[F.tid] = 0u;
        { const float* mb = mod + ((size_t)(l * 32 + bb)) * 6144 + 3 * 1024;
          for (int i = F.tid; i < 1024; i += 512) { GS[i] = gn[i] * (1.0f + mb[1024 + i]); SH[i] = mb[i]; } }
        __syncthreads();
        const int tok0 = tb * 256 + F.wave * 32;
        const bf16* xr0 = X + (size_t)(tok0 + fr) * DM + fq * 8; const bf16* xr1 = xr0 + 16 * DM;
        float ss0 = 0.f, ss1 = 0.f;
#pragma unroll 8
        for (int ks = 0; ks < 32; ++ks) { const u32x4 a = *(const u32x4*)(xr0 + ks * 32), c = *(const u32x4*)(xr1 + ks * 32);
            ss0 = dot2bf(a.x, ss0); ss0 = dot2bf(a.y, ss0); ss0 = dot2bf(a.z, ss0); ss0 = dot2bf(a.w, ss0);
            ss1 = dot2bf(c.x, ss1); ss1 = dot2bf(c.y, ss1); ss1 = dot2bf(c.z, ss1); ss1 = dot2bf(c.w, ss1); }
        const float rstd0 = __builtin_amdgcn_rsqf(sum_x16x32(ss0) * (1.0f / DM) + 1e-6f), rstd1 = __builtin_amdgcn_rsqf(sum_x16x32(ss1) * (1.0f / DM) + 1e-6f);
        f32x4 acc[2][2] = {{zero4(), zero4()}, {zero4(), zero4()}};
        unsigned char* h8w = H8 + (size_t)(tok0 + (fq & 1) * 16 + fr) * DM + (fq & ~1) * 8;
        u32x4 cx[2]; bf16x8 ah[2], al[2];
        cx[0] = *(const u32x4*)xr0; cx[1] = *(const u32x4*)xr1;
#pragma unroll
        for (int nt = 0; nt < 2; ++nt) { ah[nt] = *(const bf16x8*)(WH + (size_t)(nt * 16 + fr) * 1024 + fq * 8); al[nt] = *(const bf16x8*)(WL + (size_t)(nt * 16 + fr) * 1024 + fq * 8); }
#pragma unroll 2
        for (int ks = 0; ks < 32; ++ks) {
            const int kn = (ks + 1) & 31;
            u32x4 nx[2]; bf16x8 nah[2], nal[2];
            nx[0] = *(const u32x4*)(xr0 + kn * 32); nx[1] = *(const u32x4*)(xr1 + kn * 32);
#pragma unroll
            for (int nt = 0; nt < 2; ++nt) { nah[nt] = *(const bf16x8*)(WH + (size_t)(nt * 16 + fr) * 1024 + kn * 32 + fq * 8); nal[nt] = *(const bf16x8*)(WL + (size_t)(nt * 16 + fr) * 1024 + kn * 32 + fq * 8); }
            const f32x4 g0 = *(const LAS f32x4*)(GS + ks * 32 + fq * 8), g1 = *(const LAS f32x4*)(GS + ks * 32 + fq * 8 + 4), s0 = *(const LAS f32x4*)(SH + ks * 32 + fq * 8), s1 = *(const LAS f32x4*)(SH + ks * 32 + fq * 8 + 4);
            u32x2 f8p[2];
#pragma unroll
            for (int tt = 0; tt < 2; ++tt) {
                float xv[8]; bf8_to_f(cx[tt], xv);
                const float rs = tt ? rstd1 : rstd0;
                float hv[8];
#pragma unroll
                for (int i = 0; i < 8; ++i) hv[i] = (xv[i] * rs) * (i < 4 ? g0[i] : g1[i - 4]) + (i < 4 ? s0[i] : s1[i - 4]);
                u32x4 hi, lo;
                hi.x = pk2(hv[0], hv[1]); hi.y = pk2(hv[2], hv[3]); hi.z = pk2(hv[4], hv[5]); hi.w = pk2(hv[6], hv[7]);
                lo.x = pk2(hv[0] - bf2f(hi.x & 0xffffu), hv[1] - bf2f(hi.x >> 16)); lo.y = pk2(hv[2] - bf2f(hi.y & 0xffffu), hv[3] - bf2f(hi.y >> 16));
                lo.z = pk2(hv[4] - bf2f(hi.z & 0xffffu), hv[5] - bf2f(hi.z >> 16)); lo.w = pk2(hv[6] - bf2f(hi.w & 0xffffu), hv[7] - bf2f(hi.w >> 16));
                f8p[tt].x = (unsigned)pg8::fp8x4(hv[0], hv[1], hv[2], hv[3]); f8p[tt].y = (unsigned)pg8::fp8x4(hv[4], hv[5], hv[6], hv[7]);
                const bf16x8 bh = __builtin_bit_cast(bf16x8, hi), bl = __builtin_bit_cast(bf16x8, lo);
#pragma unroll
                for (int nt = 0; nt < 2; ++nt) {
                    acc[tt][nt] = __builtin_amdgcn_mfma_f32_16x16x32_bf16(ah[nt], bh, acc[tt][nt], 0, 0, 0);
                    acc[tt][nt] = __builtin_amdgcn_mfma_f32_16x16x32_bf16(al[nt], bh, acc[tt][nt], 0, 0, 0);
                    acc[tt][nt] = __builtin_amdgcn_mfma_f32_16x16x32_bf16(ah[nt], bl, acc[tt][nt], 0, 0, 0);
                }
            }
            { unsigned ax = f8p[0].x, ay = f8p[0].y, bx = f8p[1].x, by = f8p[1].y; pg8::swap16(ax, bx); pg8::swap16(ay, by);
              *(u32x4*)(h8w + ks * 32) = (u32x4){ax, ay, bx, by}; }
            cx[0] = nx[0]; cx[1] = nx[1]; ah[0] = nah[0]; ah[1] = nah[1]; al[0] = nal[0]; al[1] = nal[1];
        }
#pragma unroll
        for (int tt = 0; tt < 2; ++tt)
#pragma unroll
            for (int nt = 0; nt < 2; ++nt)
#pragma unroll
                for (int j = 0; j < 4; ++j) { const int e = nt * 16 + fq * 4 + j; lg[(tt * 16 + fr) * 33 + e] = acc[tt][nt][j] + P->b_router[l * 32 + e]; }
        LDS_WAIT(); asm volatile("" ::: "memory");
        if (lane < 32) {
            float v0 = -INFINITY, v1 = -INFINITY, v2 = -INFINITY, v3 = -INFINITY; int i0 = 0, i1 = 0, i2 = 0, i3 = 0;
            for (int e = 0; e < 32; ++e) { const float v = lg[lane * 33 + e];
                if (v > v0) { v3 = v2; i3 = i2; v2 = v1; i2 = i1; v1 = v0; i1 = i0; v0 = v; i0 = e; }
                else if (v > v1) { v3 = v2; i3 = i2; v2 = v1; i2 = i1; v1 = v; i1 = e; }
                else if (v > v2) { v3 = v2; i3 = i2; v2 = v; i2 = e; }
                else if (v > v3) { v3 = v; i3 = e; } }
            const float e1 = ex2((v1 - v0) * LOG2E), e2 = ex2((v2 - v0) * LOG2E), e3 = ex2((v3 - v0) * LOG2E); const float inv = __builtin_amdgcn_rcpf(1.0f + e1 + e2 + e3);
            const int tok = tok0 + lane;
            *(int4*)(TOKE + (size_t)tok * 4) = make_int4(i0, i1, i2, i3);
            *(f32x4*)(TOKG + (size_t)tok * 4) = (f32x4){inv, e1 * inv, e2 * inv, e3 * inv};
            LAS unsigned* cb = cnt + (F.wave >> 2) * 32;
            lds_add(cb + i0, 1u); lds_add(cb + i1, 1u); lds_add(cb + i2, 1u); lds_add(cb + i3, 1u);
        }
        LDS_WAIT();
        __syncthreads();
        if (F.tid < 64) COUNTS[(tb * 2 + (F.tid >> 5)) * 32 + (F.tid & 31)] = (int)cnt[F.tid];
    }
}

__device__ __forceinline__ void gather_phase(KP Pq, Frame& F) {
    F.tid = opaque_tid(F.wave0); F.lane = F.tid & 63; F.wave = opq_s(F.wave0); F.vcu = opq_s(F.vcu0); F.G = opq_s(F.G0); const KP P = kp_fresh(); (void)Pq;
    unsigned char* ws = P->ws;
    const unsigned char* H8 = (const unsigned char*)(ws + WS_H8); unsigned char* XS = (unsigned char*)(ws + WS_XS);
    const int* TOKE = (const int*)(ws + WS_TOKE); const float* TOKG = (const float*)(ws + WS_TOKG); const int* COUNTS = (const int*)(ws + WS_COUNTS);
    int* ROWDST = (int*)(ws + WS_ROWDST); float* ROWGATE = (float*)(ws + WS_ROWGATE); int* TILEE = (int*)(ws + WS_TILEE);
    LAS int* lp = (LAS int*)(F.lds);
    LAS int* part = lp + 512 * 32;
    LAS int* tot = part + 512;
    LAS int* pst = tot + 32;
    LAS unsigned* cur = (LAS unsigned*)(pst + 40);
    LAS int* posl = (LAS int*)(cur + 32);
    const int tid = F.tid;
    __syncthreads();
    { const int e = tid & 31, seg = tid >> 5; int c[32];
#pragma unroll
      for (int i = 0; i < 32; ++i) c[i] = COUNTS[(seg * 32 + i) * 32 + e];
      int run = 0;
#pragma unroll
      for (int i = 0; i < 32; ++i) { lp[(seg * 32 + i) * 32 + e] = run; run += c[i]; }
      part[seg * 32 + e] = run; }
    __syncthreads();
    if (tid < 32) { int s = 0; for (int g = 0; g < 16; ++g) { const int v = part[g * 32 + tid]; part[g * 32 + tid] = s; s += v; } tot[tid] = s; }
    __syncthreads();
    if (tid == 0) { int p = 0; for (int e = 0; e < 32; ++e) { pst[e] = p; p += (tot[e] + 255) & ~255; } pst[32] = p; }
    __syncthreads();
    if (F.vcu == 0) {
        for (int i = tid; i < MAXRT; i += 512) { int e = 0; for (int k = 1; k < 32; ++k) if (i * 256 >= pst[k]) e = k; TILEE[i] = e; }
        if (tid == 0) TILEE[MAXRT] = pst[32] / 256;
    }
    for (int e = F.vcu; e < 32; e += F.G) {
        for (int p = pst[e] + tot[e] + tid; p < pst[e + 1]; p += 512) { ROWDST[p] = -1; ROWGATE[p] = 0.f; }
    }
    for (int tb = F.vcu; tb < NTB; tb += F.G) {
        __syncthreads();
        if (tid < 32) cur[tid] = 0u;
        __syncthreads();
        { const int tok = tb * 128 + (tid >> 2), k = tid & 3; const int e = TOKE[(size_t)tok * 4 + k];
          const int pos = pst[e] + part[(tb >> 5) * 32 + e] + lp[tb * 32 + e] + (int)lds_add(cur + e, 1u);
          posl[tid] = pos; ROWDST[pos] = tok * 4 + k; ROWGATE[pos] = TOKG[(size_t)tok * 4 + k]; }
        __syncthreads();
    }
    __syncthreads();
}

__global__ void __launch_bounds__(512, 2) mk_fwd(Params Pval) {
    extern __shared__ __attribute__((aligned(16))) unsigned char lds_raw[];
    Frame F;
    F.lds = (LAS unsigned char*)lds_raw;
    F.tid = threadIdx.x; F.lane = F.tid & 63; F.wave = __builtin_amdgcn_readfirstlane(F.tid >> 6); F.wave0 = F.wave;
    F.G0 = gridDim.x; { const int bx = blockIdx.x; F.vcu0 = (F.G0 % 8 == 0) ? (bx % 8) * (F.G0 / 8) + bx / 8 : bx; } F.G = F.G0; F.vcu = F.vcu0;
    volatile LAS unsigned* MISC = (volatile LAS unsigned*)(F.lds + MISC_OFF);
    for (int u = F.tid; u < (LDS_BYTES - LDSCTL_OFF) / 4; u += 512) ((LAS unsigned*)(F.lds + LDSCTL_OFF))[u] = 0u;
    __syncthreads();
    const KP P = kp_fresh(); (void)Pval;
    unsigned char* ws = P->ws;
    XcdBarrier bar = xcd_barrier_post((unsigned*)(ws + WS_CTL) + CW_BAR, MISC + 8); bar.wv = F.wave0;
#define GRID_BAR() xcd_barrier(bar)

#ifndef PH_MASK
#define PH_MASK 0xFFFF
#endif
#define PH(k) ((PH_MASK >> (k)) & 1)
#ifndef DUP_MASK
#define DUP_MASK 0
#endif
#define DUP(k) ((DUP_MASK >> (k)) & 1)
#ifndef SELVAR
#define SELVAR 0
#endif
    if (PH(0)) p0_prologue(P, F);
    GRID_BAR();
    if (DUP(0)) { p0_prologue(P, F); GRID_BAR(); }
    for (int l = 0; l < NL; ++l) {
        if (DUP(1) && l > 0) { norm_phase<2>(P, F, NL); GRID_BAR(); }
        if (PH(1)) { if (l == 0) norm_phase<0>(P, F, 0); else norm_phase<1>(P, F, l); }
        GRID_BAR();
        if (PH(2)) { unsigned char* ws = kp_fresh()->ws; pg8::SchedDense8 S; S.o.init(T / 256, NP / 256, opq_s(F.G0), opq_s((int)blockIdx.x)); S.A = (const char*)(ws + WS_H); S.B = (const char*)(ws + WS_WIN) + (size_t)l * NP * 1024;
          pg8::EpiProj8 E{(bf16*)(ws + WS_PROJ), NP, (bf16*)(ws + WS_VT)};
          pg8::gemm_phase<pg8::EpiProj8, pg8::SchedDense8, true>(F.lds, S, E, F.wave0); }
        GRID_BAR();
        if (DUP(3)) { prep_phase<true>(P, F, l); GRID_BAR(); }
        if (PH(3)) prep_phase<false>(P, F, l);
        GRID_BAR();
        if (DUP(4)) { sel_phase<SELVAR>(P, F); GRID_BAR(); }
        if (PH(4)) sel_phase<0>(P, F);
        GRID_BAR();
        if (PH(5)) attn_phase(P, F, l);
        if (DUP(5)) { GRID_BAR(); attn_phase(P, F, l); }
        GRID_BAR();
        if (PH(6)) { unsigned char* ws = kp_fresh()->ws; const float* mod = (const float*)(ws + WS_MOD); pg8::SchedDense8 S; S.o.init(T / 256, DM / 256, opq_s(F.G0), opq_s((int)blockIdx.x)); S.A = (const char*)(ws + WS_Y); S.B = (const char*)(ws + WS_WO) + (size_t)l * 1024 * 1024;
          pg8::EpiResid8 E{l == 0 ? kp_fresh()->x : (const float*)nullptr, (bf16*)(ws + WS_X), mod + (size_t)l * 32 * 6144 + 2 * 1024};
          pg8::gemm_phase<pg8::EpiResid8, pg8::SchedDense8, true>(F.lds, S, E, F.wave0); }
        GRID_BAR();
        if (PH(7)) norm2_router_phase(P, F, l);
        GRID_BAR();
        if (DUP(7)) { norm2_router_phase(P, F, l); GRID_BAR(); }
        if (PH(9)) gather_phase(P, F);
        if (DUP(9)) { GRID_BAR(); gather_phase(P, F); }
        GRID_BAR();
        for (int rep = 0; rep < 1 + DUP(10); ++rep) {
        if (PH(10)) { unsigned char* ws = kp_fresh()->ws; const int* tile_e = (const int*)(ws + WS_TILEE); const int nrt = __builtin_amdgcn_readfirstlane(tile_e[MAXRT]);
          pg8::SchedMoeG S; S.o.init(nrt, 8, opq_s(F.G0), opq_s((int)blockIdx.x)); S.A = (const char*)(ws + WS_H8); S.B = (const char*)(ws + WS_WGU) + (size_t)l * NE * 2048 * 1024; S.tile_e = tile_e; S.estride = (size_t)2048 * 1024; S.rowdst = (const int*)(ws + WS_ROWDST);
          pg8::EpiSwiglu E{(unsigned char*)(ws + WS_ACT), kp_fresh()->b_gu + (size_t)l * NE * 2048};
          pg8::gemm_phase<pg8::EpiSwiglu, pg8::SchedMoeG, true>(F.lds, S, E, F.wave0); }
        GRID_BAR();
        if (PH(11)) { unsigned char* ws = kp_fresh()->ws; const int* tile_e = (const int*)(ws + WS_TILEE); const int nrt = __builtin_amdgcn_readfirstlane(tile_e[MAXRT]);
          pg8::SchedMoe S; S.o.init(nrt, 4, opq_s(F.G0), opq_s((int)blockIdx.x)); S.A = (const char*)(ws + WS_ACT); S.B = (const char*)(ws + WS_WDN) + (size_t)l * NE * 1024 * 1024; S.tile_e = tile_e; S.estride = (size_t)1024 * 1024;
          pg8::EpiDown E{(unsigned char*)(ws + WS_SLOT), kp_fresh()->b_dn + (size_t)l * NE * 1024, (const int*)(ws + WS_ROWDST), (const float*)(ws + WS_ROWGATE)};
          pg8::gemm_phase<pg8::EpiDown, pg8::SchedMoe, true>(F.lds, S, E, F.wave0); }
        GRID_BAR();
        }
    }
    if (PH(12)) norm_phase<2>(P, F, NL);
}

extern "C" void kernel_launch(void* const* d_in, const int* in_sizes, int n_in, void* d_out, int out_size, void* d_ws, size_t ws_size, hipStream_t stream) {
    static int grid = 0;
    if (grid == 0) {
        if (n_in != 20 || in_sizes[0] != T * DM || out_size != T * DM || ws_size < WS_END) { fprintf(stderr, "kernel_launch: unexpected shapes / workspace (%d inputs, ws %zu)\n", n_in, ws_size); grid = -1; return; }
        int dev = 0, cus = 0, per_cu = 0;
        if (hipGetDevice(&dev) != hipSuccess || hipDeviceGetAttribute(&cus, hipDeviceAttributeMultiprocessorCount, dev) != hipSuccess) { grid = -1; return; }
        if (hipFuncSetAttribute((const void*)mk_fwd, hipFuncAttributeMaxDynamicSharedMemorySize, LDS_BYTES) != hipSuccess) { fprintf(stderr, "kernel_launch: hipFuncSetAttribute failed\n"); grid = -1; return; }
        if (hipOccupancyMaxActiveBlocksPerMultiprocessor(&per_cu, (const void*)mk_fwd, 512, LDS_BYTES) != hipSuccess || per_cu < 1) { fprintf(stderr, "kernel_launch: occupancy query says %d\n", per_cu); }
        (void)hipGetLastError();
        grid = cus;
    }
    if (grid < 0) return;
    if (hipMemsetAsync((char*)d_ws + WS_CTL, 0, CTL_ZERO_BYTES, stream) != hipSuccess) return;
    Params p{};
    const float** pp = (const float**)&p;
    for (int i = 0; i < 20; ++i) pp[i] = (const float*)d_in[i];
    p.out = (float*)d_out; p.ws = (unsigned char*)d_ws;
    hipLaunchKernelGGL(mk_fwd, dim3(grid), dim3(512), LDS_BYTES, stream, p);
    const hipError_t le = hipPeekAtLastError();
    if (le != hipSuccess) fprintf(stderr, "kernel_launch: launch failed: %s\n", hipGetErrorName(le));
}
```

```cpp
#include <hip/hip_runtime.h>
#include <cstdio>
#include <cstdint>

#define GAS __attribute__((address_space(1)))
#define LAS __attribute__((address_space(3)))
typedef unsigned short bf16;
typedef unsigned u32x4 __attribute__((ext_vector_type(4)));
typedef unsigned u32x2 __attribute__((ext_vector_type(2)));
typedef float f32x4 __attribute__((ext_vector_type(4)));
typedef float f32x2 __attribute__((ext_vector_type(2)));
typedef short bf16x8 __attribute__((ext_vector_type(8)));
typedef __bf16 bf16x2_t __attribute__((ext_vector_type(2)));

constexpr int DM = 1024, NB = 32, SEQ = 2048, NL = 4, T = NB * SEQ;
constexpr int NP = 3072;
constexpr int C_QA = 0, C_KA = 256, C_VA = 512, C_QC = 768, C_KC = 1024, C_VC = 1280, C_QD = 1536, C_KD = 1792, C_VD = 2048,
              C_QB = 2304, C_LAT = 2560, C_QI = 2688, C_KI = 2816, C_WI = 2848, C_FA = 2852;
constexpr int IN_COLS = 2856;
constexpr int NE = 32, NPAIR = T * 4, PMAX = NPAIR + NE * 256, MAXRT = PMAX / 256;
constexpr int NTB = 512;
constexpr float LOG2E = 1.4426950408889634f;
constexpr float SC2 = 0.125f * LOG2E;
constexpr float RS32 = 0.17677669529663687f;

constexpr size_t MiB = 1u << 20;
constexpr size_t WS_CTL = 0, CTL_ZERO_BYTES = 1 * MiB;
constexpr size_t WS_MOD = 1 * MiB;
constexpr size_t WS_ROPE = 4 * MiB;
constexpr size_t WS_WRT = 5 * MiB;
constexpr size_t WS_TOKE = 6 * MiB, WS_TOKG = 7 * MiB, WS_COUNTS = 8 * MiB, WS_TILEE = 8 * MiB + 65536;
constexpr size_t WS_ROWDST = 9 * MiB, WS_ROWGATE = 11 * MiB, WS_THR = 13 * MiB, WS_LF = 14 * MiB;
constexpr size_t WS_KB = 16 * MiB, WS_VBT = 24 * MiB;
constexpr size_t WS_H8 = 3536 * MiB;
constexpr size_t WS_WIN = 32 * MiB, WS_WO = 56 * MiB, WS_WGU = 64 * MiB, WS_WDN = 576 * MiB;
constexpr size_t WS_X = 832 * MiB, WS_H = 1088 * MiB, WS_H2LO = 1216 * MiB, WS_PROJ = 1344 * MiB, WS_VT = 1728 * MiB, WS_Y = 1824 * MiB;
constexpr size_t WS_XS = 1952 * MiB, WS_ACT = 2480 * MiB, WS_SLOT = 3008 * MiB, WS_MASK = 3520 * MiB, WS_END = 3600 * MiB;
constexpr int CW_BAR = 4096;

constexpr int RING_BYTES = 131072;
constexpr int LDSCTL_OFF = RING_BYTES + 1024, MISC_OFF = LDSCTL_OFF + 320;
constexpr int LDS_BYTES = 147456, TE_LDS = 145408, GTAB_LDS = 135168;

struct Params {
    const float *x, *c, *w_ada, *b_ada, *norm1_g, *norm2_g, *w_in, *b_forget, *kv_norm_g, *w_uk, *w_uv, *rel_bias, *w_o,
                *w_router, *b_router, *w_gu, *b_gu, *w_dn, *b_dn, *final_g;
    float* out; unsigned char* ws;
};

typedef const Params __attribute__((address_space(4)))* KP;
__device__ __forceinline__ KP kp_fresh() { KP k = (KP)__builtin_amdgcn_kernarg_segment_ptr(); asm volatile("" : "+s"(k)); return k; }
__device__ __forceinline__ int opaque_tid(int wv) {
    int l; asm volatile("v_mbcnt_lo_u32_b32 %0, -1, 0\n\tv_mbcnt_hi_u32_b32 %0, -1, %0" : "=v"(l)); asm volatile("" : "+s"(wv)); return (wv << 6) | l; }
#define LDS_WAIT() asm volatile("s_waitcnt lgkmcnt(0)" ::: "memory")
#define VM_WAIT() asm volatile("s_waitcnt vmcnt(0)" ::: "memory")
__device__ __forceinline__ unsigned f2bf(float f) { unsigned u = __builtin_bit_cast(unsigned, f); return (u + 0x7fffu + ((u >> 16) & 1u)) >> 16; }
__device__ __forceinline__ float bf2f(unsigned b) { return __builtin_bit_cast(float, b << 16); }
__device__ __forceinline__ unsigned pk2(float lo, float hi) { f32x2 v = {lo, hi}; bf16x2_t b = __builtin_convertvector(v, bf16x2_t); return __builtin_bit_cast(unsigned, b); }
__device__ __forceinline__ float dpp_shr_f(float v, const int ctrl_is  ) {
    int r;
    if (ctrl_is == 1) r = __builtin_amdgcn_update_dpp(0, __builtin_bit_cast(int, v), 0x111, 0xf, 0xf, true);
    else if (ctrl_is == 2) r = __builtin_amdgcn_update_dpp(0, __builtin_bit_cast(int, v), 0x112, 0xf, 0xf, true);
    else if (ctrl_is == 4) r = __builtin_amdgcn_update_dpp(0, __builtin_bit_cast(int, v), 0x114, 0xf, 0xf, true);
    else r = __builtin_amdgcn_update_dpp(0, __builtin_bit_cast(int, v), 0x118, 0xf, 0xf, true);
    return __builtin_bit_cast(float, r);
}
__device__ __forceinline__ float rdl_f(float v, int l) { return __builtin_bit_cast(float, __builtin_amdgcn_readlane(__builtin_bit_cast(int, v), l)); }
__device__ __forceinline__ float row_scan(float v) { v += dpp_shr_f(v, 1); v += dpp_shr_f(v, 2); v += dpp_shr_f(v, 4); v += dpp_shr_f(v, 8); return v; }
__device__ __forceinline__ float wave_sum(float v) { v = row_scan(v); return (rdl_f(v, 15) + rdl_f(v, 31)) + (rdl_f(v, 47) + rdl_f(v, 63)); }
struct U2 { unsigned a, b; };
__device__ __forceinline__ U2 pl16(unsigned x) { U2 r; r.a = x; r.b = x; asm volatile("s_nop 1\n\tv_permlane16_swap_b32 %0, %1" : "+v"(r.a), "+v"(r.b)); return r; }
__device__ __forceinline__ U2 pl32(unsigned x) { U2 r; r.a = x; r.b = x; asm volatile("s_nop 1\n\tv_permlane32_swap_b32 %0, %1" : "+v"(r.a), "+v"(r.b)); return r; }
__device__ __forceinline__ float xor16_f(float v, int lane) { const U2 r = pl16(__builtin_bit_cast(unsigned, v)); return __builtin_bit_cast(float, (lane & 16) ? r.a : r.b); }
__device__ __forceinline__ float xor32_f(float v, int lane) { const U2 r = pl32(__builtin_bit_cast(unsigned, v)); return __builtin_bit_cast(float, (lane & 32) ? r.a : r.b); }
__device__ __forceinline__ float max_x16x32(float v) {
    U2 r = pl16(__builtin_bit_cast(unsigned, v)); v = fmaxf(__builtin_bit_cast(float, r.a), __builtin_bit_cast(float, r.b));
    r = pl32(__builtin_bit_cast(unsigned, v)); return fmaxf(__builtin_bit_cast(float, r.a), __builtin_bit_cast(float, r.b)); }
__device__ __forceinline__ float sum_x16x32(float v) {
    U2 r = pl16(__builtin_bit_cast(unsigned, v)); v = __builtin_bit_cast(float, r.a) + __builtin_bit_cast(float, r.b);
    r = pl32(__builtin_bit_cast(unsigned, v)); return __builtin_bit_cast(float, r.a) + __builtin_bit_cast(float, r.b); }
__device__ __forceinline__ float max3f(float a, float b, float c) { float r; asm("v_max3_f32 %0, %1, %2, %3" : "=v"(r) : "v"(a), "v"(b), "v"(c)); return r; }
__device__ __forceinline__ unsigned lds_add(LAS unsigned* p, unsigned v) { return __hip_atomic_fetch_add(p, v, __ATOMIC_RELAXED, __HIP_MEMORY_SCOPE_WORKGROUP); }
__device__ __forceinline__ f32x4 zero4() { float z = 0.f; asm volatile("" : "+v"(z)); return (f32x4){z, z, z, z}; }
typedef __bf16 bf16x2n __attribute__((ext_vector_type(2)));
__device__ __forceinline__ float dot2bf(unsigned w, float c) { const bf16x2n v = __builtin_bit_cast(bf16x2n, w); return __builtin_amdgcn_fdot2_f32_bf16(v, v, c, false); }
__device__ __forceinline__ float ex2(float x) { return __builtin_amdgcn_exp2f(x); }
__device__ __forceinline__ float lg2(float x) { return __builtin_amdgcn_logf(x); }

#define XB_TMO      128
#define XB_XCNT(j)  (256  + 64 * (j))
#define XB_XSUB(j)  (1280 + 64 * (j))
#define XB_XGEN(j)  (2304 + 64 * (j))
#define XB_TOP      3328
#define XB_TOPGEN   3392
#define XCD_BAR_WORDS 3456
#define XB_SPIN_CAP (1u << 21)
__device__ __forceinline__ unsigned xb_ld(unsigned* p)              { return __hip_atomic_load(p, __ATOMIC_RELAXED, __HIP_MEMORY_SCOPE_AGENT); }
__device__ __forceinline__ unsigned xb_add(unsigned* p, unsigned v) { return __hip_atomic_fetch_add(p, v, __ATOMIC_RELAXED, __HIP_MEMORY_SCOPE_AGENT); }
__device__ __forceinline__ unsigned xb_xcc_id() { return (unsigned)__builtin_amdgcn_s_getreg((3 << 11) | 20) & 0xFu; }
#define XB_SPIN(cond, bar) do { unsigned _sp = 0; while (cond) { __builtin_amdgcn_s_sleep(1); \
    if ((++_sp & 255u) == 0u) { if (xb_ld(&(bar)[XB_TMO])) break; if (_sp > XB_SPIN_CAP) { atomicAdd(&(bar)[XB_TMO], 1u); break; } } } } while (0)
struct XcdBarrier { unsigned* bar; unsigned x; volatile LAS unsigned* st; int wv; };
__device__ __forceinline__ XcdBarrier xcd_barrier_post(unsigned* bar, volatile LAS unsigned* st) {
    XcdBarrier b; b.bar = bar; b.x = xb_xcc_id(); b.st = st;
    if (threadIdx.x == 0) (void)xb_add(&bar[XB_XCNT(b.x)], 1u);
    return b;
}
__device__ __forceinline__ void xcd_barrier_complete(unsigned* bar, unsigned x, unsigned& nloc, unsigned& nx) {
    const unsigned G = gridDim.x * gridDim.y * gridDim.z;
    unsigned sum, cnt, mine, sp = 0u;
    for (;;) {
        sum = 0u; cnt = 0u; mine = 0u;
#pragma unroll
        for (unsigned j = 0; j < 16; ++j) { const unsigned c = xb_ld(&bar[XB_XCNT(j)]); sum += c; cnt += (c > 0u) ? 1u : 0u; mine = (j == x) ? c : mine; }
        if (sum == G) break;
        __builtin_amdgcn_s_sleep(1);
        if ((++sp & 255u) == 0u) { if (xb_ld(&bar[XB_TMO])) break; if (sp > XB_SPIN_CAP) { atomicAdd(&bar[XB_TMO], 1u); break; } }
    }
    nloc = mine > 0u ? mine : 1u; nx = cnt > 0u ? cnt : 1u;
}
__device__ __forceinline__ void xcd_barrier(const XcdBarrier& b) {
    asm volatile("s_waitcnt vmcnt(0)" ::: "memory");
    __syncthreads();
    if (opaque_tid(b.wv) == 0) {
        unsigned* bar = b.bar; asm volatile("" : "+s"(bar));
        unsigned bx = b.x; asm volatile("" : "+s"(bx));
        __builtin_amdgcn_s_waitcnt(0);
        unsigned nloc = b.st[0], nx = b.st[1];
        if (nloc == 0u) { xcd_barrier_complete(bar, bx, nloc, nx); b.st[0] = nloc; b.st[1] = nx; }
        const unsigned old = xb_add(&bar[XB_XSUB(bx)], 1u);
        const unsigned gen = old / nloc;
        if (old + 1u == (gen + 1u) * nloc) {
            __builtin_amdgcn_fence(__ATOMIC_RELEASE, "agent");
            asm volatile("s_waitcnt vmcnt(0)" ::: "memory");
            const unsigned og = xb_add(&bar[XB_TOP], 1u);
            const unsigned tg = og / nx;
            if (og + 1u == (tg + 1u) * nx) xb_add(&bar[XB_TOPGEN], 1u);
            else XB_SPIN(xb_ld(&bar[XB_TOPGEN]) == tg, bar);
            __builtin_amdgcn_fence(__ATOMIC_ACQUIRE, "agent");
            xb_add(&bar[XB_XGEN(bx)], 1u);
            asm volatile("s_waitcnt vmcnt(0)" ::: "memory");
        } else {
            XB_SPIN(xb_ld(&bar[XB_XGEN(bx)]) == gen, bar);
            __builtin_amdgcn_fence(__ATOMIC_ACQUIRE, "agent");
            asm volatile("s_waitcnt vmcnt(0)" ::: "memory");
        }
    }
    __syncthreads();
}

namespace pg8 {
constexpr int BM = 256, BK = 64, HALF = 128, HTB = HALF * BK * 2, NXCD = 8, WGM = 8, KD = 1024;
constexpr size_t HSTEP = (size_t)HALF * KD * 2, TSTEP = 2 * HSTEP, KSTEP = (size_t)BK * 2;
__host__ __device__ __forceinline__ int lds_byte(int r, int c) { const int st = (r >> 4) * 2 + (c >> 5), rr = r & 15, cc = c & 31, ob = rr * 64 + cc * 2; return st * 1024 + (ob ^ (((ob >> 9) & 1) << 5)); }
__host__ __device__ __forceinline__ void stage_rc(int b, int& R, int& C) { const int st = b / 1024, sb = b % 1024, swz = sb ^ (((sb >> 9) & 1) << 5); R = (st >> 1) * 16 + swz / 64; C = (st & 1) * 32 + (swz % 64) / 2; }
__host__ __device__ __forceinline__ int perm32(int rho) { const int n = rho >> 4, i = rho & 15; return 8 * (i >> 2) + 4 * n + (i & 3); }
struct Unit { int pm, pn, e; };
struct Order {
    int nM, nN, nwg, G, c;
    __device__ void init(int nM_, int nN_, int G_, int c_) { nM = nM_; nN = nN_; nwg = nM * nN; G = G_; c = c_; }
    __device__ bool tile(int i, int& pm, int& pn) const {
        const long L = (long)i * G + c; if (L >= nwg) return false;
        int wgid = (int)L; { const int q = nwg / NXCD, r = nwg % NXCD, xcd = wgid % NXCD, off = wgid / NXCD; wgid = (xcd < r ? xcd * (q + 1) : r * (q + 1) + (xcd - r) * q) + off; }
        const int nig = WGM * nN, gid = wgid / nig, fm = gid * WGM, gsz = (nM - fm) < WGM ? (nM - fm) : WGM;
        pm = fm + ((wgid % nig) % gsz); pn = (wgid % nig) / gsz; return true;
    }
};
struct SchedDense {
    static constexpr bool GATHER = false, LA = false;
    Order o; const char* A; const char* B;
    __device__ __forceinline__ bool next(int i, Unit& u) const { u.e = 0; return o.tile(i, u.pm, u.pn); }
    __device__ __forceinline__ const char* aptr(const Unit& u) const { return A + (size_t)u.pm * TSTEP; }
    __device__ __forceinline__ const char* bptr(const Unit& u) const { return B + (size_t)u.pn * TSTEP; }
};
struct SchedDense8 {
    static constexpr bool GATHER = false, LA = false;
    Order o; const char* A; const char* B;
    __device__ __forceinline__ bool next(int i, Unit& u) const { u.e = 0; return o.tile(i, u.pm, u.pn); }
    __device__ __forceinline__ const char* aptr(const Unit& u) const { return A + (size_t)u.pm * (TSTEP / 2); }
    __device__ __forceinline__ const char* bptr(const Unit& u) const { return B + (size_t)u.pn * (TSTEP / 2); }
};
struct SchedMoe {
    static constexpr bool GATHER = false, LA = true;
    __device__ __forceinline__ bool idx(int i, Unit& u) const { return o.tile(i, u.pm, u.pn); }
    __device__ __forceinline__ int e_raw(const Unit& u) const { return tile_e[u.pm]; }
    Order o; const char* A; const char* B; const int* tile_e; size_t estride;
    __device__ __forceinline__ bool next(int i, Unit& u) const { if (!o.tile(i, u.pm, u.pn)) return false; u.e = __builtin_amdgcn_readfirstlane(tile_e[u.pm]); return true; }
    __device__ __forceinline__ const char* aptr(const Unit& u) const { return A + (size_t)u.pm * (TSTEP / 2); }
    __device__ __forceinline__ const char* bptr(const Unit& u) const { return B + (size_t)u.e * estride + (size_t)u.pn * (TSTEP / 2); }
};
struct SchedMoeG {
    static constexpr bool GATHER = true, LA = true;
    Order o; const char* A; const char* B; const int* tile_e; size_t estride; const int* rowdst; const unsigned* gt32;
    __device__ __forceinline__ bool idx(int i, Unit& u) const { return o.tile(i, u.pm, u.pn); }
    __device__ __forceinline__ int e_raw(const Unit& u) const { return tile_e[u.pm]; }
    __device__ __forceinline__ bool next(int i, Unit& u) const { if (!o.tile(i, u.pm, u.pn)) return false; u.e = __builtin_amdgcn_readfirstlane(tile_e[u.pm]); return true; }
    __device__ __forceinline__ const char* aptr(const Unit&) const { return A; }
    __device__ __forceinline__ const char* bptr(const Unit& u) const { return B + (size_t)u.e * estride + (size_t)u.pn * (TSTEP / 2); }
};
typedef int v8i __attribute__((ext_vector_type(8)));
__device__ __forceinline__ int fp8x4(float a, float b, float c, float d) {
    float hi = 448.f; asm volatile("" : "+v"(hi));
    a = __builtin_amdgcn_fmed3f(a, -hi, hi); b = __builtin_amdgcn_fmed3f(b, -hi, hi); c = __builtin_amdgcn_fmed3f(c, -hi, hi); d = __builtin_amdgcn_fmed3f(d, -hi, hi);
    int r = __builtin_amdgcn_cvt_pk_fp8_f32(a, b, 0, false); r = __builtin_amdgcn_cvt_pk_fp8_f32(c, d, r, true); return r;
}
__host__ __device__ __forceinline__ int x8(int rr) { return ((rr >> 1) & 1) | (((rr >> 3) & 1) << 2); }
__device__ __forceinline__ unsigned cvt_pk_bf16(float lo, float hi) { unsigned r; asm volatile("v_cvt_pk_bf16_f32 %0, %1, %2" : "=v"(r) : "v"(lo), "v"(hi)); return r; }

struct EpiProj {
    static constexpr bool DMAFILL = false; static constexpr int NSTORE = 16, TABW = 0, TAB_OFF = 0; __device__ __forceinline__ void fill_load(const Unit&, int, unsigned (&)[2]) const {} __device__ __forceinline__ void fill_store(LAS unsigned*, int, const unsigned (&)[2]) const {}
    static constexpr bool PERM = true;
    bf16* O; int ldc; bf16* VT;
    __device__ __forceinline__ static bool vt_unit(const Unit& u) { return u.pn == 2 || u.pn == 5 || u.pn == 8; }
    __device__ __forceinline__ void operator()(const f32x4 (&acc)[2][2][4][2], const Unit& u, int wr, int wc, int fr, int fq) const {
        if (vt_unit(u)) {
            const int g = (u.pn - 2) / 3, tok0 = u.pm * BM + wc * 32 + 8 * fq, b = tok0 >> 11, t0 = tok0 & 2047;
            bf16* vb = VT + ((size_t)(g * NB + b) * 256 + wr * 64 + fr) * SEQ + t0;
#pragma unroll
            for (int ai = 0; ai < 2; ++ai)
#pragma unroll
                for (int m = 0; m < 4; ++m)
#pragma unroll
                    for (int bj = 0; bj < 2; ++bj) { const f32x4 v0 = acc[ai][bj][m][0], v1 = acc[ai][bj][m][1];
                        u32x4 w; w.x = cvt_pk_bf16(v0[0], v0[1]); w.y = cvt_pk_bf16(v0[2], v0[3]); w.z = cvt_pk_bf16(v1[0], v1[1]); w.w = cvt_pk_bf16(v1[2], v1[3]);
                        *(u32x4*)(vb + (size_t)(ai * HALF + m * 16) * SEQ + bj * HALF) = w; }
            return;
        }
        const int row0 = u.pm * BM + wr * 64 + fr, col0 = u.pn * BM + wc * 32 + 8 * fq;
#pragma unroll
        for (int ai = 0; ai < 2; ++ai)
#pragma unroll
            for (int m = 0; m < 4; ++m) { bf16* rowp = O + (size_t)(row0 + ai * HALF + m * 16) * ldc + col0;
#pragma unroll
                for (int bj = 0; bj < 2; ++bj) { const f32x4 v0 = acc[ai][bj][m][0], v1 = acc[ai][bj][m][1];
                    u32x4 w; w.x = cvt_pk_bf16(v0[0], v0[1]); w.y = cvt_pk_bf16(v0[2], v0[3]); w.z = cvt_pk_bf16(v1[0], v1[1]); w.w = cvt_pk_bf16(v1[2], v1[3]);
                    *(u32x4*)(rowp + bj * HALF) = w; } }
    }
};
struct EpiResid {
    static constexpr bool DMAFILL = false; static constexpr int NSTORE = 16, TABW = 0, TAB_OFF = 0; __device__ __forceinline__ void fill_load(const Unit&, int, unsigned (&)[2]) const {} __device__ __forceinline__ void fill_store(LAS unsigned*, int, const unsigned (&)[2]) const {}
    static constexpr bool PERM = true; __device__ __forceinline__ static bool vt_unit(const Unit&) { return false; }
    const float* xin_f32; bf16* X; const float* gate;
    __device__ __forceinline__ void operator()(const f32x4 (&acc)[2][2][4][2], const Unit& u, int wr, int wc, int fr, int fq) const {
        const int row0 = u.pm * BM + wr * 64 + fr, col0 = u.pn * BM + wc * 32 + 8 * fq;
        const float* g = gate + (size_t)((u.pm * BM) >> 11) * 6144 + col0;
        f32x4 gv[2][2];
#pragma unroll
        for (int bj = 0; bj < 2; ++bj)
#pragma unroll
            for (int n = 0; n < 2; ++n) gv[bj][n] = *(const f32x4*)(g + bj * HALF + 4 * n);
#pragma unroll
        for (int ai = 0; ai < 2; ++ai)
#pragma unroll
            for (int m = 0; m < 4; ++m) { const size_t ro = (size_t)(row0 + ai * HALF + m * 16) * DM + col0;
#pragma unroll
                for (int bj = 0; bj < 2; ++bj) {
                    f32x4 x0, x1;
                    if (xin_f32) { x0 = *(const f32x4*)(xin_f32 + ro + bj * HALF); x1 = *(const f32x4*)(xin_f32 + ro + bj * HALF + 4); }
                    else { const u32x4 w = *(const u32x4*)(X + ro + bj * HALF);
                        x0 = (f32x4){__builtin_bit_cast(float, w.x << 16), __builtin_bit_cast(float, w.x & 0xffff0000u), __builtin_bit_cast(float, w.y << 16), __builtin_bit_cast(float, w.y & 0xffff0000u)};
                        x1 = (f32x4){__builtin_bit_cast(float, w.z << 16), __builtin_bit_cast(float, w.z & 0xffff0000u), __builtin_bit_cast(float, w.w << 16), __builtin_bit_cast(float, w.w & 0xffff0000u)}; }
                    const f32x4 v0 = x0 + gv[bj][0] * acc[ai][bj][m][0], v1 = x1 + gv[bj][1] * acc[ai][bj][m][1];
                    u32x4 o; o.x = cvt_pk_bf16(v0[0], v0[1]); o.y = cvt_pk_bf16(v0[2], v0[3]); o.z = cvt_pk_bf16(v1[0], v1[1]); o.w = cvt_pk_bf16(v1[2], v1[3]);
                    *(u32x4*)(X + ro + bj * HALF) = o; } }
    }
};
__device__ __forceinline__ float swiglu1(float g, float l) {
    g = fminf(g, 7.0f); l = fminf(fmaxf(l, -7.0f), 7.0f);
    const float s = __builtin_amdgcn_rcpf(1.0f + __builtin_amdgcn_exp2f(-1.702f * LOG2E * g));
    return g * s * (l + 1.0f);
}
__device__ __forceinline__ int arow(int m, int fr) { return (m >> 1) * 32 + 8 * (fr >> 2) + 4 * (m & 1) + (fr & 3); }
struct EpiProj8 {
    static constexpr bool DMAFILL = false; static constexpr int NSTORE = 16, TABW = 0, TAB_OFF = 0; __device__ __forceinline__ void fill_load(const Unit&, int, unsigned (&)[2]) const {} __device__ __forceinline__ void fill_store(LAS unsigned*, int, const unsigned (&)[2]) const {}
    static constexpr bool PERM = true;
    bf16* O; int ldc; bf16* VT;
    __device__ __forceinline__ static bool vt_unit(const Unit& u) { return u.pn == 2 || u.pn == 5 || u.pn == 8; }
    __device__ __forceinline__ void operator()(const f32x4 (&acc)[2][2][4][2], const Unit& u, int wr, int wc, int fr, int fq) const {
        if (vt_unit(u)) {
            const int g = (u.pn - 2) / 3, tok0 = u.pm * BM + wc * 32 + 8 * fq, b = tok0 >> 11, t0 = tok0 & 2047;
            bf16* vb = VT + ((size_t)(g * NB + b) * 256 + wr * 64) * SEQ + t0;
#pragma unroll
            for (int ai = 0; ai < 2; ++ai)
#pragma unroll
                for (int m = 0; m < 4; ++m)
#pragma unroll
                    for (int bj = 0; bj < 2; ++bj) { const f32x4 v0 = acc[ai][bj][m][0] * 0.015625f, v1 = acc[ai][bj][m][1] * 0.015625f;
                        u32x4 w; w.x = cvt_pk_bf16(v0[0], v0[1]); w.y = cvt_pk_bf16(v0[2], v0[3]); w.z = cvt_pk_bf16(v1[0], v1[1]); w.w = cvt_pk_bf16(v1[2], v1[3]);
                        *(u32x4*)(vb + (size_t)(ai * HALF + arow(m, fr)) * SEQ + bj * HALF) = w; }
            return;
        }
        const int row0 = u.pm * BM + wr * 64, col0 = u.pn * BM + wc * 32 + 8 * fq;
#pragma unroll
        for (int ai = 0; ai < 2; ++ai)
#pragma unroll
            for (int m = 0; m < 4; ++m) { bf16* rowp = O + (size_t)(row0 + ai * HALF + arow(m, fr)) * ldc + col0;
#pragma unroll
                for (int bj = 0; bj < 2; ++bj) { const f32x4 v0 = acc[ai][bj][m][0] * 0.015625f, v1 = acc[ai][bj][m][1] * 0.015625f;
                    u32x4 w; w.x = cvt_pk_bf16(v0[0], v0[1]); w.y = cvt_pk_bf16(v0[2], v0[3]); w.z = cvt_pk_bf16(v1[0], v1[1]); w.w = cvt_pk_bf16(v1[2], v1[3]);
                    *(u32x4*)(rowp + bj * HALF) = w; } }
    }
};
__device__ __forceinline__ void swap16(unsigned& a, unsigned& b) { asm volatile("s_nop 1\n\tv_permlane16_swap_b32 %0, %1" : "+v"(a), "+v"(b)); }
struct EpiSwiglu {
    static constexpr bool PERM = true; __device__ __forceinline__ static bool vt_unit(const Unit&) { return false; }
    unsigned char* O; const float* bias;
    static constexpr bool DMAFILL = true; static constexpr int NSTORE = 4, TABW = 256, TAB_OFF = 143360;
    __device__ __forceinline__ void fill_dma(const Unit& u, LAS unsigned* tab, int tid) const { const int wv = __builtin_amdgcn_readfirstlane(tid >> 6), t = tid & 255;
        if (wv < 4) __builtin_amdgcn_global_load_lds((const unsigned*)(bias + (size_t)u.e * 2048 + (t < 128 ? u.pn * HALF + t : 1024 + u.pn * HALF + (t - 128))), tab + wv * 64, 4, 0, 0); }
    __device__ __forceinline__ void fill_load(const Unit& u, int tid, unsigned (&v)[2]) const { const int t = tid & 255;
        v[0] = __builtin_bit_cast(unsigned, bias[(size_t)u.e * 2048 + (t < 128 ? u.pn * HALF + t : 1024 + u.pn * HALF + (t - 128))]); v[1] = 0u; }
    __device__ __forceinline__ void fill_store(LAS unsigned* tab, int tid, const unsigned (&v)[2]) const { tab[tid & 255] = v[0]; }
    __device__ __forceinline__ void operator()(const f32x4 (&acc)[2][2][4][2], const Unit& u, int wr, int wc, int fr, int fq, const LAS unsigned* tab) const {
        const int row0 = u.pm * BM + wr * 64, colw = u.pn * HALF + wc * 32 + 8 * (fq & ~1), odd = fq & 1;
        f32x4 bv[2][2];
#pragma unroll
        for (int bj = 0; bj < 2; ++bj)
#pragma unroll
            for (int n = 0; n < 2; ++n) { bv[bj][n] = *(const LAS f32x4*)(tab + bj * 128 + wc * 32 + 8 * fq + 4 * n); if (bj == 1) bv[bj][n] = bv[bj][n] * 4.0f + 4.0f; }
#pragma unroll
        for (int ai = 0; ai < 2; ++ai)
#pragma unroll
            for (int mp = 0; mp < 2; ++mp) { u32x2 wp[2];
#pragma unroll
              for (int mm = 0; mm < 2; ++mm) { const int m = 2 * mp + mm;
                int wq[2];
#pragma unroll
                for (int n = 0; n < 2; ++n) { const f32x4 g4 = acc[ai][0][m][n] * 0.015625f + bv[0][n], l4 = acc[ai][1][m][n] * 0.0625f + bv[1][n];
                    f32x2 r2[2];
#pragma unroll
                    for (int hh = 0; hh < 2; ++hh) {
                        f32x2 g = {fminf(g4[2 * hh], 7.0f), fminf(g4[2 * hh + 1], 7.0f)};
                        f32x2 l = {__builtin_amdgcn_fmed3f(l4[2 * hh], -24.0f, 32.0f), __builtin_amdgcn_fmed3f(l4[2 * hh + 1], -24.0f, 32.0f)};
                        const f32x2 ea = g * (-1.702f * LOG2E);
                        const f32x2 den = (f32x2){__builtin_amdgcn_exp2f(ea[0]), __builtin_amdgcn_exp2f(ea[1])} + 1.0f;
                        const f32x2 sg = {__builtin_amdgcn_rcpf(den[0]), __builtin_amdgcn_rcpf(den[1])};
                        r2[hh] = (g * sg) * l; }
                    int w = __builtin_amdgcn_cvt_pk_fp8_f32(r2[0][0], r2[0][1], 0, false); wq[n] = __builtin_amdgcn_cvt_pk_fp8_f32(r2[1][0], r2[1][1], w, true); }
                wp[mm].x = (unsigned)wq[0]; wp[mm].y = (unsigned)wq[1]; }
              unsigned ax = wp[0].x, ay = wp[0].y, bx = wp[1].x, by = wp[1].y;
              swap16(ax, bx); swap16(ay, by);
              *(u32x4*)(O + (size_t)(row0 + ai * HALF + arow(2 * mp + odd, fr)) * DM + colw) = (u32x4){ax, ay, bx, by}; }
    }
};
struct EpiDown {
    static constexpr bool PERM = true; __device__ __forceinline__ static bool vt_unit(const Unit&) { return false; }
    unsigned char* O; const float* bias; const int* dst; const float* gate;
    static constexpr int NSTORE = 8, TABW = 768, TAB_OFF = 135168;
    static constexpr bool DMAFILL = true;
    __device__ __forceinline__ void fill_dma(const Unit& u, LAS unsigned* tab, int tid) const { const int wv = __builtin_amdgcn_readfirstlane(tid >> 6), t = tid & 255;
        if (wv < 4) { __builtin_amdgcn_global_load_lds((const unsigned*)(bias + (size_t)u.e * 1024 + u.pn * BM + t), tab + wv * 64, 4, 0, 0);
                      __builtin_amdgcn_global_load_lds((const unsigned*)(dst + u.pm * BM + t), tab + 256 + wv * 64, 4, 0, 0); }
        else __builtin_amdgcn_global_load_lds((const unsigned*)(gate + u.pm * BM + t), tab + 512 + (wv - 4) * 64, 4, 0, 0); }
    __device__ __forceinline__ void fill_load(const Unit& u, int tid, unsigned (&v)[2]) const { const int t = tid & 255;
        const float* p0 = (tid < 256) ? bias + (size_t)u.e * 1024 + u.pn * BM + t : gate + u.pm * BM + t;
        v[0] = __builtin_bit_cast(unsigned, *p0); v[1] = (unsigned)dst[u.pm * BM + t]; }
    __device__ __forceinline__ void fill_store(LAS unsigned* tab, int tid, const unsigned (&v)[2]) const { tab[tid + (tid < 256 ? 0 : 256)] = v[0]; tab[256 + (tid & 255)] = v[1]; }
    __device__ __forceinline__ void operator()(const f32x4 (&acc)[2][2][4][2], const Unit& u, int wr, int wc, int fr, int fq, const LAS unsigned* tab) const {
        const int colw = u.pn * BM + wc * 32 + 8 * (fq & ~1), odd = fq & 1;
        f32x4 bv[2][2];
#pragma unroll
        for (int bj = 0; bj < 2; ++bj)
#pragma unroll
            for (int n = 0; n < 2; ++n) bv[bj][n] = *(const LAS f32x4*)(tab + bj * HALF + wc * 32 + 8 * fq + 4 * n);
#pragma unroll
        for (int ai = 0; ai < 2; ++ai)
#pragma unroll
            for (int mp = 0; mp < 2; ++mp) { u32x2 wp[2][2];
#pragma unroll
                for (int mm = 0; mm < 2; ++mm) { const int m = 2 * mp + mm; const int rl = wr * 64 + ai * HALF + arow(m, fr); const float gt = __builtin_bit_cast(float, tab[512 + rl]) * 32.0f;
#pragma unroll
                    for (int bj = 0; bj < 2; ++bj) { const f32x4 v0 = (acc[ai][bj][m][0] * 0.00390625f + bv[bj][0]) * gt, v1 = (acc[ai][bj][m][1] * 0.00390625f + bv[bj][1]) * gt;
                        wp[mm][bj].x = (unsigned)fp8x4(v0[0], v0[1], v0[2], v0[3]); wp[mm][bj].y = (unsigned)fp8x4(v1[0], v1[1], v1[2], v1[3]); } }
                const int d = (int)tab[256 + wr * 64 + ai * HALF + arow(2 * mp + odd, fr)];
                unsigned char* rowp = O + (size_t)(d < 0 ? T * 4 : d) * DM + colw;
#pragma unroll
                for (int bj = 0; bj < 2; ++bj) { unsigned ax = wp[0][bj].x, ay = wp[0][bj].y, bx = wp[1][bj].x, by = wp[1][bj].y;
                    swap16(ax, bx); swap16(ay, by);
                    *(u32x4*)(rowp + bj * HALF) = (u32x4){ax, ay, bx, by}; } }
    }
};

struct EpiResid8 {
    static constexpr bool DMAFILL = false; static constexpr int NSTORE = 16, TABW = 0, TAB_OFF = 0; __device__ __forceinline__ void fill_load(const Unit&, int, unsigned (&)[2]) const {} __device__ __forceinline__ void fill_store(LAS unsigned*, int, const unsigned (&)[2]) const {}
    static constexpr bool PERM = true; __device__ __forceinline__ static bool vt_unit(const Unit&) { return false; }
    const float* xin_f32; bf16* X; const float* gate;
    __device__ __forceinline__ void operator()(const f32x4 (&acc)[2][2][4][2], const Unit& u, int wr, int wc, int fr, int fq) const {
        const int row0 = u.pm * BM + wr * 64, col0 = u.pn * BM + wc * 32 + 8 * fq;
        const float* g = gate + (size_t)((u.pm * BM) >> 11) * 6144 + col0;
        f32x4 gv[2][2];
#pragma unroll
        for (int bj = 0; bj < 2; ++bj)
#pragma unroll
            for (int n = 0; n < 2; ++n) gv[bj][n] = *(const f32x4*)(g + bj * HALF + 4 * n) * 0.001953125f;
#pragma unroll
        for (int ai = 0; ai < 2; ++ai)
#pragma unroll
            for (int m = 0; m < 4; ++m) { const size_t ro = (size_t)(row0 + ai * HALF + arow(m, fr)) * DM + col0;
#pragma unroll
                for (int bj = 0; bj < 2; ++bj) {
                    f32x4 x0, x1;
                    if (xin_f32) { x0 = *(const f32x4*)(xin_f32 + ro + bj * HALF); x1 = *(const f32x4*)(xin_f32 + ro + bj * HALF + 4); }
                    else { const u32x4 w = *(const u32x4*)(X + ro + bj * HALF);
                        x0 = (f32x4){__builtin_bit_cast(float, w.x << 16), __builtin_bit_cast(float, w.x & 0xffff0000u), __builtin_bit_cast(float, w.y << 16), __builtin_bit_cast(float, w.y & 0xffff0000u)};
                        x1 = (f32x4){__builtin_bit_cast(float, w.z << 16), __builtin_bit_cast(float, w.z & 0xffff0000u), __builtin_bit_cast(float, w.w << 16), __builtin_bit_cast(float, w.w & 0xffff0000u)}; }
                    const f32x4 v0 = x0 + gv[bj][0] * acc[ai][bj][m][0], v1 = x1 + gv[bj][1] * acc[ai][bj][m][1];
                    u32x4 o; o.x = cvt_pk_bf16(v0[0], v0[1]); o.y = cvt_pk_bf16(v0[2], v0[3]); o.z = cvt_pk_bf16(v1[0], v1[1]); o.w = cvt_pk_bf16(v1[2], v1[3]);
                    *(u32x4*)(X + ro + bj * HALF) = o; } }
    }
};

template <class Epi, class Sched, bool FP8 = false>
__device__ __forceinline__ void gemm_phase(LAS unsigned char* lds, const Sched& S, const Epi& E, int wave_s) {
    const int tid = opaque_tid(wave_s), wid = __builtin_amdgcn_readfirstlane(tid >> 6), lane = tid & 63, wr = wid >> 2, wc = wid & 3, fr = lane & 15, fq = lane >> 4;
    constexpr int K = KD, nt = FP8 ? K / 128 : K / BK;
    unsigned voffA[2], voffB[2];
#pragma unroll
    for (int i = 0; i < 2; ++i) {
        if (FP8) { const int q = (tid * 16 + i * 8192) >> 4, st = q >> 7, rr = (q >> 3) & 15, s16 = (q & 7) ^ x8(rr); const int R = st * 16 + rr, Rb = (R & ~31) + perm32(R & 31);
            voffA[i] = voffB[i] = (unsigned)(Rb * K + s16 * 16); }
        else { int R, C; stage_rc(tid * 16 + i * 8192, R, C); const int Rb = Epi::PERM ? ((R & ~31) + perm32(R & 31)) : R;
            voffA[i] = (unsigned)(R * K + C) * 2u; voffB[i] = (unsigned)(Rb * K + C) * 2u; } }
    constexpr size_t kstep = KSTEP, hstep = FP8 ? HSTEP / 2 : HSTEP;
    constexpr bool GATHER = Sched::GATHER;
#define PG8_GTAB ((LAS unsigned*)(lds + GTAB_LDS) + opaque_tid(wave_s))
    const unsigned ldsw = (unsigned)wid * 1024u;
    const int aoff = FP8 ? ((wr * 64 + fr) * 8 + ((fq * 2) ^ x8(fr))) * 16 : lds_byte(wr * 64 + fr, fq * 8), boff = FP8 ? ((wc * 32 + fr) * 8 + ((fq * 2) ^ x8(fr))) * 16 : lds_byte(wc * 32 + fr, fq * 8);
    const int poff = FP8 ? ((((fq * 2 + 1) ^ x8(fr)) - ((fq * 2) ^ x8(fr))) * 16) : 1024;
    const LAS unsigned char* pa0 = lds + aoff; const LAS unsigned char* pa1 = lds + aoff + poff; const LAS unsigned char* pb0 = lds + 65536 + boff; const LAS unsigned char* pb1 = lds + 65536 + boff + poff;
    asm volatile("" : "+v"(pa0), "+v"(pa1), "+v"(pb0), "+v"(pb1));

#define PG8_SA(b, h) (((b) * 2 + (h)) * HTB)
#define PG8_SB(b, h) ((4 + (b) * 2 + (h)) * HTB)
#define PG8_VOFFB (FP8 ? voffA : voffB)
#define PG8_STAGE(bufoff, gbase, voff) do { _Pragma("unroll") for (int _i = 0; _i < 2; ++_i) { unsigned _v = (voff)[_i]; asm volatile("" : "+v"(_v));     \
        __builtin_amdgcn_global_load_lds((const unsigned*)((const char*)(gbase) + _v), (LAS unsigned*)(lds + (bufoff) + ldsw + _i * 8192), 16, 0, 0); } } while (0)
#define PG8_STAGE_A(bufoff, gbase, h, par) do { if constexpr (GATHER) { const unsigned _w = PG8_GTAB[(par) * 1024 + (h) * 512]; _Pragma("unroll") for (int _i = 0; _i < 2; ++_i) { \
            unsigned _v = ((_w >> (16 * _i)) & 0xffffu) * 1024u + (voffA[_i] & 1023u); asm volatile("" : "+v"(_v)); \
            __builtin_amdgcn_global_load_lds((const unsigned*)((const char*)(gbase) + _v), (LAS unsigned*)(lds + (bufoff) + ldsw + _i * 8192), 16, 0, 0); } } \
        else PG8_STAGE(bufoff, (gbase) + (h) * hstep, voffA); } while (0)
#define PG8_GLOAD(u, g) do { if constexpr (GATHER) { _Pragma("unroll") for (int _h = 0; _h < 2; ++_h) _Pragma("unroll") for (int _i = 0; _i < 2; ++_i) { \
            unsigned _vo = voffA[_i]; asm volatile("" : "+v"(_vo)); (g)[_h * 2 + _i] = S.rowdst[(u).pm * BM + _h * HALF + (int)(_vo >> 10)]; } } } while (0)
#define PG8_GSTORE(par, g) do { if constexpr (GATHER) { _Pragma("unroll") for (int _h = 0; _h < 2; ++_h) { unsigned _w = 0; _Pragma("unroll") for (int _i = 0; _i < 2; ++_i) { \
            const int _d = (g)[_h * 2 + _i]; _w |= (unsigned)(_d < 0 ? 0 : (_d >> 2)) << (16 * _i); } PG8_GTAB[(par) * 1024 + _h] = _w; } } } while (0)
#define PG8_GFILL(u, par) do { if constexpr (GATHER) { const int _t = opaque_tid(wave_s); _Pragma("unroll") for (int _h = 0; _h < 2; ++_h) \
            PG8_GTAB[(par) * 1024 + _h * 512] = S.gt32[((u).pm * 2 + _h) * 512 + _t]; } } while (0)
#define PG8_LDA(dst, b, h) do { _Pragma("unroll") for (int m = 0; m < 4; ++m) _Pragma("unroll") for (int k = 0; k < 2; ++k) dst[m][k] = *(const LAS bf16x8*)((k ? pa1 : pa0) + PG8_SA(b, h) + m * 2048); } while (0)
#define PG8_LDB(dst, b, h) do { _Pragma("unroll") for (int n = 0; n < 2; ++n) _Pragma("unroll") for (int k = 0; k < 2; ++k) dst[n][k] = *(const LAS bf16x8*)((k ? pb1 : pb0) + (PG8_SB(b, h) - 65536) + n * 2048); } while (0)
#define PG8_V8(f) __builtin_shufflevector(__builtin_bit_cast(u32x4, (f)[0]), __builtin_bit_cast(u32x4, (f)[1]), 0, 1, 2, 3, 4, 5, 6, 7)
#define PG8_MMA(ai, bj, At, Bt) do { __builtin_amdgcn_s_setprio(1); \
        if constexpr (FP8) { _Pragma("unroll") for (int m = 0; m < 4; ++m) _Pragma("unroll") for (int n = 0; n < 2; ++n) \
            acc[ai][bj][m][n] = __builtin_amdgcn_mfma_scale_f32_16x16x128_f8f6f4(__builtin_bit_cast(v8i, PG8_V8(Bt[n])), __builtin_bit_cast(v8i, PG8_V8(At[m])), acc[ai][bj][m][n], 0, 0, 0, 0, 0, 0); } \
        else { _Pragma("unroll") for (int m = 0; m < 4; ++m) _Pragma("unroll") for (int n = 0; n < 2; ++n) _Pragma("unroll") for (int k = 0; k < 2; ++k) \
            acc[ai][bj][m][n] = __builtin_amdgcn_mfma_f32_16x16x32_bf16(Bt[n][k], At[m][k], acc[ai][bj][m][n], 0, 0, 0); } \
        __builtin_amdgcn_s_setprio(0); } while (0)
#define PG8_WAIT_V(n) asm volatile("s_waitcnt vmcnt(" #n ")" ::: "memory")
#define PG8_WAIT_L(n) asm volatile("s_waitcnt lgkmcnt(" #n ")" ::: "memory")
#define PG8_BAR __builtin_amdgcn_s_barrier()
#define PG8_SCHED __builtin_amdgcn_sched_barrier(0)
    Unit cur, nxt; int ui = 0;
    if (!S.next(0, cur)) return;
    f32x4 acc[2][2][4][2];
    { float z0 = 0.f; asm volatile("" : "+v"(z0));
#pragma unroll
    for (int a = 0; a < 2; ++a)
#pragma unroll
        for (int b = 0; b < 2; ++b)
#pragma unroll
            for (int m = 0; m < 4; ++m)
#pragma unroll
                for (int n = 0; n < 2; ++n) acc[a][b][m][n] = (f32x4){z0, z0, z0, z0}; }
    bf16x8 At[4][2], B0[2][2], B1[2][2];
    const char* cA = Epi::vt_unit(cur) ? S.bptr(cur) : S.aptr(cur); const char* cB = Epi::vt_unit(cur) ? S.aptr(cur) : S.bptr(cur);
    int cpar = 0;
    PG8_GFILL(cur, 0);
    if constexpr (Sched::LA && GATHER) { Unit t1; if (S.idx(1, t1)) PG8_GFILL(t1, 1); }
    {
        PG8_STAGE(PG8_SB(0, 0), cB, PG8_VOFFB); PG8_STAGE(PG8_SB(0, 1), cB + hstep, PG8_VOFFB); PG8_STAGE_A(PG8_SA(0, 0), cA, 0, 0); PG8_STAGE_A(PG8_SA(0, 1), cA, 1, 0);
        if (wr == 1) PG8_BAR;
        PG8_WAIT_V(2); PG8_BAR;
        PG8_STAGE(PG8_SB(1, 0), cB + kstep, PG8_VOFFB); PG8_STAGE_A(PG8_SA(1, 0), cA + kstep, 0, 0); PG8_STAGE(PG8_SB(1, 1), cB + hstep + kstep, PG8_VOFFB);
        PG8_WAIT_V(6); PG8_BAR;
    }
    constexpr bool LA = Sched::LA;
    bool has_next = false;
    nxt = cur;
    if constexpr (LA) {
        has_next = S.next(1, nxt);
        if constexpr (Epi::TABW > 0) { unsigned fv[2]; const int tz = opaque_tid(wave_s); E.fill_load(cur, tz, fv); E.fill_store((LAS unsigned*)(lds + Epi::TAB_OFF), tz, fv); }
    }
    for (;;) {
        if constexpr (!LA) {
        has_next = S.next(ui + 1, nxt);
        if constexpr (Epi::TABW > 0) { unsigned fv[2]; const int tz = opaque_tid(wave_s); E.fill_load(cur, tz, fv); E.fill_store((LAS unsigned*)(lds + Epi::TAB_OFF) + (ui & 1) * Epi::TABW, tz, fv); }
        }
        const bool nvt = has_next && Epi::vt_unit(nxt);
        const char* nA = has_next ? (nvt ? S.bptr(nxt) : S.aptr(nxt)) : cA; const char* nB = has_next ? (nvt ? S.aptr(nxt) : S.bptr(nxt)) : cB;
        if constexpr (!LA) { if (has_next) PG8_GFILL(nxt, cpar ^ 1); }
        const int npar = has_next ? (cpar ^ 1) : cpar;
#pragma unroll 1
        for (int t = 0; t < nt; t += 2) {
            const bool last = (t == nt - 2);
            const char* a1 = cA + (size_t)(t + 1) * kstep;
            const char* a2 = last ? nA : cA + (size_t)(t + 2) * kstep; const char* b2 = last ? nB : cB + (size_t)(t + 2) * kstep;
            const char* a3 = a2 + kstep; const char* b3 = b2 + kstep;
            const int p2 = last ? npar : cpar;
            PG8_LDB(B0, 0, 0); PG8_LDB(B1, 0, 1); PG8_SCHED; PG8_LDA(At, 0, 0); PG8_STAGE_A(PG8_SA(1, 1), a1, 1, cpar);
            PG8_WAIT_V(8); PG8_WAIT_L(0); PG8_BAR; PG8_MMA(0, 0, At, B0); PG8_MMA(0, 1, At, B1); PG8_BAR; PG8_SCHED;
            PG8_LDA(At, 0, 1); PG8_STAGE(PG8_SB(0, 0), b2, PG8_VOFFB); PG8_STAGE(PG8_SB(0, 1), b2 + hstep, PG8_VOFFB); PG8_STAGE_A(PG8_SA(0, 0), a2, 0, p2);
            PG8_WAIT_V(8); PG8_WAIT_L(0); PG8_BAR; PG8_MMA(1, 0, At, B0); PG8_MMA(1, 1, At, B1); PG8_BAR; PG8_SCHED;
            PG8_LDB(B0, 1, 0); PG8_LDB(B1, 1, 1); PG8_SCHED; PG8_LDA(At, 1, 0); PG8_STAGE_A(PG8_SA(0, 1), a2, 1, p2);
            PG8_WAIT_V(8); PG8_WAIT_L(0); PG8_BAR; PG8_MMA(0, 0, At, B0); PG8_MMA(0, 1, At, B1); PG8_BAR; PG8_SCHED;
            PG8_LDA(At, 1, 1); PG8_STAGE(PG8_SB(1, 0), b3, PG8_VOFFB); PG8_STAGE(PG8_SB(1, 1), b3 + hstep, PG8_VOFFB); PG8_STAGE_A(PG8_SA(1, 0), a3, 0, p2);
            PG8_WAIT_V(8); PG8_WAIT_L(0); PG8_BAR; PG8_MMA(1, 0, At, B0); PG8_MMA(1, 1, At, B1); PG8_BAR; PG8_SCHED;
        }
        Unit nx2 = nxt; bool has_n2 = false; int e2 = 0; unsigned fv2[2] = {0u, 0u}; int g4[4] = {0, 0, 0, 0};
        if constexpr (LA) has_n2 = has_next && S.idx(ui + 2, nx2);
        if (wr == 0) PG8_BAR;
        constexpr bool DMAT = LA && Epi::DMAFILL;
        if constexpr (DMAT) { __builtin_amdgcn_global_load_lds((const unsigned*)(S.tile_e + nx2.pm), (LAS unsigned*)(lds + TE_LDS + ldsw / 4), 4, 0, 0);
                              if constexpr (GATHER) { const int _t = opaque_tid(wave_s);
                                  __builtin_amdgcn_global_load_lds(S.gt32 + (nx2.pm * 2 + 0) * 512 + _t, (LAS unsigned*)(lds + GTAB_LDS) + cpar * 1024 + ldsw / 16, 4, 0, 0);
                                  __builtin_amdgcn_global_load_lds(S.gt32 + (nx2.pm * 2 + 1) * 512 + _t, (LAS unsigned*)(lds + GTAB_LDS) + cpar * 1024 + 512 + ldsw / 16, 4, 0, 0); }
                              E.fill_dma(nxt, (LAS unsigned*)(lds + Epi::TAB_OFF) + ((ui + 1) & 1) * Epi::TABW, opaque_tid(wave_s)); }
        else if constexpr (LA) { e2 = S.e_raw(nx2); PG8_GLOAD(nx2, g4); if constexpr (Epi::TABW > 0) E.fill_load(nxt, opaque_tid(wave_s), fv2); }
        { const int tz = opaque_tid(wave_s); const int l2 = tz & 63, w2 = __builtin_amdgcn_readfirstlane(tz >> 6); if constexpr (Epi::TABW > 0) E(acc, cur, w2 >> 2, w2 & 3, l2 & 15, l2 >> 4, (const LAS unsigned*)(lds + Epi::TAB_OFF) + (ui & 1) * Epi::TABW); else E(acc, cur, w2 >> 2, w2 & 3, l2 & 15, l2 >> 4); }
        if (!has_next) break;
        { float z0 = 0.f; asm volatile("" : "+v"(z0));
#pragma unroll
        for (int a = 0; a < 2; ++a)
#pragma unroll
            for (int b = 0; b < 2; ++b)
#pragma unroll
                for (int m = 0; m < 4; ++m)
#pragma unroll
                    for (int n = 0; n < 2; ++n) acc[a][b][m][n] = (f32x4){z0, z0, z0, z0}; }
        if constexpr (DMAT) { if constexpr (Epi::NSTORE == 8) asm volatile("s_waitcnt vmcnt(8)" ::: "memory"); else asm volatile("s_waitcnt vmcnt(4)" ::: "memory");
                              const int ev = *(const LAS int*)(lds + TE_LDS + ldsw / 4); if (has_n2) nx2.e = __builtin_amdgcn_readfirstlane(ev); }
        else if constexpr (LA) { asm volatile("" : "+v"(e2), "+v"(g4[0]), "+v"(g4[1]), "+v"(g4[2]), "+v"(g4[3]), "+v"(fv2[0]), "+v"(fv2[1]));
                            if (has_n2) { nx2.e = __builtin_amdgcn_readfirstlane(e2); PG8_GSTORE(cpar, g4); }
                            if constexpr (Epi::TABW > 0) E.fill_store((LAS unsigned*)(lds + Epi::TAB_OFF) + ((ui + 1) & 1) * Epi::TABW, opaque_tid(wave_s), fv2); }
        cur = nxt; cA = nA; cB = nB; ++ui; cpar = npar;
        if constexpr (LA) { nxt = nx2; has_next = has_n2; }
        if (wr == 1) PG8_BAR;
    }
    PG8_WAIT_V(0);
    PG8_BAR;
#undef PG8_SA
#undef PG8_SB
#undef PG8_STAGE
#undef PG8_STAGE_A
#undef PG8_GTAB
#undef PG8_GFILL
#undef PG8_GLOAD
#undef PG8_GSTORE
#undef PG8_VOFFB
#undef PG8_LDA
#undef PG8_LDB
#undef PG8_MMA
#undef PG8_V8
#undef PG8_WAIT_V
#undef PG8_WAIT_L
#undef PG8_BAR
#undef PG8_SCHED
}
}

struct Frame {
    LAS unsigned char* lds;
    int tid, lane, wave, vcu, G, vcu0, G0, wave0;
};
__device__ __forceinline__ int opq_s(int v) { asm volatile("" : "+s"(v)); return v; }

__device__ __forceinline__ int win_src_col(int d) {
    if (d < 768) return d;
    if (d < 1536) return 1320 + (d - 768);
    if (d < 2304) return 2088 + (d - 1536);
    if (d < 2560) return 772 + (d - 2304);
    if (d < 2688) return 1028 + (d - 2560);
    if (d < 2816) return 1156 + (d - 2688);
    if (d < 2848) return 1284 + (d - 2816);
    if (d < 2852) return 1316 + (d - 2848);
    if (d < 2856) return 768 + (d - 2852);
    return -1;
}
__device__ __forceinline__ void tr_item(const float* W, int ldw, bf16* WT, int k0, int d0, int sc, LAS float* scr, int lane) {
#pragma unroll 8
    for (int i = 0; i < 32; ++i) { const int kk = 2 * i + (lane >> 5); scr[kk * 33 + (lane & 31)] = sc >= 0 ? __builtin_nontemporal_load(&W[(size_t)(k0 + kk) * ldw + sc]) : 0.f; }
    LDS_WAIT(); asm volatile("" ::: "memory");
    const int c = lane & 7;
#pragma unroll
    for (int j = 0; j < 4; ++j) { const int n = (lane >> 3) + 8 * j; const LAS float* s = scr + (8 * c) * 33 + n;
        u32x4 o; o.x = pk2(s[0 * 33], s[1 * 33]); o.y = pk2(s[2 * 33], s[3 * 33]); o.z = pk2(s[4 * 33], s[5 * 33]); o.w = pk2(s[6 * 33], s[7 * 33]);
        *(u32x4*)(WT + (size_t)(d0 + n) * 1024 + k0 + 8 * c) = o; }
    LDS_WAIT(); asm volatile("" ::: "memory");
}
__device__ __forceinline__ void tr_item8(const float* W, int ldw, unsigned char* WT, int k0, int d0, int sc, LAS float* scr, int lane) {
#pragma unroll 8
    for (int i = 0; i < 32; ++i) { const int kk = 2 * i + (lane >> 5); scr[kk * 33 + (lane & 31)] = sc >= 0 ? __builtin_nontemporal_load(&W[(size_t)(k0 + kk) * ldw + sc]) * 64.0f : 0.f; }
    LDS_WAIT(); asm volatile("" ::: "memory");
    const int c = lane & 7;
#pragma unroll
    for (int j = 0; j < 4; ++j) { const int n = (lane >> 3) + 8 * j; const LAS float* s = scr + (8 * c) * 33 + n;
        u32x2 o; o.x = (unsigned)pg8::fp8x4(s[0 * 33], s[1 * 33], s[2 * 33], s[3 * 33]); o.y = (unsigned)pg8::fp8x4(s[4 * 33], s[5 * 33], s[6 * 33], s[7 * 33]);
        *(u32x2*)(WT + (size_t)(d0 + n) * 1024 + k0 + 8 * c) = o; }
    LDS_WAIT(); asm volatile("" ::: "memory");
}
__device__ __forceinline__ void sincos_d(float angf, float& cs, float& sn) {
    const double a = (double)angf;
    const double q = __builtin_rint(a * 0.63661977236758134308);
    const double r = __builtin_fma(-q, 1.57079632679489661923, a) - q * 6.123233995736766e-17;
    const double r2 = r * r;
    double s = -1.0 / 39916800.0; s = s * r2 + 1.0 / 362880.0; s = s * r2 - 1.0 / 5040.0; s = s * r2 + 1.0 / 120.0; s = s * r2 - 1.0 / 6.0; s = s * r2 * r + r;
    double c = 1.0 / 479001600.0; c = c * r2 - 1.0 / 3628800.0; c = c * r2 + 1.0 / 40320.0; c = c * r2 - 1.0 / 720.0; c = c * r2 + 1.0 / 24.0; c = c * r2 - 0.5; c = c * r2 + 1.0;
    const int qi = ((int)q) & 3;
    const double cc = (qi == 0) ? c : (qi == 1) ? -s : (qi == 2) ? -c : s;
    const double ss = (qi == 0) ? s : (qi == 1) ? c : (qi == 2) ? -s : -c;
    cs = (float)cc; sn = (float)ss;
}
__device__ __forceinline__ void p0_prologue(KP Pq, Frame& F) {
    F.tid = opaque_tid(F.wave0); F.lane = F.tid & 63; F.wave = opq_s(F.wave0); F.vcu = opq_s(F.vcu0); F.G = opq_s(F.G0); const KP P = kp_fresh(); (void)Pq;
    unsigned char* ws = P->ws;
    LAS float* scr = (LAS float*)(F.lds + F.wave * 16384);
    const int gw = F.vcu * 8 + F.wave, NGW = F.G * 8;
    constexpr int N_WIN = NL * 16 * 96, N_WO = NL * 16 * 32, N_GU = NL * NE * 16 * 64, N_DN = NL * NE * 16 * 32;
    for (int it = gw; it < N_WIN + N_WO + N_GU + N_DN; it += NGW) {
        int r = it;
        if (r < N_WIN) { const int l = r / 1536, rr = r % 1536, kb = rr / 96, db = rr % 96;
            tr_item8(P->w_in + (size_t)l * 1024 * IN_COLS, IN_COLS, (unsigned char*)(ws + WS_WIN) + (size_t)l * NP * 1024, kb * 64, db * 32, win_src_col(db * 32 + (F.lane & 31)), scr, F.lane); continue; }
        r -= N_WIN;
        if (r < N_WO) { const int l = r / 512, rr = r % 512, kb = rr / 32, db = rr % 32;
            tr_item8(P->w_o + (size_t)l * 1024 * 1024, 1024, (unsigned char*)(ws + WS_WO) + (size_t)l * 1024 * 1024, kb * 64, db * 32, db * 32 + (F.lane & 31), scr, F.lane); continue; }
        r -= N_WO;
        if (r < N_GU) { const int le = r / 1024, rr = r % 1024, kb = rr / 64, db = rr % 64;
            const int pn = db >> 3, w = db & 7; const int src = (w < 4) ? (pn * 128 + w * 32) : (1024 + pn * 128 + (w - 4) * 32);
            tr_item8(P->w_gu + (size_t)le * 1024 * 2048, 2048, (unsigned char*)(ws + WS_WGU) + (size_t)le * 2048 * 1024, kb * 64, db * 32, src + (F.lane & 31), scr, F.lane); continue; }
        r -= N_GU;
        { const int le = r / 512, rr = r % 512, kb = rr / 32, db = rr % 32;
            tr_item8(P->w_dn + (size_t)le * 1024 * 1024, 1024, (unsigned char*)(ws + WS_WDN) + (size_t)le * 1024 * 1024, kb * 64, db * 32, db * 32 + (F.lane & 31), scr, F.lane); }
    }
    const int gt = F.vcu * 512 + F.tid, NGT = F.G * 512;
    for (int i = gt; i < NL * 32 * 1024; i += NGT) { const int l = i >> 15, e = (i >> 10) & 31, k = i & 1023;
        const float w = P->w_router[((size_t)l * 1024 + k) * 32 + e]; const unsigned hi = f2bf(w); const unsigned lo = f2bf(w - bf2f(hi));
        ((bf16*)(ws + WS_WRT))[i] = (bf16)hi; ((bf16*)(ws + WS_WRT))[NL * 32 * 1024 + i] = (bf16)lo; }
    float* rt = (float*)(ws + WS_ROPE);
    for (int i = gt; i < SEQ * 48; i += NGT) { const int t = i / 48, j = i % 48;
        const int half = j < 32 ? 32 : 16, ii = j < 32 ? j : j - 32;
        const float inv = (float)exp(-9.210340371976184 * (double)ii / (double)half);
        const float ang = (float)t * inv; float cs, sn; sincos_d(ang, cs, sn);
        if (j < 32) { rt[t * 32 + ii] = cs; rt[SEQ * 32 + t * 32 + ii] = sn; }
        else { rt[SEQ * 64 + t * 16 + ii] = cs; rt[SEQ * 64 + SEQ * 16 + t * 16 + ii] = sn; } }
    __syncthreads();
    {
        LAS float* cact = (LAS float*)(F.lds);
        LAS float* red = (LAS float*)(F.lds + 32768);
        float* mod = (float*)(ws + WS_MOD);
        for (int it = F.vcu; it < NL * 48; it += F.G) {
            const int l = it / 48, cg = it % 48, cj = F.tid & 127, kq = F.tid >> 7, col = cg * 128 + cj;
            float acc[32];
#pragma unroll
            for (int b = 0; b < 32; ++b) acc[b] = 0.f;
            for (int kc = 0; kc < 8; ++kc) {
                __syncthreads();
#pragma unroll
                for (int i = 0; i < 8; ++i) { const int idx = F.tid + 512 * i, b = idx & 31, kk = idx >> 5; const float v = P->c[b * 1024 + kc * 128 + kk];
                    cact[kk * 32 + b] = v * __builtin_amdgcn_rcpf(1.0f + ex2(-v * LOG2E)); }
                __syncthreads();
                for (int k2 = 0; k2 < 32; ++k2) { const int kk = kq * 32 + k2; const float w = P->w_ada[((size_t)l * 1024 + kc * 128 + kk) * 6144 + col];
#pragma unroll
                    for (int b4 = 0; b4 < 8; ++b4) { const f32x4 cv = *(const LAS f32x4*)(cact + kk * 32 + 4 * b4);
                        const f32x2 lo = (f32x2){cv[0], cv[1]} * w + (f32x2){acc[4 * b4], acc[4 * b4 + 1]}, hi = (f32x2){cv[2], cv[3]} * w + (f32x2){acc[4 * b4 + 2], acc[4 * b4 + 3]};
                        acc[4 * b4] = lo[0]; acc[4 * b4 + 1] = lo[1]; acc[4 * b4 + 2] = hi[0]; acc[4 * b4 + 3] = hi[1]; } }
            }
#pragma unroll
            for (int b = 0; b < 32; ++b) red[(kq * 32 + b) * 128 + cj] = acc[b];
            __syncthreads();
#pragma unroll
            for (int i = 0; i < 8; ++i) { const int idx = F.tid + 512 * i, b = idx >> 7, c2 = idx & 127;
                const float s = red[(0 * 32 + b) * 128 + c2] + red[(1 * 32 + b) * 128 + c2] + red[(2 * 32 + b) * 128 + c2] + red[(3 * 32 + b) * 128 + c2];
                mod[((size_t)l * 32 + b) * 6144 + cg * 128 + c2] = s + P->b_ada[l * 6144 + cg * 128 + c2]; }
            __syncthreads();
        }
    }
}

__device__ __forceinline__ void bf8_to_f(const u32x4 w, float (&o)[8]) {
    o[0] = __builtin_bit_cast(float, w.x << 16); o[1] = __builtin_bit_cast(float, w.x & 0xffff0000u); o[2] = __builtin_bit_cast(float, w.y << 16); o[3] = __builtin_bit_cast(float, w.y & 0xffff0000u);
    o[4] = __builtin_bit_cast(float, w.z << 16); o[5] = __builtin_bit_cast(float, w.z & 0xffff0000u); o[6] = __builtin_bit_cast(float, w.w << 16); o[7] = __builtin_bit_cast(float, w.w & 0xffff0000u);
}
template <int MODE>
__device__ __forceinline__ void norm_phase(KP Pq, Frame& F, int l) {
    F.tid = opaque_tid(F.wave0); F.lane = F.tid & 63; F.wave = opq_s(F.wave0); F.vcu = opq_s(F.vcu0); F.G = opq_s(F.G0); const KP P = kp_fresh(); (void)Pq;
    unsigned char* ws = P->ws;
    const float* mod = (const float*)(ws + WS_MOD);
    bf16* X = (bf16*)(ws + WS_X);
    unsigned char* H = (unsigned char*)(ws + WS_H);
    const unsigned char* SL = (const unsigned char*)(ws + WS_SLOT);
    const int gw = F.vcu * 8 + F.wave, NGW = F.G * 8, lane = F.lane;
    for (int tok0 = gw * 2; tok0 < T; tok0 += NGW * 2) {
        const int b = tok0 >> 11;
        float v[2][2][8];
#pragma unroll
        for (int tt = 0; tt < 2; ++tt)
#pragma unroll
            for (int j = 0; j < 2; ++j) { const size_t off = (size_t)(tok0 + tt) * DM + 8 * lane + 512 * j;
                if (MODE == 0) { const f32x4 a = *(const f32x4*)(P->x + off), c = *(const f32x4*)(P->x + off + 4);
                    v[tt][j][0] = a[0]; v[tt][j][1] = a[1]; v[tt][j][2] = a[2]; v[tt][j][3] = a[3]; v[tt][j][4] = c[0]; v[tt][j][5] = c[1]; v[tt][j][6] = c[2]; v[tt][j][7] = c[3]; }
                else bf8_to_f(*(const u32x4*)(X + off), v[tt][j]); }
        if (MODE == 1 || MODE == 2) {
            const float* g2 = mod + ((size_t)((MODE == 1 ? l - 1 : NL - 1) * 32 + b)) * 6144 + 5 * 1024;
#pragma unroll
            for (int j = 0; j < 2; ++j) {
                const f32x4 ga = *(const f32x4*)(g2 + 8 * lane + 512 * j), gb = *(const f32x4*)(g2 + 8 * lane + 512 * j + 4);
#pragma unroll
                for (int tt = 0; tt < 2; ++tt) {
                    u32x2 w[4];
#pragma unroll
                    for (int k = 0; k < 4; ++k) w[k] = *(const u32x2*)(SL + ((size_t)(tok0 + tt) * 4 + k) * DM + 8 * lane + 512 * j);
                    float sacc[8] = {0.f, 0.f, 0.f, 0.f, 0.f, 0.f, 0.f, 0.f};
#pragma unroll
                    for (int k = 0; k < 4; ++k) {
                        const f32x2 a0 = __builtin_amdgcn_cvt_pk_f32_fp8((int)w[k].x, false), a1 = __builtin_amdgcn_cvt_pk_f32_fp8((int)w[k].x, true), a2 = __builtin_amdgcn_cvt_pk_f32_fp8((int)w[k].y, false), a3 = __builtin_amdgcn_cvt_pk_f32_fp8((int)w[k].y, true);
                        sacc[0] += a0[0]; sacc[1] += a0[1]; sacc[2] += a1[0]; sacc[3] += a1[1]; sacc[4] += a2[0]; sacc[5] += a2[1]; sacc[6] += a3[0]; sacc[7] += a3[1]; }
#pragma unroll
                    for (int i = 0; i < 8; ++i) v[tt][j][i] += (i < 4 ? ga[i] : gb[i - 4]) * (sacc[i] * 0.03125f);
                    if (MODE == 1) { u32x4 o; o.x = pk2(v[tt][j][0], v[tt][j][1]); o.y = pk2(v[tt][j][2], v[tt][j][3]); o.z = pk2(v[tt][j][4], v[tt][j][5]); o.w = pk2(v[tt][j][6], v[tt][j][7]);
                        *(u32x4*)(X + (size_t)(tok0 + tt) * DM + 8 * lane + 512 * j) = o; bf8_to_f(o, v[tt][j]); }
                }
            }
        }
        float rstd[2];
#pragma unroll
        for (int tt = 0; tt < 2; ++tt) { float ss = 0.f;
#pragma unroll
            for (int j = 0; j < 2; ++j)
#pragma unroll
                for (int i = 0; i < 8; i += 2) ss += v[tt][j][i] * v[tt][j][i] + v[tt][j][i + 1] * v[tt][j][i + 1];
            rstd[tt] = __builtin_amdgcn_rsqf(wave_sum(ss) * (1.0f / DM) + 1e-6f); }
        if (MODE == 2) {
#pragma unroll
            for (int j = 0; j < 2; ++j) { const f32x4 ga = *(const f32x4*)(P->final_g + 8 * lane + 512 * j), gb = *(const f32x4*)(P->final_g + 8 * lane + 512 * j + 4);
#pragma unroll
                for (int tt = 0; tt < 2; ++tt) { float* o = P->out + (size_t)(tok0 + tt) * DM + 8 * lane + 512 * j;
                    *(f32x4*)o = (f32x4){v[tt][j][0], v[tt][j][1], v[tt][j][2], v[tt][j][3]} * rstd[tt] * ga; *(f32x4*)(o + 4) = (f32x4){v[tt][j][4], v[tt][j][5], v[tt][j][6], v[tt][j][7]} * rstd[tt] * gb; } }
        } else {
            const float* gn = P->norm1_g + l * DM;
            const float* mb = mod + ((size_t)(l * 32 + b)) * 6144;
#pragma unroll
            for (int j = 0; j < 2; ++j) {
                const int c0 = 8 * lane + 512 * j;
                float g8[8], sh8[8], sc8[8];
                { const f32x4 a = *(const f32x4*)(gn + c0), c = *(const f32x4*)(gn + c0 + 4), d = *(const f32x4*)(mb + c0), e = *(const f32x4*)(mb + c0 + 4), f = *(const f32x4*)(mb + 1024 + c0), g = *(const f32x4*)(mb + 1024 + c0 + 4);
#pragma unroll
                  for (int i = 0; i < 4; ++i) { g8[i] = a[i]; g8[4 + i] = c[i]; sh8[i] = d[i]; sh8[4 + i] = e[i]; sc8[i] = f[i] + 1.0f; sc8[4 + i] = g[i] + 1.0f; } }
#pragma unroll
                for (int tt = 0; tt < 2; ++tt) { float h[8];
#pragma unroll
                    for (int i = 0; i < 8; ++i) h[i] = (v[tt][j][i] * rstd[tt] * g8[i]) * sc8[i] + sh8[i];
                    u32x2 o; o.x = (unsigned)pg8::fp8x4(h[0], h[1], h[2], h[3]); o.y = (unsigned)pg8::fp8x4(h[4], h[5], h[6], h[7]);
                    *(u32x2*)(H + (size_t)(tok0 + tt) * DM + c0) = o; }
            }
        }
    }
}

template <bool DRY> __device__ __forceinline__ void prep_phase(KP Pq, Frame& F, int l) {
    F.tid = opaque_tid(F.wave0); F.lane = F.tid & 63; F.wave = opq_s(F.wave0); F.vcu = opq_s(F.vcu0); F.G = opq_s(F.G0); const KP P = kp_fresh(); (void)Pq;
    unsigned char* ws = P->ws;
    bf16* PR = (bf16*)(ws + WS_PROJ);
    bf16* KB = (bf16*)(ws + WS_KB); bf16* VBT = (bf16*)(ws + WS_VBT);
    float* LF = (float*)(ws + WS_LF);
    const float* rt = (const float*)(ws + WS_ROPE);
    const float* cos64 = rt, * sin64 = rt + SEQ * 32, * cos32 = rt + SEQ * 64, * sin32 = rt + SEQ * 64 + SEQ * 16;
    LAS bf16* ltile = (LAS bf16*)(F.lds);
    LAS bf16* vst = (LAS bf16*)(F.lds + 32768);
    const int tid = F.tid, lane = F.lane, wv = F.wave, fr = lane & 15, fq = lane >> 4;
    const int half = wv >> 2, p = wv & 1, th = (wv >> 1) & 1;
    bf16x8 wf[2][4];
    { const float* W = (half ? P->w_uv : P->w_uk) + l * 8192;
#pragma unroll
      for (int dd = 0; dd < 2; ++dd)
#pragma unroll
          for (int ks = 0; ks < 4; ++ks) { float f[8];
#pragma unroll
              for (int j = 0; j < 8; ++j) f[j] = W[(ks * 32 + fq * 8 + j) * 64 + (p + 2 * dd) * 16 + fr];
              u32x4 w; w.x = pk2(f[0], f[1]); w.y = pk2(f[2], f[3]); w.z = pk2(f[4], f[5]); w.w = pk2(f[6], f[7]); wf[dd][ks] = __builtin_bit_cast(bf16x8, w); } }
    const f32x2 kg = *(const f32x2*)(P->kv_norm_g + l * 128 + 2 * lane);
    for (int u = F.vcu; u < T / 64; u += F.G) {
        const int tok0 = u * 64, b = u >> 5, t0 = (u & 31) * 64;
        __syncthreads();
        {
            const int tl = tid >> 3, sub = tid & 7, t = t0 + tl;
            bf16* row = PR + (size_t)(tok0 + tl) * NP;
            {
                const f32x4 cs = *(const f32x4*)(cos64 + t * 32 + sub * 4), sn = *(const f32x4*)(sin64 + t * 32 + sub * 4);
                u32x2 a[4], c[4];
#pragma unroll
                for (int hh = 0; hh < 4; ++hh) { a[hh] = *(const u32x2*)(row + C_QB + hh * 64 + sub * 4); c[hh] = *(const u32x2*)(row + C_QB + hh * 64 + 32 + sub * 4); }
#pragma unroll
                for (int hh = 0; hh < 4; ++hh) {
                    const float x10 = bf2f(a[hh].x & 0xffffu), x11 = bf2f(a[hh].x >> 16), x12 = bf2f(a[hh].y & 0xffffu), x13 = bf2f(a[hh].y >> 16);
                    const float x20 = bf2f(c[hh].x & 0xffffu), x21 = bf2f(c[hh].x >> 16), x22 = bf2f(c[hh].y & 0xffffu), x23 = bf2f(c[hh].y >> 16);
                    u32x2 o1, o2;
                    o1.x = pk2(x10 * cs[0] - x20 * sn[0], x11 * cs[1] - x21 * sn[1]); o1.y = pk2(x12 * cs[2] - x22 * sn[2], x13 * cs[3] - x23 * sn[3]);
                    o2.x = pk2(x10 * sn[0] + x20 * cs[0], x11 * sn[1] + x21 * cs[1]); o2.y = pk2(x12 * sn[2] + x22 * cs[2], x13 * sn[3] + x23 * cs[3]);
                    if (!DRY) { *(u32x2*)(row + C_QB + hh * 64 + sub * 4) = o1; *(u32x2*)(row + C_QB + hh * 64 + 32 + sub * 4) = o2; }
                    else if (o1.x == 0x12345678u && o2.y == 0x9abcdef0u) LF[0] = 0.f;
                }
            }
            {
                const int ih = sub >> 1, i8 = (sub & 1) * 8;
                const f32x4 cs0 = *(const f32x4*)(cos32 + t * 16 + i8), cs1 = *(const f32x4*)(cos32 + t * 16 + i8 + 4), sn0 = *(const f32x4*)(sin32 + t * 16 + i8), sn1 = *(const f32x4*)(sin32 + t * 16 + i8 + 4);
                bf16* bq = row + C_QI + ih * 32 + i8; bf16* bk = row + C_KI + i8;
                const u32x4 qa = *(const u32x4*)bq, qc = *(const u32x4*)(bq + 16);
                u32x4 ka = qa, kc = qc;
                if (sub < 2) { ka = *(const u32x4*)bk; kc = *(const u32x4*)(bk + 16); }
#pragma unroll
                for (int which = 0; which < 2; ++which) {
                    float x1[8], x2[8]; bf8_to_f(which ? ka : qa, x1); bf8_to_f(which ? kc : qc, x2);
                    float o1[8], o2[8];
#pragma unroll
                    for (int i = 0; i < 8; ++i) { const float cc = (i < 4) ? cs0[i & 3] : cs1[i & 3], ss = (i < 4) ? sn0[i & 3] : sn1[i & 3]; o1[i] = x1[i] * cc - x2[i] * ss; o2[i] = x1[i] * ss + x2[i] * cc; }
                    u32x4 w1, w2; w1.x = pk2(o1[0], o1[1]); w1.y = pk2(o1[2], o1[3]); w1.z = pk2(o1[4], o1[5]); w1.w = pk2(o1[6], o1[7]);
                    w2.x = pk2(o2[0], o2[1]); w2.y = pk2(o2[2], o2[3]); w2.z = pk2(o2[4], o2[5]); w2.w = pk2(o2[6], o2[7]);
                    if (!DRY) { if (which == 0) { *(u32x4*)bq = w1; *(u32x4*)(bq + 16) = w2; } else if (sub < 2) { *(u32x4*)bk = w1; *(u32x4*)(bk + 16) = w2; } }
                    else if (w1.x == 0x12345678u && w2.y == 0x9abcdef0u) LF[0] = 0.f;
                }
            }
            if (sub == 2) {
                const u32x2 w = *(const u32x2*)(row + C_FA);
                const float fa[4] = {bf2f(w.x & 0xffffu), bf2f(w.x >> 16), bf2f(w.y & 0xffffu), bf2f(w.y >> 16)};
#pragma unroll
                for (int hh = 0; hh < 4; ++hh) { const float z = fa[hh] + P->b_forget[l * 4 + hh];
                    LF[((size_t)(b * 4 + hh)) * SEQ + t] = fminf(z, 0.f) - 0.6931471805599453f * lg2(1.0f + ex2(-fabsf(z) * LOG2E)); }
            }
        }
        {
            unsigned lw[8];
#pragma unroll
            for (int i = 0; i < 8; ++i) lw[i] = *(const unsigned*)(PR + (size_t)(tok0 + wv * 8 + i) * NP + C_LAT + 2 * lane);
#pragma unroll
            for (int i = 0; i < 8; ++i) { const float a0 = bf2f(lw[i] & 0xffffu), a1 = bf2f(lw[i] >> 16);
                const float rstd = __builtin_amdgcn_rsqf(wave_sum(a0 * a0 + a1 * a1) * (1.0f / 128.0f) + 1e-6f);
                *(LAS unsigned*)(ltile + (wv * 8 + i) * 136 + 2 * lane) = pk2(a0 * rstd * kg[0], a1 * rstd * kg[1]); }
        }
        __syncthreads();
        {
            f32x4 acc[2][2];
#pragma unroll
            for (int dd = 0; dd < 2; ++dd)
#pragma unroll
                for (int tt = 0; tt < 2; ++tt) acc[dd][tt] = zero4();
#pragma unroll
            for (int tt = 0; tt < 2; ++tt)
#pragma unroll
                for (int ks = 0; ks < 4; ++ks) { const bf16x8 bfr = *(const LAS bf16x8*)(ltile + ((2 * th + tt) * 16 + fr) * 136 + ks * 32 + fq * 8);
#pragma unroll
                    for (int dd = 0; dd < 2; ++dd) acc[dd][tt] = __builtin_amdgcn_mfma_f32_16x16x32_bf16(wf[dd][ks], bfr, acc[dd][tt], 0, 0, 0); }
#pragma unroll
            for (int tt = 0; tt < 2; ++tt) { const int tl = (2 * th + tt) * 16 + fr, t = t0 + tl;
                if (half == 0) {
                    const int d1 = p * 16 + fq * 4;
                    const f32x4 cs = *(const f32x4*)(cos64 + t * 32 + d1), sn = *(const f32x4*)(sin64 + t * 32 + d1);
                    const f32x4 x1 = acc[0][tt], x2 = acc[1][tt];
                    const f32x4 o1 = x1 * cs - x2 * sn, o2 = x1 * sn + x2 * cs;
                    u32x2 w1, w2; w1.x = pk2(o1[0], o1[1]); w1.y = pk2(o1[2], o1[3]); w2.x = pk2(o2[0], o2[1]); w2.y = pk2(o2[2], o2[3]);
                    *(u32x2*)(KB + (size_t)(tok0 + tl) * 64 + d1) = w1; *(u32x2*)(KB + (size_t)(tok0 + tl) * 64 + 32 + d1) = w2;
                } else {
#pragma unroll
                    for (int dd = 0; dd < 2; ++dd)
#pragma unroll
                        for (int j = 0; j < 4; ++j) vst[((p + 2 * dd) * 16 + fq * 4 + j) * 72 + tl] = (bf16)f2bf(acc[dd][tt][j]);
                }
            }
        }
        __syncthreads();
        { const int d = tid >> 3, oct = tid & 7;
          *(u32x4*)(VBT + ((size_t)(b * 64 + d)) * SEQ + t0 + oct * 8) = *(const LAS u32x4*)(vst + d * 72 + oct * 8); }
    }
    __syncthreads();
}

__device__ __forceinline__ void idx_scores(const bf16x8 (&kif)[2], const bf16x8 (&qif)[4], const float (&wq)[4], unsigned (&sk)[8]) {
#pragma unroll
    for (int t = 0; t < 2; ++t) {
        const f32x4 z = {0.f, 0.f, 0.f, 0.f};
        const f32x4 a0 = __builtin_amdgcn_mfma_f32_16x16x32_bf16(kif[t], qif[0], z, 0, 0, 0);
        const f32x4 a1 = __builtin_amdgcn_mfma_f32_16x16x32_bf16(kif[t], qif[1], z, 0, 0, 0);
        const f32x4 a2 = __builtin_amdgcn_mfma_f32_16x16x32_bf16(kif[t], qif[2], z, 0, 0, 0);
        const f32x4 a3 = __builtin_amdgcn_mfma_f32_16x16x32_bf16(kif[t], qif[3], z, 0, 0, 0);
#pragma unroll
        for (int j = 0; j < 4; ++j) {
            const float r0 = fmaxf(a0[j], 0.f), r1 = fmaxf(a1[j], 0.f), r2 = fmaxf(a2[j], 0.f), r3 = fmaxf(a3[j], 0.f);
            float v = wq[0] * r0; v = __builtin_fmaf(wq[1], r1, v); v = __builtin_fmaf(wq[2], r2, v); v = __builtin_fmaf(wq[3], r3, v);
            unsigned u = __builtin_bit_cast(unsigned, v); u = (u == 0x80000000u) ? 0u : u;
            sk[t * 4 + j] = (u & 0x80000000u) ? ~u : (u | 0x80000000u);
        }
    }
}

__device__ __forceinline__ unsigned wave_total(unsigned c) {
    c += (unsigned)__builtin_amdgcn_update_dpp(0, (int)c, 0x111, 0xf, 0xf, true);
    c += (unsigned)__builtin_amdgcn_update_dpp(0, (int)c, 0x112, 0xf, 0xf, true);
    c += (unsigned)__builtin_amdgcn_update_dpp(0, (int)c, 0x114, 0xf, 0xf, true);
    c += (unsigned)__builtin_amdgcn_update_dpp(0, (int)c, 0x118, 0xf, 0xf, true);
    return (unsigned)__builtin_amdgcn_readlane((int)c, 15) + (unsigned)__builtin_amdgcn_readlane((int)c, 31) + (unsigned)__builtin_amdgcn_readlane((int)c, 47) + (unsigned)__builtin_amdgcn_readlane((int)c, 63);
}
__device__ __forceinline__ unsigned bfi32(unsigned m, unsigned a, unsigned b) { return (m & a) | (~m & b); }
__device__ __forceinline__ void bit_transpose32(unsigned (&a)[32]) {
#pragma unroll
    for (int i = 0; i < 32; ++i) if (!(i & 16)) { const unsigned lo = a[i], hi = a[i + 16]; a[i] = __builtin_amdgcn_perm(hi, lo, 0x05040100u); a[i + 16] = __builtin_amdgcn_perm(hi, lo, 0x07060302u); }
#pragma unroll
    for (int i = 0; i < 32; ++i) if (!(i & 8)) { const unsigned lo = a[i], hi = a[i + 8]; a[i] = __builtin_amdgcn_perm(hi, lo, 0x06020400u); a[i + 8] = __builtin_amdgcn_perm(hi, lo, 0x07030501u); }
#pragma unroll
    for (int i = 0; i < 32; ++i) if (!(i & 4)) { const unsigned lo = a[i], hi = a[i + 4]; a[i] = bfi32(0x0f0f0f0fu, lo, hi << 4); a[i + 4] = bfi32(0x0f0f0f0fu, lo >> 4, hi); }
#pragma unroll
    for (int i = 0; i < 32; ++i) if (!(i & 2)) { const unsigned lo = a[i], hi = a[i + 2]; a[i] = bfi32(0x33333333u, lo, hi << 2); a[i + 2] = bfi32(0x33333333u, lo >> 2, hi); }
#pragma unroll
    for (int i = 0; i < 32; ++i) if (!(i & 1)) { const unsigned lo = a[i], hi = a[i + 1]; a[i] = bfi32(0x55555555u, lo, hi << 1); a[i + 1] = bfi32(0x55555555u, lo >> 1, hi); }
}
__device__ __forceinline__ unsigned low_n_set(unsigned eq, int n) {
    unsigned I = 0u;
#pragma unroll
    for (int bit = 16; bit >= 1; bit >>= 1) { const unsigned cand = I + (unsigned)bit; if ((int)__builtin_popcount(eq & ((1u << cand) - 1u)) < n) I = cand; }
    const unsigned r = eq & (I >= 31u ? 0xffffffffu : ((2u << I) - 1u));
    return (n <= 0) ? 0u : (n >= (int)__builtin_popcount(eq)) ? eq : r;
}
__device__ __forceinline__ unsigned tie_take(unsigned eq, unsigned need, int lane) {
    const unsigned e = (unsigned)__builtin_popcount(eq);
    unsigned c = e;
    c += (unsigned)__builtin_amdgcn_update_dpp(0, (int)c, 0x111, 0xf, 0xf, true);
    c += (unsigned)__builtin_amdgcn_update_dpp(0, (int)c, 0x112, 0xf, 0xf, true);
    c += (unsigned)__builtin_amdgcn_update_dpp(0, (int)c, 0x114, 0xf, 0xf, true);
    c += (unsigned)__builtin_amdgcn_update_dpp(0, (int)c, 0x118, 0xf, 0xf, true);
    const unsigned t0 = (unsigned)__builtin_amdgcn_readlane((int)c, 15), t1 = (unsigned)__builtin_amdgcn_readlane((int)c, 31), t2 = (unsigned)__builtin_amdgcn_readlane((int)c, 47);
    const unsigned pre = c - e + (lane >= 16 ? t0 : 0u) + (lane >= 32 ? t1 : 0u) + (lane >= 48 ? t2 : 0u);
    return low_n_set(eq, (int)need - (int)pre);
}
template <int VAR> __device__ __forceinline__ void sel_phase(KP Pq, Frame& F) {
    F.tid = opaque_tid(F.wave0); F.lane = F.tid & 63; F.wave = opq_s(F.wave0); F.vcu = opq_s(F.vcu0); F.G = opq_s(F.G0); const KP P = kp_fresh(); (void)Pq;
    unsigned char* ws = P->ws;
    const bf16* PR = (const bf16*)(ws + WS_PROJ);
    unsigned long long* MASK = (unsigned long long*)(ws + WS_MASK);
    LAS unsigned* keys = (LAS unsigned*)(F.lds);
    constexpr int KST = 2052;
    const int lane = F.lane, fr = lane & 15, fq = lane >> 4, wv = F.wave;
    bf16x8 pq[4], pk[2]; unsigned pw[2];
    auto sel_fetch = [&](int u2) {
        const int c2 = 31 - (u2 >> 7), b2 = (u2 >> 2) & 31, q2 = u2 & 3;
        const bf16* qr = PR + ((size_t)b2 * SEQ + c2 * 64 + q2 * 16 + fr) * NP;
#pragma unroll
        for (int ih = 0; ih < 4; ++ih) pq[ih] = *(const bf16x8*)(qr + C_QI + ih * 32 + fq * 8);
        pw[0] = *(const unsigned*)(qr + C_WI); pw[1] = *(const unsigned*)(qr + C_WI + 2);
        const bf16* kb2 = PR + ((size_t)b2 * SEQ + (fr >> 2) * 8 + (fr & 3)) * NP + C_KI + fq * 8;
        pk[0] = *(const bf16x8*)(kb2 + (size_t)(wv * 32) * NP); pk[1] = *(const bf16x8*)(kb2 + (size_t)(wv * 32 + 4) * NP);
    };
    if (F.vcu < NB * 28 * 4) sel_fetch(F.vcu);
    for (int u = F.vcu; u < NB * 28 * 4; u += F.G) {
        const int c = 31 - (u >> 7), b = (u >> 2) & 31, qt0 = u & 3;
        const int L = (c + 1) * 64, nsteps = L / 32, nr = c + 1;
        const size_t rowb = (size_t)b * SEQ;
        for (int qt = qt0; qt == qt0; ++qt) {
            __syncthreads();
            {
                bf16x8 qif[4]; float wq[4];
#pragma unroll
                for (int ih = 0; ih < 4; ++ih) { qif[ih] = pq[ih]; wq[ih] = bf2f((pw[ih >> 1] >> (16 * (ih & 1))) & 0xffffu) * (0.5f * RS32); }
                const bf16* kbase = PR + (rowb + (fr >> 2) * 8 + (fr & 3)) * NP + C_KI + fq * 8;
                bf16x8 kif[2], kin[2];
                int s = wv;
                kif[0] = pk[0]; kif[1] = pk[1];
                for (; s < (VAR == 2 ? 0 : nsteps); s += 8) {
                    const int sn = s + 8;
                    if (sn < nsteps) { kin[0] = *(const bf16x8*)(kbase + (size_t)(sn * 32) * NP); kin[1] = *(const bf16x8*)(kbase + (size_t)(sn * 32 + 4) * NP); }
                    unsigned sk[8]; idx_scores(kif, qif, wq, sk);
                    LAS unsigned* dst = keys + fr * KST + s * 32; const int x = (s >> 1) & 7;
                    *(LAS u32x4*)(dst + 4 * ((2 * fq) ^ x)) = (u32x4){sk[0], sk[1], sk[2], sk[3]}; *(LAS u32x4*)(dst + 4 * ((2 * fq + 1) ^ x)) = (u32x4){sk[4], sk[5], sk[6], sk[7]};
                    kif[0] = kin[0]; kif[1] = kin[1];
                }
            }
            __syncthreads();
            if (u + F.G < NB * 28 * 4) sel_fetch(u + F.G);
            {
                unsigned pA[32], pB[32];
                const int sw = (lane >> 1) & 7;
                const LAS unsigned* krA = keys + (wv * 2) * KST + 32 * lane; const LAS unsigned* krB = krA + KST;
#pragma unroll
                for (int cc = 0; cc < 8; ++cc) { const u32x4 v = *(const LAS u32x4*)(krA + 4 * (cc ^ sw)); pA[4 * cc] = v.x; pA[4 * cc + 1] = v.y; pA[4 * cc + 2] = v.z; pA[4 * cc + 3] = v.w; }
#pragma unroll
                for (int cc = 0; cc < 8; ++cc) { const u32x4 v = *(const LAS u32x4*)(krB + 4 * (cc ^ sw)); pB[4 * cc] = v.x; pB[4 * cc + 1] = v.y; pB[4 * cc + 2] = v.z; pB[4 * cc + 3] = v.w; }
                bit_transpose32(pA); bit_transpose32(pB);
                unsigned eqA = (lane < nsteps) ? 0xffffffffu : 0u, eqB = eqA, gtA = 0u, gtB = 0u;
                unsigned GA = 0u, GB = 0u;
#define SEL_BIT(b) if (!done) { \
                    const unsigned xA = eqA & pA[b], xB = eqB & pB[b]; \
                    const unsigned tot = wave_total((unsigned)__builtin_popcount(xA) | ((unsigned)__builtin_popcount(xB) << 16)); \
                    const unsigned nA = GA + (tot & 0xffffu), nB = GB + (tot >> 16); \
                    const unsigned kA = (nA > 256u) ? 0u : 0xffffffffu, kB = (nB > 256u) ? 0u : 0xffffffffu; \
                    gtA |= xA & kA; eqA = xA ^ (eqA & kA); GA = (nA > 256u) ? GA : nA; \
                    gtB |= xB & kB; eqB = xB ^ (eqB & kB); GB = (nB > 256u) ? GB : nB; \
                    if (((b) & 1) == 0) done = (GA == 256u) && (GB == 256u); }
                bool done = false;
                SEL_BIT(31) SEL_BIT(30) SEL_BIT(29) SEL_BIT(28) SEL_BIT(27) SEL_BIT(26) SEL_BIT(25) SEL_BIT(24) SEL_BIT(23) SEL_BIT(22) SEL_BIT(21) SEL_BIT(20) SEL_BIT(19) SEL_BIT(18) SEL_BIT(17) SEL_BIT(16)
                SEL_BIT(15) SEL_BIT(14) SEL_BIT(13) SEL_BIT(12) SEL_BIT(11) SEL_BIT(10) SEL_BIT(9) SEL_BIT(8) SEL_BIT(7) SEL_BIT(6) SEL_BIT(5) SEL_BIT(4) SEL_BIT(3) SEL_BIT(2) SEL_BIT(1) SEL_BIT(0)
#undef SEL_BIT
                const bool exA = (GA == 256u), exB = (GB == 256u);
                if (!exA) gtA |= tie_take(eqA, 256u - GA, lane);
                if (!exB) gtB |= tie_take(eqB, 256u - GB, lane);
                unsigned* M32 = (unsigned*)MASK + (rowb + c * 64 + qt * 16 + wv * 2) * 64 + lane;
                { u32x4 q0 = __builtin_bit_cast(u32x4, pq[0]), q1 = __builtin_bit_cast(u32x4, pq[1]), q2 = __builtin_bit_cast(u32x4, pq[2]), q3 = __builtin_bit_cast(u32x4, pq[3]), k0 = __builtin_bit_cast(u32x4, pk[0]), k1 = __builtin_bit_cast(u32x4, pk[1]);
                  asm volatile("" : "+v"(q0), "+v"(q1), "+v"(q2), "+v"(q3), "+v"(k0), "+v"(k1), "+v"(pw[0]), "+v"(pw[1]));
                  pq[0] = __builtin_bit_cast(bf16x8, q0); pq[1] = __builtin_bit_cast(bf16x8, q1); pq[2] = __builtin_bit_cast(bf16x8, q2); pq[3] = __builtin_bit_cast(bf16x8, q3); pk[0] = __builtin_bit_cast(bf16x8, k0); pk[1] = __builtin_bit_cast(bf16x8, k1); }
                M32[0] = gtA; M32[64] = gtB;
            }
        }
    }
    __syncthreads();
}

constexpr int ATT_KBUF = 0, ATT_VBUF = 16384, ATT_NF = 32768, ATT_FLAG = 40960, ATT_RELT = 49152, RELW = 768, RELO = 640;
__device__ __forceinline__ int kswz(int row) { return ((row >> 3) & 3) * 2 + ((row >> 1) & 1); }
__device__ __forceinline__ int vswz(int row) { return (row >> 1) & 7; }
struct AttnPre { bf16x8 qf[2][2]; u32x4 k0, v0, k1, v1; };
template <int KIND>
__device__ __forceinline__ void attn_fetch(unsigned char* ws, int b, int h, int blk, int tid, AttnPre& R) {
    const int lane = tid & 63, wv = __builtin_amdgcn_readfirstlane(tid >> 6), fr = lane & 15, fq = lane >> 4;
    const size_t rowb = (size_t)b * SEQ;
    constexpr int QCOL = (KIND == 0) ? C_QA : (KIND == 1) ? C_QB : (KIND == 2) ? C_QC : C_QD;
    constexpr int KCOL = (KIND == 0) ? C_KA : (KIND == 2) ? C_KC : C_KD;
    constexpr int VG = (KIND == 0) ? 0 : (KIND == 2) ? 1 : 2;
    constexpr unsigned KPB = (KIND == 1) ? 128u : (unsigned)NP * 2u;
    const char* PRb = (const char*)(ws + WS_PROJ) + rowb * NP * 2;
    const int qw = (KIND == 1) ? blk * 64 + (wv & 3) * 16 : blk * 256 + wv * 32;
    const int hw = (KIND == 1) ? (wv >> 2) * 2 : h;
#pragma unroll
    for (int qi = 0; qi < 2; ++qi)
#pragma unroll
        for (int ks = 0; ks < 2; ++ks) {
            if (KIND == 1) R.qf[qi][ks] = *(const bf16x8*)(PRb + (unsigned)((qw + fr) * NP + QCOL + (hw + qi) * 64 + ks * 32 + fq * 8) * 2u);
            else R.qf[qi][ks] = *(const bf16x8*)(PRb + (unsigned)((qw + 16 * qi + fr) * NP + QCOL + hw * 64 + ks * 32 + fq * 8) * 2u);
        }
    const char* Kb; const char* Vtb;
    if (KIND == 1) { Kb = (const char*)(ws + WS_KB) + rowb * 128; Vtb = (const char*)(ws + WS_VBT) + (size_t)b * 64 * SEQ * 2; }
    else { Kb = PRb + (KCOL + h * 64) * 2; Vtb = (const char*)(ws + WS_VT) + ((size_t)((VG * NB + b) * 4 + h) * 64) * SEQ * 2; }
    const int srow = tid >> 3, ssl = tid & 7;
    const unsigned kgoff = (unsigned)srow * KPB + (unsigned)((ssl ^ kswz(srow)) * 16);
    const unsigned vgoff = (unsigned)(srow * SEQ * 2) + (unsigned)((ssl ^ vswz(srow)) * 16);
    int s_first, s_last, s_dir;
    if (KIND == 0) { s_first = 0; s_last = blk * 4 + 3; s_dir = 1; }
    else if (KIND == 1) { s_first = 0; s_last = blk; s_dir = 1; }
    else if (KIND == 2) { s_first = blk * 4 + 3; s_last = 0; s_dir = -1; }
    else { s_first = blk * 4 - 8 < 0 ? 0 : blk * 4 - 8; s_last = blk * 4 + 3; s_dir = 1; }
    R.k0 = *(const u32x4*)(Kb + (size_t)(s_first * 64) * KPB + kgoff); R.v0 = *(const u32x4*)(Vtb + (size_t)(s_first * 128) + vgoff);
    R.k1 = R.k0; R.v1 = R.v0;
    if (s_first != s_last) { R.k1 = *(const u32x4*)(Kb + (size_t)((s_first + s_dir) * 64) * KPB + kgoff); R.v1 = *(const u32x4*)(Vtb + (size_t)((s_first + s_dir) * 128) + vgoff); }
}
template <int KIND>
__device__ __forceinline__ void attn_wg(unsigned char* ws, int b, int h, int blk, LAS unsigned char* lds, int wave_s, AttnPre& pre, bool hn, int nb, int nh, int nblk) {
    const int tid = opaque_tid(wave_s), lane = tid & 63, wv = __builtin_amdgcn_readfirstlane(tid >> 6);
    const int fr = lane & 15, fq = lane >> 4;
    const size_t rowb = (size_t)b * SEQ;
    constexpr int QCOL = (KIND == 0) ? C_QA : (KIND == 1) ? C_QB : (KIND == 2) ? C_QC : C_QD;
    constexpr int KCOL = (KIND == 0) ? C_KA : (KIND == 2) ? C_KC : C_KD;
    constexpr int YCOL = (KIND == 0) ? 0 : (KIND == 1) ? 256 : (KIND == 2) ? 512 : 768;
    constexpr int VG = (KIND == 0) ? 0 : (KIND == 2) ? 1 : 2;
    constexpr unsigned KPB = (KIND == 1) ? 128u : (unsigned)NP * 2u;
    const char* PRb = (const char*)(ws + WS_PROJ) + rowb * NP * 2;
    const int qw = (KIND == 1) ? blk * 64 + (wv & 3) * 16 : blk * 256 + wv * 32;
    const int hw = (KIND == 1) ? (wv >> 2) * 2 : h;
    bf16x8 qf[2][2];
#pragma unroll
    for (int qi = 0; qi < 2; ++qi)
#pragma unroll
        for (int ks = 0; ks < 2; ++ks) qf[qi][ks] = pre.qf[qi][ks];
    const char* Kb; const char* Vtb;
    if (KIND == 1) { Kb = (const char*)(ws + WS_KB) + rowb * 128; Vtb = (const char*)(ws + WS_VBT) + (size_t)b * 64 * SEQ * 2; }
    else { Kb = PRb + (KCOL + h * 64) * 2; Vtb = (const char*)(ws + WS_VT) + ((size_t)((VG * NB + b) * 4 + h) * 64) * SEQ * 2; }
    const int srow = tid >> 3, ssl = tid & 7;
    const unsigned kgoff = (unsigned)srow * KPB + (unsigned)((ssl ^ kswz(srow)) * 16);
    const unsigned vgoff = (unsigned)(srow * SEQ * 2) + (unsigned)((ssl ^ vswz(srow)) * 16);
    LAS unsigned char* kst = lds + ATT_KBUF + tid * 16; LAS unsigned char* vst = lds + ATT_VBUF + tid * 16;
    const int krow0 = (fr >> 2) * 8 + (fr & 3);
    const int kro0 = krow0 * 128 + ((fq ^ kswz(krow0)) * 16), kro1 = krow0 * 128 + (((4 + fq) ^ kswz(krow0)) * 16);
    const int vro0 = fr * 128 + ((fq ^ vswz(fr)) * 16), vro1 = fr * 128 + (((4 + fq) ^ vswz(fr)) * 16);
    const unsigned char* mrow = (const unsigned char*)(ws + WS_MASK) + (rowb + qw + fr) * 256;
    const bool sel_all = (KIND != 1) || (blk < 4);
    LAS float* nf = (LAS float*)(lds + ATT_NF);
    const LAS float* relt = (const LAS float*)(lds + ATT_RELT);
    LAS unsigned* flags = (LAS unsigned*)(lds + ATT_FLAG);
    int s_first, s_last, s_dir;
    if (KIND == 0) { s_first = 0; s_last = blk * 4 + 3; s_dir = 1; }
    else if (KIND == 1) { s_first = 0; s_last = blk; s_dir = 1; }
    else if (KIND == 2) { s_first = blk * 4 + 3; s_last = 0; s_dir = -1; }
    else { s_first = blk * 4 - 8 < 0 ? 0 : blk * 4 - 8; s_last = blk * 4 + 3; s_dir = 1; }
    u32x4 kreg = pre.k1, vreg = pre.v1;
    __syncthreads();
    { const u32x4 k0 = pre.k0, v0 = pre.v0; *(LAS u32x4*)(kst) = k0; *(LAS u32x4*)(vst) = v0; }
    bool fetched = false;
    f32x4 O[2][4];
#pragma unroll
    for (int qi = 0; qi < 2; ++qi)
#pragma unroll
        for (int dt = 0; dt < 4; ++dt) O[qi][dt] = zero4();
    float NINF = -INFINITY; unsigned ONE2 = 0x3f803f80u; asm volatile("" : "+v"(NINF), "+v"(ONE2));
    float mrun[2], mref[2]; f32x4 Ol[2];
#pragma unroll
    for (int qi = 0; qi < 2; ++qi) { mrun[qi] = (KIND == 2) ? 0.f : NINF; mref[qi] = 0.f; Ol[qi] = zero4(); }
    bf16x8 ones8;
    { u32x4 o1; o1.x = ONE2; o1.y = ONE2; o1.z = ONE2; o1.w = ONE2; ones8 = __builtin_bit_cast(bf16x8, o1); }
    const bool hi1 = (fq & 1) == 0, hi2 = (fq & 2) == 0;
    bool wdone = false;
    __syncthreads();
    int s = s_first, cur = 0;
    for (;;) {
        const bool has_next = (s != s_last);
        if (!has_next && hn) { attn_fetch<(KIND + 1) & 3>(ws, nb, nh, nblk, tid, pre); fetched = true; }
        unsigned long long mbits = ~0ull;
        if (KIND == 1 && !sel_all) mbits = *(const unsigned long long*)(mrow + s * 8);
        const LAS unsigned char* kbuf = lds + ATT_KBUF + cur * 8192; const LAS unsigned char* vbuf = lds + ATT_VBUF + cur * 8192;
#pragma unroll
        for (int jj2 = 0; jj2 < 2; ++jj2) {
            const int j = (KIND == 2) ? 1 - jj2 : jj2;
            const int kb0 = s * 64 + j * 32;
            bool active;
            if (KIND == 0) active = (kb0 <= qw + 31);
            else if (KIND == 1) active = true;
            else if (KIND == 2) active = (kb0 <= qw + 30) && !wdone;
            else { const int c0 = qw & ~63; active = (kb0 >= c0 - 512) && (kb0 < c0 + 64); }
            if (active) {
                bf16x8 kf[2][2], vf[4];
#pragma unroll
                for (int t = 0; t < 2; ++t) { kf[t][0] = *(const LAS bf16x8*)(kbuf + j * 4096 + t * 512 + kro0); kf[t][1] = *(const LAS bf16x8*)(kbuf + j * 4096 + t * 512 + kro1); }
#pragma unroll
                for (int dt = 0; dt < 4; ++dt) vf[dt] = *(const LAS bf16x8*)(vbuf + dt * 2048 + (j ? vro1 : vro0));
                const unsigned selmask = (unsigned)(mbits >> (j * 32 + fq * 8)) & 0xffu;
                unsigned pmask[4];
                if (KIND == 1) {
#pragma unroll
                    for (int i = 0; i < 4; ++i) { const unsigned lo = (unsigned)((int)(selmask << (31 - 2 * i)) >> 31), hi = (unsigned)((int)(selmask << (30 - 2 * i)) >> 31); pmask[i] = bfi32(0x0000ffffu, lo, hi); }
                }
                float bias[8];
                if (KIND == 0) { const f32x4 b0 = *(const LAS f32x4*)(nf + kb0 + fq * 8), b1 = *(const LAS f32x4*)(nf + kb0 + fq * 8 + 4);
#pragma unroll
                    for (int jx = 0; jx < 4; ++jx) { bias[jx] = b0[jx]; bias[4 + jx] = b1[jx]; } }
                const bool diag = (KIND == 0 || KIND == 2) && (kb0 + 31 >= qw);
#pragma unroll
                for (int qi = 0; qi < 2; ++qi) {
                    f32x4 st[2];
#pragma unroll
                    for (int t = 0; t < 2; ++t) { st[t] = __builtin_amdgcn_mfma_f32_16x16x32_bf16(kf[t][0], qf[qi][0], (f32x4){0.f, 0.f, 0.f, 0.f}, 0, 0, 0);
                        st[t] = __builtin_amdgcn_mfma_f32_16x16x32_bf16(kf[t][1], qf[qi][1], st[t], 0, 0, 0); }
                    const int q = (KIND == 1) ? (qw + fr) : (qw + 16 * qi + fr);
                    bf16x8 pb;
                    if (KIND == 2) {
                        float w[8], sg[8], qv[8];
                        const float carry = mrun[qi];
#pragma unroll
                        for (int jj = 0; jj < 8; ++jj) { const bool valid = !diag || (kb0 + fq * 8 + jj < q);
                            const float a = ex2(fminf(st[jj >> 2][jj & 3] * (-SC2), 120.0f));
                            const float s1 = __builtin_amdgcn_rcpf(1.0f + a);
                            sg[jj] = valid ? s1 : 0.f; qv[jj] = valid ? a * s1 : 1.0f; }
                        float suf[8]; suf[7] = 1.0f;
#pragma unroll
                        for (int jj = 6; jj >= 0; --jj) suf[jj] = suf[jj + 1] * qv[jj + 1];
                        const float tot = lg2(suf[0] * qv[0]);
                        const float t1 = xor16_f(tot, lane), t2 = xor32_f(tot, lane), t3 = xor16_f(t2, lane);
                        const float hi = (hi1 ? t1 : 0.f) + (hi2 ? t2 : 0.f) + (hi2 ? t3 : 0.f);
                        const float eb = ex2(carry + hi);
#pragma unroll
                        for (int jj = 0; jj < 8; ++jj) w[jj] = (sg[jj] * suf[jj]) * eb;
                        mrun[qi] = carry + ((tot + t1) + (t2 + t3));
                        u32x4 pw; pw.x = pk2(w[0], w[1]); pw.y = pk2(w[2], w[3]); pw.z = pk2(w[4], w[5]); pw.w = pk2(w[6], w[7]);
                        pb = __builtin_bit_cast(bf16x8, pw);
                    } else {
                        f32x2 xv[4];
                        const f32x2 r0 = {st[0][0], st[0][1]}, r1 = {st[0][2], st[0][3]}, r2 = {st[1][0], st[1][1]}, r3 = {st[1][2], st[1][3]};
                        const bool farb = (KIND == 3) && (kb0 + 31 + 128 <= qw);
                        const bool rawp = (KIND == 1) || farb;
                        const float cb = farb ? relt[h * RELW] : 0.f;
                        float p[8];
                        if (rawp) {
                            const float ms0 = (KIND == 3) ? mref[qi] - cb : mref[qi];
                            xv[0] = r0 * SC2 - ms0; xv[1] = r1 * SC2 - ms0; xv[2] = r2 * SC2 - ms0; xv[3] = r3 * SC2 - ms0;
                            const float dmx = max3f(max3f(xv[0][0], xv[0][1], xv[1][0]), max3f(xv[1][1], xv[2][0], xv[2][1]), max3f(xv[3][0], xv[3][1], xv[3][1]));
                            if (__any(dmx > ((mrun[qi] == NINF) ? NINF : 16.0f))) {
                                const float mx = max_x16x32(dmx + mref[qi]);
                                const float mnew = fmaxf(mrun[qi], mx);
                                const float mns = (mnew == NINF) ? 0.f : mnew;
                                const float alpha = ex2(mrun[qi] - mns);
                                const float dm = mns - mref[qi];
                                xv[0] = xv[0] - dm; xv[1] = xv[1] - dm; xv[2] = xv[2] - dm; xv[3] = xv[3] - dm;
                                mrun[qi] = mnew; mref[qi] = mns; Ol[qi] = Ol[qi] * alpha;
#pragma unroll
                                for (int dt = 0; dt < 4; ++dt) O[qi][dt] = O[qi][dt] * alpha;
                            }
#pragma unroll
                            for (int i = 0; i < 4; ++i) { p[2 * i] = ex2(xv[i][0]); p[2 * i + 1] = ex2(xv[i][1]); }
                        } else {
                            if (KIND == 0) {
                                xv[0] = r0 * SC2 + (f32x2){bias[0], bias[1]}; xv[1] = r1 * SC2 + (f32x2){bias[2], bias[3]}; xv[2] = r2 * SC2 + (f32x2){bias[4], bias[5]}; xv[3] = r3 * SC2 + (f32x2){bias[6], bias[7]};
                                if (diag) {
#pragma unroll
                                    for (int jj = 0; jj < 8; ++jj) if (kb0 + fq * 8 + jj > q) xv[jj >> 1][jj & 1] = NINF;
                                }
                            } else {
                                float bt[8];
#pragma unroll
                                for (int jj = 0; jj < 8; ++jj) bt[jj] = relt[h * RELW + RELO + (kb0 + fq * 8 - q) + jj];
                                xv[0] = r0 * SC2 + (f32x2){bt[0], bt[1]}; xv[1] = r1 * SC2 + (f32x2){bt[2], bt[3]}; xv[2] = r2 * SC2 + (f32x2){bt[4], bt[5]}; xv[3] = r3 * SC2 + (f32x2){bt[6], bt[7]};
                            }
                            const float mxl = max3f(max3f(xv[0][0], xv[0][1], xv[1][0]), max3f(xv[1][1], xv[2][0], xv[2][1]), max3f(xv[3][0], xv[3][1], xv[3][1]));
                            if (__any(mxl > mrun[qi] + ((KIND == 0) ? 96.0f : 16.0f))) {
                                const float mx = max_x16x32(mxl);
                                const float mnew = fmaxf(mrun[qi], mx);
                                const float mns = (mnew == NINF) ? 0.f : mnew;
                                const float alpha = ex2(mrun[qi] - mns);
                                mrun[qi] = mnew; mref[qi] = mns; Ol[qi] = Ol[qi] * alpha;
#pragma unroll
                                for (int dt = 0; dt < 4; ++dt) O[qi][dt] = O[qi][dt] * alpha;
                            }
                            const float msafe = mref[qi];
#pragma unroll
                            for (int i = 0; i < 4; ++i) { const f32x2 d = xv[i] - msafe; p[2 * i] = ex2(d[0]); p[2 * i + 1] = ex2(d[1]); }
                        }
                        u32x4 pw; pw.x = pk2(p[0], p[1]); pw.y = pk2(p[2], p[3]); pw.z = pk2(p[4], p[5]); pw.w = pk2(p[6], p[7]);
                        if (KIND == 1) { pw.x &= pmask[0]; pw.y &= pmask[1]; pw.z &= pmask[2]; pw.w &= pmask[3]; }
                        pb = __builtin_bit_cast(bf16x8, pw);
                        Ol[qi] = __builtin_amdgcn_mfma_f32_16x16x32_bf16(ones8, pb, Ol[qi], 0, 0, 0);
                    }
#pragma unroll
                    for (int dt = 0; dt < 4; ++dt) O[qi][dt] = __builtin_amdgcn_mfma_f32_16x16x32_bf16(vf[dt], pb, O[qi][dt], 0, 0, 0);
                }
                if (KIND == 2) { const bool dn = (mrun[0] < -151.f) && (mrun[1] < -151.f); if (__all(dn)) wdone = true; }
            }
        }
        if (!has_next) break;
        if (KIND == 2) { if (lane == 0) flags[cur * 8 + wv] = wdone ? 1u : 0u; }
        *(LAS u32x4*)(kst + (cur ^ 1) * 8192) = kreg; *(LAS u32x4*)(vst + (cur ^ 1) * 8192) = vreg;
        if (s + s_dir != s_last) { kreg = *(const u32x4*)(Kb + (size_t)((s + 2 * s_dir) * 64) * KPB + kgoff); vreg = *(const u32x4*)(Vtb + (size_t)((s + 2 * s_dir) * 128) + vgoff); }
        __syncthreads();
        if (KIND == 2) {
            const unsigned f = flags[cur * 8 + (lane & 7)];
            if (__all(f != 0u)) break;
        }
        s += s_dir; cur ^= 1;
    }
    if (hn && !fetched) attn_fetch<(KIND + 1) & 3>(ws, nb, nh, nblk, tid, pre);
    if (hn) { u32x4 q0 = __builtin_bit_cast(u32x4, pre.qf[0][0]), q1 = __builtin_bit_cast(u32x4, pre.qf[0][1]), q2 = __builtin_bit_cast(u32x4, pre.qf[1][0]), q3 = __builtin_bit_cast(u32x4, pre.qf[1][1]);
        asm volatile("" : "+v"(q0), "+v"(q1), "+v"(q2), "+v"(q3), "+v"(pre.k0), "+v"(pre.v0), "+v"(pre.k1), "+v"(pre.v1));
        pre.qf[0][0] = __builtin_bit_cast(bf16x8, q0); pre.qf[0][1] = __builtin_bit_cast(bf16x8, q1); pre.qf[1][0] = __builtin_bit_cast(bf16x8, q2); pre.qf[1][1] = __builtin_bit_cast(bf16x8, q3); }
    unsigned char* Y = (unsigned char*)(ws + WS_Y);
#pragma unroll
    for (int qi = 0; qi < 2; ++qi) {
        float inv = 1.0f;
        if (KIND != 2) inv = __builtin_amdgcn_rcpf(Ol[qi][0]);
        const int q = (KIND == 1) ? (qw + fr) : (qw + 16 * qi + fr);
        const int hh = (KIND == 1) ? hw + qi : h;
        unsigned char* yr = Y + (rowb + q) * DM + YCOL + hh * 64 + fq * 4;
        inv *= 8.0f;
#pragma unroll
        for (int dt = 0; dt < 4; ++dt) { const f32x4 o = O[qi][dt] * inv; *(unsigned*)(yr + dt * 16) = (unsigned)pg8::fp8x4(o[0], o[1], o[2], o[3]); }
    }
}

__device__ __forceinline__ void attn_phase(KP Pq, Frame& F, int l) {
    F.tid = opaque_tid(F.wave0); F.lane = F.tid & 63; F.wave = opq_s(F.wave0); F.vcu = opq_s(F.vcu0); F.G = opq_s(F.G0); const KP P = kp_fresh(); (void)Pq;
    LAS float* relt = (LAS float*)(F.lds + ATT_RELT);
    unsigned char* ws = P->ws;
    __syncthreads();
    for (int i = F.tid; i < 4 * RELW; i += 512) { const int hh = i / RELW; int rel = i % RELW - RELO; rel = rel < -128 ? -128 : (rel > 128 ? 128 : rel); relt[i] = P->rel_bias[(l * 4 + hh) * 257 + rel + 128] * LOG2E; }
    __syncthreads();
    for (int vu = F.vcu; vu < 256; vu += F.G) {
        {
            LAS float* nf = (LAS float*)(F.lds + ATT_NF); LAS float* wsum = (LAS float*)(F.lds + ATT_FLAG + 256);
            __syncthreads();
            const f32x4 x = *(const f32x4*)((const float*)(ws + WS_LF) + (size_t)(vu >> 1) * SEQ + 4 * F.tid);
            const float s4 = (x[0] + x[1]) + (x[2] + x[3]);
            float incl = row_scan(s4);
            { const float T0 = rdl_f(incl, 15), T1 = rdl_f(incl, 31), T2 = rdl_f(incl, 47), T3 = rdl_f(incl, 63);
              incl += ((F.lane >= 16) ? T0 : 0.f) + ((F.lane >= 32) ? T1 : 0.f) + ((F.lane >= 48) ? T2 : 0.f);
              if (F.lane == 0) wsum[F.wave] = ((T0 + T1) + (T2 + T3)); }
            __syncthreads();
            float off = 0.f;
            for (int w2 = 0; w2 < F.wave; ++w2) off += wsum[w2];
            float pref = off + (incl - s4); f32x4 o;
            pref += x[0]; o[0] = -pref * LOG2E; pref += x[1]; o[1] = -pref * LOG2E; pref += x[2]; o[2] = -pref * LOG2E; pref += x[3]; o[3] = -pref * LOG2E;
            *(LAS f32x4*)(nf + 4 * F.tid) = o;
            __syncthreads();
        }
        auto unit_of = [&](int s2, int& kb, int& kh, int& kblk) { const int kind2 = (s2 + vu) & 3, j2 = s2 >> 2;
            if (kind2 == 1) { const int r = vu & 7; kb = vu >> 3; kh = 0; kblk = (j2 == 0) ? r : (j2 == 1) ? 31 - r : (j2 == 2) ? 15 - r : 16 + r; }
            else { const int bh = vu >> 1, o = vu & 1; kb = bh >> 2; kh = bh & 3; kblk = (j2 == 0) ? o : (j2 == 1) ? 7 - o : (j2 == 2) ? 2 + o : 5 - o; } };
        AttnPre A;
        { int b0, h0, k0; unit_of(0, b0, h0, k0); const int kind0 = vu & 3, tid0 = opaque_tid(F.wave0);
          if (kind0 == 0) attn_fetch<0>(ws, b0, h0, k0, tid0, A); else if (kind0 == 1) attn_fetch<1>(ws, b0, h0, k0, tid0, A); else if (kind0 == 2) attn_fetch<2>(ws, b0, h0, k0, tid0, A); else attn_fetch<3>(ws, b0, h0, k0, tid0, A); }
        for (int s = 0; s < 16; ++s) {
            const int kind = (s + vu) & 3;
            int b, h, blk, nb = 0, nh = 0, nblk = 0; unit_of(s, b, h, blk);
            const bool hn = s < 15; if (hn) unit_of(s + 1, nb, nh, nblk);
            if (kind == 0) attn_wg<0>(ws, b, h, blk, F.lds, F.wave0, A, hn, nb, nh, nblk);
            else if (kind == 1) attn_wg<1>(ws, b, h, blk, F.lds, F.wave0, A, hn, nb, nh, nblk);
            else if (kind == 2) attn_wg<2>(ws, b, h, blk, F.lds, F.wave0, A, hn, nb, nh, nblk);
            else attn_wg<3>(ws, b, h, blk, F.lds, F.wave0, A, hn, nb, nh, nblk);
        }
    }
    __syncthreads();
}

__device__ __forceinline__ void norm2_router_phase(KP Pq, Frame& F, int l) {
    F.tid = opaque_tid(F.wave0); F.lane = F.tid & 63; F.wave = opq_s(F.wave0); F.vcu = opq_s(F.vcu0); F.G = opq_s(F.G0); const KP P = kp_fresh(); (void)Pq;
    unsigned char* ws = P->ws;
    const bf16* X = (const bf16*)(ws + WS_X);
    const float* mod = (const float*)(ws + WS_MOD);
    unsigned char* H8 = (unsigned char*)(ws + WS_H8);
    const bf16* WH = (const bf16*)(ws + WS_WRT) + (size_t)l * 32 * 1024; const bf16* WL = WH + NL * 32 * 1024;
    int* TOKE = (int*)(ws + WS_TOKE); float* TOKG = (float*)(ws + WS_TOKG); int* COUNTS = (int*)(ws + WS_COUNTS);
    LAS float* lg = (LAS float*)(F.lds) + F.wave * (32 * 33);
    LAS unsigned* cnt = (LAS unsigned*)(F.lds + 40960);
    LAS float* GS = (LAS float*)(F.lds + 49152);
    LAS float* SH = GS + 1024;
    const int lane = F.lane, fr = lane & 15, fq = lane >> 4;
    const float* gn = P->norm2_g + l * DM;
    for (int tb = F.vcu; tb < NTB / 2; tb += F.G) {
        const int bb = (tb * 256) >> 11;
        __syncthreads();
        if (F.tid < 64) cnt[F.tid] = 0u;
        { const float* mb = mod + ((size_t)(l * 32 + bb)) * 6144 + 3 * 1024;
          for (int i = F.tid; i < 1024; i += 512) { GS[i] = gn[i] * (1.0f + mb[1024 + i]); SH[i] = mb[i]; } }
        __syncthreads();
        const int tok0 = tb * 256 + F.wave * 32;
        const bf16* xr0 = X + (size_t)(tok0 + fr) * DM + fq * 8; const bf16* xr1 = xr0 + 16 * DM;
        float ss0 = 0.f, ss1 = 0.f;
#pragma unroll 8
        for (int ks = 0; ks < 32; ++ks) { const u32x4 a = *(const u32x4*)(xr0 + ks * 32), c = *(const u32x4*)(xr1 + ks * 32);
            ss0 = dot2bf(a.x, ss0); ss0 = dot2bf(a.y, ss0); ss0 = dot2bf(a.z, ss0); ss0 = dot2bf(a.w, ss0);
            ss1 = dot2bf(c.x, ss1); ss1 = dot2bf(c.y, ss1); ss1 = dot2bf(c.z, ss1); ss1 = dot2bf(c.w, ss1); }
        const float rstd0 = __builtin_amdgcn_rsqf(sum_x16x32(ss0) * (1.0f / DM) + 1e-6f), rstd1 = __builtin_amdgcn_rsqf(sum_x16x32(ss1) * (1.0f / DM) + 1e-6f);
        f32x4 acc[2][2] = {{zero4(), zero4()}, {zero4(), zero4()}};
        unsigned char* h8w = H8 + (size_t)(tok0 + (fq & 1) * 16 + fr) * DM + (fq & ~1) * 8;
        u32x4 cx[2]; bf16x8 ah[2], al[2];
        cx[0] = *(const u32x4*)xr0; cx[1] = *(const u32x4*)xr1;
#pragma unroll
        for (int nt = 0; nt < 2; ++nt) { ah[nt] = *(const bf16x8*)(WH + (size_t)(nt * 16 + fr) * 1024 + fq * 8); al[nt] = *(const bf16x8*)(WL + (size_t)(nt * 16 + fr) * 1024 + fq * 8); }
#pragma unroll 2
        for (int ks = 0; ks < 32; ++ks) {
            const int kn = (ks + 1) & 31;
            u32x4 nx[2]; bf16x8 nah[2], nal[2];
            nx[0] = *(const u32x4*)(xr0 + kn * 32); nx[1] = *(const u32x4*)(xr1 + kn * 32);
#pragma unroll
            for (int nt = 0; nt < 2; ++nt) { nah[nt] = *(const bf16x8*)(WH + (size_t)(nt * 16 + fr) * 1024 + kn * 32 + fq * 8); nal[nt] = *(const bf16x8*)(WL + (size_t)(nt * 16 + fr) * 1024 + kn * 32 + fq * 8); }
            const f32x4 g0 = *(const LAS f32x4*)(GS + ks * 32 + fq * 8), g1 = *(const LAS f32x4*)(GS + ks * 32 + fq * 8 + 4), s0 = *(const LAS f32x4*)(SH + ks * 32 + fq * 8), s1 = *(const LAS f32x4*)(SH + ks * 32 + fq * 8 + 4);
            u32x2 f8p[2];
#pragma unroll
            for (int tt = 0; tt < 2; ++tt) {
                float xv[8]; bf8_to_f(cx[tt], xv);
                const float rs = tt ? rstd1 : rstd0;
                float hv[8];
#pragma unroll
                for (int i = 0; i < 8; ++i) hv[i] = (xv[i] * rs) * (i < 4 ? g0[i] : g1[i - 4]) + (i < 4 ? s0[i] : s1[i - 4]);
                u32x4 hi, lo;
                hi.x = pk2(hv[0], hv[1]); hi.y = pk2(hv[2], hv[3]); hi.z = pk2(hv[4], hv[5]); hi.w = pk2(hv[6], hv[7]);
                lo.x = pk2(hv[0] - bf2f(hi.x & 0xffffu), hv[1] - bf2f(hi.x >> 16)); lo.y = pk2(hv[2] - bf2f(hi.y & 0xffffu), hv[3] - bf2f(hi.y >> 16));
                lo.z = pk2(hv[4] - bf2f(hi.z & 0xffffu), hv[5] - bf2f(hi.z >> 16)); lo.w = pk2(hv[6] - bf2f(hi.w & 0xffffu), hv[7] - bf2f(hi.w >> 16));
                f8p[tt].x = (unsigned)pg8::fp8x4(hv[0], hv[1], hv[2], hv[3]); f8p[tt].y = (unsigned)pg8::fp8x4(hv[4], hv[5], hv[6], hv[7]);
                const bf16x8 bh = __builtin_bit_cast(bf16x8, hi), bl = __builtin_bit_cast(bf16x8, lo);
#pragma unroll
                for (int nt = 0; nt < 2; ++nt) {
                    acc[tt][nt] = __builtin_amdgcn_mfma_f32_16x16x32_bf16(ah[nt], bh, acc[tt][nt], 0, 0, 0);
                    acc[tt][nt] = __builtin_amdgcn_mfma_f32_16x16x32_bf16(al[nt], bh, acc[tt][nt], 0, 0, 0);
                    acc[tt][nt] = __builtin_amdgcn_mfma_f32_16x16x32_bf16(ah[nt], bl, acc[tt][nt], 0, 0, 0);
                }
            }
            { unsigned ax = f8p[0].x, ay = f8p[0].y, bx = f8p[1].x, by = f8p[1].y; pg8::swap16(ax, bx); pg8::swap16(ay, by);
              *(u32x4*)(h8w + ks * 32) = (u32x4){ax, ay, bx, by}; }
            cx[0] = nx[0]; cx[1] = nx[1]; ah[0] = nah[0]; ah[1] = nah[1]; al[0] = nal[0]; al[1] = nal[1];
        }
#pragma unroll
        for (int tt = 0; tt < 2; ++tt)
#pragma unroll
            for (int nt = 0; nt < 2; ++nt)
#pragma unroll
                for (int j = 0; j < 4; ++j) { const int e = nt * 16 + fq * 4 + j; lg[(tt * 16 + fr) * 33 + e] = acc[tt][nt][j] + P->b_router[l * 32 + e]; }
        LDS_WAIT(); asm volatile("" ::: "memory");
        if (lane < 32) {
            float v0 = -INFINITY, v1 = -INFINITY, v2 = -INFINITY, v3 = -INFINITY; int i0 = 0, i1 = 0, i2 = 0, i3 = 0;
            for (int e = 0; e < 32; ++e) { const float v = lg[lane * 33 + e];
                if (v > v0) { v3 = v2; i3 = i2; v2 = v1; i2 = i1; v1 = v0; i1 = i0; v0 = v; i0 = e; }
                else if (v > v1) { v3 = v2; i3 = i2; v2 = v1; i2 = i1; v1 = v; i1 = e; }
                else if (v > v2) { v3 = v2; i3 = i2; v2 = v; i2 = e; }
                else if (v > v3) { v3 = v; i3 = e; } }
            const float e1 = ex2((v1 - v0) * LOG2E), e2 = ex2((v2 - v0) * LOG2E), e3 = ex2((v3 - v0) * LOG2E); const float inv = __builtin_amdgcn_rcpf(1.0f + e1 + e2 + e3);
            const int tok = tok0 + lane;
            *(int4*)(TOKE + (size_t)tok * 4) = make_int4(i0, i1, i2, i3);
            *(f32x4*)(TOKG + (size_t)tok * 4) = (f32x4){inv, e1 * inv, e2 * inv, e3 * inv};
            LAS unsigned* cb = cnt + (F.wave >> 2) * 32;
            lds_add(cb + i0, 1u); lds_add(cb + i1, 1u); lds_add(cb + i2, 1u); lds_add(cb + i3, 1u);
        }
        LDS_WAIT();
        __syncthreads();
        if (F.tid < 64) COUNTS[(tb * 2 + (F.tid >> 5)) * 32 + (F.tid & 31)] = (int)cnt[F.tid];
    }
}

__device__ __forceinline__ void gather_phase(KP Pq, Frame& F) {
    F.tid = opaque_tid(F.wave0); F.lane = F.tid & 63; F.wave = opq_s(F.wave0); F.vcu = opq_s(F.vcu0); F.G = opq_s(F.G0); const KP P = kp_fresh(); (void)Pq;
    unsigned char* ws = P->ws;
    const unsigned char* H8 = (const unsigned char*)(ws + WS_H8); unsigned char* XS = (unsigned char*)(ws + WS_XS);
    const int* TOKE = (const int*)(ws + WS_TOKE); const float* TOKG = (const float*)(ws + WS_TOKG); const int* COUNTS = (const int*)(ws + WS_COUNTS);
    int* ROWDST = (int*)(ws + WS_ROWDST); float* ROWGATE = (float*)(ws + WS_ROWGATE); int* TILEE = (int*)(ws + WS_TILEE);
    LAS int* lp = (LAS int*)(F.lds);
    LAS int* part = lp + 512 * 32;
    LAS int* tot = part + 512;
    LAS int* pst = tot + 32;
    LAS unsigned* cur = (LAS unsigned*)(pst + 40);
    LAS int* posl = (LAS int*)(cur + 32);
    const int tid = F.tid;
    unsigned short* GT16 = (unsigned short*)(ws + WS_XS);
    auto gt_put = [&](int pos, int tok) { const int pm = pos >> 8, r = pos & 255, hh = r >> 7, Rb = r & 127, ii = Rb >> 6, y = Rb & 63, yy = y & 31;
        const int R0 = (y & 32) + 16 * ((yy >> 2) & 1) + 4 * (yy >> 3) + (yy & 3); const int t0 = (R0 >> 4) * 128 + (R0 & 15) * 8;
        unsigned short* g = GT16 + ((size_t)((pm * 2 + hh) * 512 + t0) * 2 + ii);
#pragma unroll
        for (int cc = 0; cc < 8; ++cc) g[cc * 2] = (unsigned short)tok; };
    __syncthreads();
    { const int e = tid & 31, seg = tid >> 5; int c[32];
#pragma unroll
      for (int i = 0; i < 32; ++i) c[i] = COUNTS[(seg * 32 + i) * 32 + e];
      int run = 0;
#pragma unroll
      for (int i = 0; i < 32; ++i) { lp[(seg * 32 + i) * 32 + e] = run; run += c[i]; }
      part[seg * 32 + e] = run; }
    __syncthreads();
    if (tid < 32) { int s = 0; for (int g = 0; g < 16; ++g) { const int v = part[g * 32 + tid]; part[g * 32 + tid] = s; s += v; } tot[tid] = s; }
    __syncthreads();
    if (tid == 0) { int p = 0; for (int e = 0; e < 32; ++e) { pst[e] = p; p += (tot[e] + 255) & ~255; } pst[32] = p; }
    __syncthreads();
    if (F.vcu == 0) {
        for (int i = tid; i < MAXRT; i += 512) { int e = 0; for (int k = 1; k < 32; ++k) if (i * 256 >= pst[k]) e = k; TILEE[i] = e; }
        if (tid == 0) TILEE[MAXRT] = pst[32] / 256;
    }
    for (int e = F.vcu; e < 32; e += F.G) {
        for (int p = pst[e] + tot[e] + tid; p < pst[e + 1]; p += 512) { ROWDST[p] = -1; ROWGATE[p] = 0.f; gt_put(p, 0); }
    }
    for (int tb = F.vcu; tb < NTB; tb += F.G) {
        __syncthreads();
        if (tid < 32) cur[tid] = 0u;
        __syncthreads();
        { const int tok = tb * 128 + (tid >> 2), k = tid & 3; const int e = TOKE[(size_t)tok * 4 + k];
          const int pos = pst[e] + part[(tb >> 5) * 32 + e] + lp[tb * 32 + e] + (int)lds_add(cur + e, 1u);
          posl[tid] = pos; ROWDST[pos] = tok * 4 + k; ROWGATE[pos] = TOKG[(size_t)tok * 4 + k]; gt_put(pos, tok); }
        __syncthreads();
    }
    __syncthreads();
}

__global__ void __launch_bounds__(512, 2) mk_fwd(Params Pval) {
    extern __shared__ __attribute__((aligned(16))) unsigned char lds_raw[];
    Frame F;
    F.lds = (LAS unsigned char*)lds_raw;
    F.tid = threadIdx.x; F.lane = F.tid & 63; F.wave = __builtin_amdgcn_readfirstlane(F.tid >> 6); F.wave0 = F.wave;
    F.G0 = gridDim.x; { const int bx = blockIdx.x; F.vcu0 = (F.G0 % 8 == 0) ? (bx % 8) * (F.G0 / 8) + bx / 8 : bx; } F.G = F.G0; F.vcu = F.vcu0;
    volatile LAS unsigned* MISC = (volatile LAS unsigned*)(F.lds + MISC_OFF);
    for (int u = F.tid; u < (LDS_BYTES - LDSCTL_OFF) / 4; u += 512) ((LAS unsigned*)(F.lds + LDSCTL_OFF))[u] = 0u;
    __syncthreads();
    const KP P = kp_fresh(); (void)Pval;
    unsigned char* ws = P->ws;
    XcdBarrier bar = xcd_barrier_post((unsigned*)(ws + WS_CTL) + CW_BAR, MISC + 8); bar.wv = F.wave0;
#define GRID_BAR() xcd_barrier(bar)

#ifndef PH_MASK
#define PH_MASK 0xFFFF
#endif
#define PH(k) ((PH_MASK >> (k)) & 1)
#ifndef DUP_MASK
#define DUP_MASK 0
#endif
#define DUP(k) ((DUP_MASK >> (k)) & 1)
#ifndef SELVAR
#define SELVAR 0
#endif
    if (PH(0)) p0_prologue(P, F);
    GRID_BAR();
    if (DUP(0)) { p0_prologue(P, F); GRID_BAR(); }
    for (int l = 0; l < NL; ++l) {
        if (DUP(1) && l > 0) { norm_phase<2>(P, F, NL); GRID_BAR(); }
        if (PH(1)) { if (l == 0) norm_phase<0>(P, F, 0); else norm_phase<1>(P, F, l); }
        GRID_BAR();
        if (PH(2)) { unsigned char* ws = kp_fresh()->ws; pg8::SchedDense8 S; S.o.init(T / 256, NP / 256, opq_s(F.G0), opq_s((int)blockIdx.x)); S.A = (const char*)(ws + WS_H); S.B = (const char*)(ws + WS_WIN) + (size_t)l * NP * 1024;
          pg8::EpiProj8 E{(bf16*)(ws + WS_PROJ), NP, (bf16*)(ws + WS_VT)};
          pg8::gemm_phase<pg8::EpiProj8, pg8::SchedDense8, true>(F.lds, S, E, F.wave0); }
        GRID_BAR();
        if (DUP(3)) { prep_phase<true>(P, F, l); GRID_BAR(); }
        if (PH(3)) prep_phase<false>(P, F, l);
        GRID_BAR();
        if (DUP(4)) { sel_phase<SELVAR>(P, F); GRID_BAR(); }
        if (PH(4)) sel_phase<0>(P, F);
        GRID_BAR();
        if (PH(5)) attn_phase(P, F, l);
        if (DUP(5)) { GRID_BAR(); attn_phase(P, F, l); }
        GRID_BAR();
        if (PH(6)) { unsigned char* ws = kp_fresh()->ws; const float* mod = (const float*)(ws + WS_MOD); pg8::SchedDense8 S; S.o.init(T / 256, DM / 256, opq_s(F.G0), opq_s((int)blockIdx.x)); S.A = (const char*)(ws + WS_Y); S.B = (const char*)(ws + WS_WO) + (size_t)l * 1024 * 1024;
          pg8::EpiResid8 E{l == 0 ? kp_fresh()->x : (const float*)nullptr, (bf16*)(ws + WS_X), mod + (size_t)l * 32 * 6144 + 2 * 1024};
          pg8::gemm_phase<pg8::EpiResid8, pg8::SchedDense8, true>(F.lds, S, E, F.wave0); }
        GRID_BAR();
        if (PH(7)) norm2_router_phase(P, F, l);
        GRID_BAR();
        if (DUP(7)) { norm2_router_phase(P, F, l); GRID_BAR(); }
        if (PH(9)) gather_phase(P, F);
        if (DUP(9)) { GRID_BAR(); gather_phase(P, F); }
        GRID_BAR();
        for (int rep = 0; rep < 1 + DUP(10); ++rep) {
        if (PH(10)) { unsigned char* ws = kp_fresh()->ws; const int* tile_e = (const int*)(ws + WS_TILEE); const int nrt = __builtin_amdgcn_readfirstlane(tile_e[MAXRT]);
          pg8::SchedMoeG S; S.o.init(nrt, 8, opq_s(F.G0), opq_s((int)blockIdx.x)); S.A = (const char*)(ws + WS_H8); S.B = (const char*)(ws + WS_WGU) + (size_t)l * NE * 2048 * 1024; S.tile_e = tile_e; S.estride = (size_t)2048 * 1024; S.rowdst = (const int*)(ws + WS_ROWDST); S.gt32 = (const unsigned*)(ws + WS_XS);
          pg8::EpiSwiglu E{(unsigned char*)(ws + WS_ACT), kp_fresh()->b_gu + (size_t)l * NE * 2048};
          pg8::gemm_phase<pg8::EpiSwiglu, pg8::SchedMoeG, true>(F.lds, S, E, F.wave0); }
        GRID_BAR();
        if (PH(11)) { unsigned char* ws = kp_fresh()->ws; const int* tile_e = (const int*)(ws + WS_TILEE); const int nrt = __builtin_amdgcn_readfirstlane(tile_e[MAXRT]);
          pg8::SchedMoe S; S.o.init(nrt, 4, opq_s(F.G0), opq_s((int)blockIdx.x)); S.A = (const char*)(ws + WS_ACT); S.B = (const char*)(ws + WS_WDN) + (size_t)l * NE * 1024 * 1024; S.tile_e = tile_e; S.estride = (size_t)1024 * 1024;
          pg8::EpiDown E{(unsigned char*)(ws + WS_SLOT), kp_fresh()->b_dn + (size_t)l * NE * 1024, (const int*)(ws + WS_ROWDST), (const float*)(ws + WS_ROWGATE)};
          pg8::gemm_phase<pg8::EpiDown, pg8::SchedMoe, true>(F.lds, S, E, F.wave0); }
        GRID_BAR();
        }
    }
    if (PH(12)) norm_phase<2>(P, F, NL);
}

extern "C" void kernel_launch(void* const* d_in, const int* in_sizes, int n_in, void* d_out, int out_size, void* d_ws, size_t ws_size, hipStream_t stream) {
    static int grid = 0;
    if (grid == 0) {
        if (n_in != 20 || in_sizes[0] != T * DM || out_size != T * DM || ws_size < WS_END) { fprintf(stderr, "kernel_launch: unexpected shapes / workspace (%d inputs, ws %zu)\n", n_in, ws_size); grid = -1; return; }
        int dev = 0, cus = 0, per_cu = 0;
        if (hipGetDevice(&dev) != hipSuccess || hipDeviceGetAttribute(&cus, hipDeviceAttributeMultiprocessorCount, dev) != hipSuccess) { grid = -1; return; }
        if (hipFuncSetAttribute((const void*)mk_fwd, hipFuncAttributeMaxDynamicSharedMemorySize, LDS_BYTES) != hipSuccess) { fprintf(stderr, "kernel_launch: hipFuncSetAttribute failed\n"); grid = -1; return; }
        if (hipOccupancyMaxActiveBlocksPerMultiprocessor(&per_cu, (const void*)mk_fwd, 512, LDS_BYTES) != hipSuccess || per_cu < 1) { fprintf(stderr, "kernel_launch: occupancy query says %d\n", per_cu); }
        (void)hipGetLastError();
        grid = cus;
    }
    if (grid < 0) return;
    if (hipMemsetAsync((char*)d_ws + WS_CTL, 0, CTL_ZERO_BYTES, stream) != hipSuccess) return;
    Params p{};
    const float** pp = (const float**)&p;
    for (int i = 0; i < 20; ++i) pp[i] = (const float*)d_in[i];
    p.out = (float*)d_out; p.ws = (unsigned char*)d_ws;
    hipLaunchKernelGGL(mk_fwd, dim3(grid), dim3(512), LDS_BYTES, stream, p);
    const hipError_t le = hipPeekAtLastError();
    if (le != hipSuccess) fprintf(stderr, "kernel_launch: launch failed: %s\n", hipGetErrorName(le));
}
```

```cpp
#include <hip/hip_runtime.h>
#include <cstdio>
#include <cstdint>

#define GAS __attribute__((address_space(1)))
#define LAS __attribute__((address_space(3)))
typedef unsigned short bf16;
typedef unsigned u32x4 __attribute__((ext_vector_type(4)));
typedef unsigned u32x2 __attribute__((ext_vector_type(2)));
typedef float f32x4 __attribute__((ext_vector_type(4)));
typedef float f32x2 __attribute__((ext_vector_type(2)));
typedef short bf16x8 __attribute__((ext_vector_type(8)));
typedef __bf16 bf16x2_t __attribute__((ext_vector_type(2)));

constexpr int DM = 1024, NB = 32, SEQ = 2048, NL = 4, T = NB * SEQ;
constexpr int NP = 3072;
constexpr int C_QA = 0, C_KA = 256, C_VA = 512, C_QC = 768, C_KC = 1024, C_VC = 1280, C_QD = 1536, C_KD = 1792, C_VD = 2048,
              C_QB = 2304, C_LAT = 2560, C_QI = 2688, C_KI = 2816, C_WI = 2848, C_FA = 2852;
constexpr int IN_COLS = 2856;
constexpr int NE = 32, NPAIR = T * 4, PMAX = NPAIR + NE * 256, MAXRT = PMAX / 256;
constexpr int NTB = 512;
constexpr float LOG2E = 1.4426950408889634f;
constexpr float SC2 = 0.125f * LOG2E;
constexpr float RS32 = 0.17677669529663687f;

constexpr size_t MiB = 1u << 20;
constexpr size_t WS_CTL = 0, CTL_ZERO_BYTES = 1 * MiB;
constexpr size_t WS_MOD = 1 * MiB;
constexpr size_t WS_ROPE = 4 * MiB;
constexpr size_t WS_WRT = 5 * MiB;
constexpr size_t WS_TOKE = 6 * MiB, WS_TOKG = 7 * MiB, WS_COUNTS = 8 * MiB, WS_TILEE = 8 * MiB + 65536;
constexpr size_t WS_ROWDST = 9 * MiB, WS_ROWGATE = 11 * MiB, WS_THR = 13 * MiB, WS_LF = 14 * MiB;
constexpr size_t WS_KB = 16 * MiB, WS_VBT = 24 * MiB;
constexpr size_t WS_H8 = 3536 * MiB;
constexpr size_t WS_WIN = 32 * MiB, WS_WO = 56 * MiB, WS_WGU = 64 * MiB, WS_WDN = 576 * MiB;
constexpr size_t WS_X = 832 * MiB, WS_H = 1088 * MiB, WS_H2LO = 1216 * MiB, WS_PROJ = 1344 * MiB, WS_VT = 1728 * MiB, WS_Y = 1824 * MiB;
constexpr size_t WS_XS = 1952 * MiB, WS_ACT = 2480 * MiB, WS_SLOT = 3008 * MiB, WS_MASK = 3520 * MiB, WS_END = 3600 * MiB;
constexpr int CW_BAR = 4096;

constexpr int RING_BYTES = 131072;
constexpr int LDSCTL_OFF = RING_BYTES + 1024, MISC_OFF = LDSCTL_OFF + 320;
constexpr int LDS_BYTES = 147456, TE_LDS = 145408, GTAB_LDS = 135168;

struct Params {
    const float *x, *c, *w_ada, *b_ada, *norm1_g, *norm2_g, *w_in, *b_forget, *kv_norm_g, *w_uk, *w_uv, *rel_bias, *w_o,
                *w_router, *b_router, *w_gu, *b_gu, *w_dn, *b_dn, *final_g;
    float* out; unsigned char* ws;
};

typedef const Params __attribute__((address_space(4)))* KP;
__device__ __forceinline__ KP kp_fresh() { KP k = (KP)__builtin_amdgcn_kernarg_segment_ptr(); asm volatile("" : "+s"(k)); return k; }
__device__ __forceinline__ int opaque_tid(int wv) {
    int l; asm volatile("v_mbcnt_lo_u32_b32 %0, -1, 0\n\tv_mbcnt_hi_u32_b32 %0, -1, %0" : "=v"(l)); asm volatile("" : "+s"(wv)); return (wv << 6) | l; }
#define LDS_WAIT() asm volatile("s_waitcnt lgkmcnt(0)" ::: "memory")
#define VM_WAIT() asm volatile("s_waitcnt vmcnt(0)" ::: "memory")
__device__ __forceinline__ unsigned f2bf(float f) { unsigned u = __builtin_bit_cast(unsigned, f); return (u + 0x7fffu + ((u >> 16) & 1u)) >> 16; }
__device__ __forceinline__ float bf2f(unsigned b) { return __builtin_bit_cast(float, b << 16); }
__device__ __forceinline__ unsigned pk2(float lo, float hi) { f32x2 v = {lo, hi}; bf16x2_t b = __builtin_convertvector(v, bf16x2_t); return __builtin_bit_cast(unsigned, b); }
__device__ __forceinline__ float dpp_shr_f(float v, const int ctrl_is  ) {
    int r;
    if (ctrl_is == 1) r = __builtin_amdgcn_update_dpp(0, __builtin_bit_cast(int, v), 0x111, 0xf, 0xf, true);
    else if (ctrl_is == 2) r = __builtin_amdgcn_update_dpp(0, __builtin_bit_cast(int, v), 0x112, 0xf, 0xf, true);
    else if (ctrl_is == 4) r = __builtin_amdgcn_update_dpp(0, __builtin_bit_cast(int, v), 0x114, 0xf, 0xf, true);
    else r = __builtin_amdgcn_update_dpp(0, __builtin_bit_cast(int, v), 0x118, 0xf, 0xf, true);
    return __builtin_bit_cast(float, r);
}
__device__ __forceinline__ float rdl_f(float v, int l) { return __builtin_bit_cast(float, __builtin_amdgcn_readlane(__builtin_bit_cast(int, v), l)); }
__device__ __forceinline__ float row_scan(float v) { v += dpp_shr_f(v, 1); v += dpp_shr_f(v, 2); v += dpp_shr_f(v, 4); v += dpp_shr_f(v, 8); return v; }
__device__ __forceinline__ float wave_sum(float v) { v = row_scan(v); return (rdl_f(v, 15) + rdl_f(v, 31)) + (rdl_f(v, 47) + rdl_f(v, 63)); }
struct U2 { unsigned a, b; };
__device__ __forceinline__ U2 pl16(unsigned x) { U2 r; r.a = x; r.b = x; asm volatile("s_nop 1\n\tv_permlane16_swap_b32 %0, %1" : "+v"(r.a), "+v"(r.b)); return r; }
__device__ __forceinline__ U2 pl32(unsigned x) { U2 r; r.a = x; r.b = x; asm volatile("s_nop 1\n\tv_permlane32_swap_b32 %0, %1" : "+v"(r.a), "+v"(r.b)); return r; }
__device__ __forceinline__ float xor16_f(float v, int lane) { const U2 r = pl16(__builtin_bit_cast(unsigned, v)); return __builtin_bit_cast(float, (lane & 16) ? r.a : r.b); }
__device__ __forceinline__ float xor32_f(float v, int lane) { const U2 r = pl32(__builtin_bit_cast(unsigned, v)); return __builtin_bit_cast(float, (lane & 32) ? r.a : r.b); }
__device__ __forceinline__ float max_x16x32(float v) {
    U2 r = pl16(__builtin_bit_cast(unsigned, v)); v = fmaxf(__builtin_bit_cast(float, r.a), __builtin_bit_cast(float, r.b));
    r = pl32(__builtin_bit_cast(unsigned, v)); return fmaxf(__builtin_bit_cast(float, r.a), __builtin_bit_cast(float, r.b)); }
__device__ __forceinline__ float sum_x16x32(float v) {
    U2 r = pl16(__builtin_bit_cast(unsigned, v)); v = __builtin_bit_cast(float, r.a) + __builtin_bit_cast(float, r.b);
    r = pl32(__builtin_bit_cast(unsigned, v)); return __builtin_bit_cast(float, r.a) + __builtin_bit_cast(float, r.b); }
__device__ __forceinline__ float max3f(float a, float b, float c) { float r; asm("v_max3_f32 %0, %1, %2, %3" : "=v"(r) : "v"(a), "v"(b), "v"(c)); return r; }
__device__ __forceinline__ unsigned lds_add(LAS unsigned* p, unsigned v) { return __hip_atomic_fetch_add(p, v, __ATOMIC_RELAXED, __HIP_MEMORY_SCOPE_WORKGROUP); }
__device__ __forceinline__ f32x4 zero4() { float z = 0.f; asm volatile("" : "+v"(z)); return (f32x4){z, z, z, z}; }
typedef __bf16 bf16x2n __attribute__((ext_vector_type(2)));
__device__ __forceinline__ float dot2bf(unsigned w, float c) { const bf16x2n v = __builtin_bit_cast(bf16x2n, w); return __builtin_amdgcn_fdot2_f32_bf16(v, v, c, false); }
__device__ __forceinline__ float ex2(float x) { return __builtin_amdgcn_exp2f(x); }
__device__ __forceinline__ float lg2(float x) { return __builtin_amdgcn_logf(x); }

#define XB_TMO      128
#define XB_XCNT(j)  (256  + 64 * (j))
#define XB_XSUB(j)  (1280 + 64 * (j))
#define XB_XGEN(j)  (2304 + 64 * (j))
#define XB_TOP      3328
#define XB_TOPGEN   3392
#define XCD_BAR_WORDS 3456
#define XB_SPIN_CAP (1u << 21)
__device__ __forceinline__ unsigned xb_ld(unsigned* p)              { return __hip_atomic_load(p, __ATOMIC_RELAXED, __HIP_MEMORY_SCOPE_AGENT); }
__device__ __forceinline__ unsigned xb_add(unsigned* p, unsigned v) { return __hip_atomic_fetch_add(p, v, __ATOMIC_RELAXED, __HIP_MEMORY_SCOPE_AGENT); }
__device__ __forceinline__ unsigned xb_xcc_id() { return (unsigned)__builtin_amdgcn_s_getreg((3 << 11) | 20) & 0xFu; }
#define XB_SPIN(cond, bar) do { unsigned _sp = 0; while (cond) { __builtin_amdgcn_s_sleep(1); \
    if ((++_sp & 255u) == 0u) { if (xb_ld(&(bar)[XB_TMO])) break; if (_sp > XB_SPIN_CAP) { atomicAdd(&(bar)[XB_TMO], 1u); break; } } } } while (0)
struct XcdBarrier { unsigned* bar; unsigned x; volatile LAS unsigned* st; int wv; };
__device__ __forceinline__ XcdBarrier xcd_barrier_post(unsigned* bar, volatile LAS unsigned* st) {
    XcdBarrier b; b.bar = bar; b.x = xb_xcc_id(); b.st = st;
    if (threadIdx.x == 0) (void)xb_add(&bar[XB_XCNT(b.x)], 1u);
    return b;
}
__device__ __forceinline__ void xcd_barrier_complete(unsigned* bar, unsigned x, unsigned& nloc, unsigned& nx) {
    const unsigned G = gridDim.x * gridDim.y * gridDim.z;
    unsigned sum, cnt, mine, sp = 0u;
    for (;;) {
        sum = 0u; cnt = 0u; mine = 0u;
#pragma unroll
        for (unsigned j = 0; j < 16; ++j) { const unsigned c = xb_ld(&bar[XB_XCNT(j)]); sum += c; cnt += (c > 0u) ? 1u : 0u; mine = (j == x) ? c : mine; }
        if (sum == G) break;
        __builtin_amdgcn_s_sleep(1);
        if ((++sp & 255u) == 0u) { if (xb_ld(&bar[XB_TMO])) break; if (sp > XB_SPIN_CAP) { atomicAdd(&bar[XB_TMO], 1u); break; } }
    }
    nloc = mine > 0u ? mine : 1u; nx = cnt > 0u ? cnt : 1u;
}
__device__ __forceinline__ void xcd_barrier(const XcdBarrier& b) {
    asm volatile("s_waitcnt vmcnt(0)" ::: "memory");
    __syncthreads();
    if (opaque_tid(b.wv) == 0) {
        unsigned* bar = b.bar; asm volatile("" : "+s"(bar));
        unsigned bx = b.x; asm volatile("" : "+s"(bx));
        __builtin_amdgcn_s_waitcnt(0);
        unsigned nloc = b.st[0], nx = b.st[1];
        if (nloc == 0u) { xcd_barrier_complete(bar, bx, nloc, nx); b.st[0] = nloc; b.st[1] = nx; }
        const unsigned old = xb_add(&bar[XB_XSUB(bx)], 1u);
        const unsigned gen = old / nloc;
        if (old + 1u == (gen + 1u) * nloc) {
            __builtin_amdgcn_fence(__ATOMIC_RELEASE, "agent");
            asm volatile("s_waitcnt vmcnt(0)" ::: "memory");
            const unsigned og = xb_add(&bar[XB_TOP], 1u);
            const unsigned tg = og / nx;
            if (og + 1u == (tg + 1u) * nx) xb_add(&bar[XB_TOPGEN], 1u);
            else XB_SPIN(xb_ld(&bar[XB_TOPGEN]) == tg, bar);
            __builtin_amdgcn_fence(__ATOMIC_ACQUIRE, "agent");
            xb_add(&bar[XB_XGEN(bx)], 1u);
            asm volatile("s_waitcnt vmcnt(0)" ::: "memory");
        } else {
            XB_SPIN(xb_ld(&bar[XB_XGEN(bx)]) == gen, bar);
            __builtin_amdgcn_fence(__ATOMIC_ACQUIRE, "agent");
            asm volatile("s_waitcnt vmcnt(0)" ::: "memory");
        }
    }
    __syncthreads();
}

namespace pg8 {
constexpr int BM = 256, BK = 64, HALF = 128, HTB = HALF * BK * 2, NXCD = 8, WGM = 8, KD = 1024;
constexpr size_t HSTEP = (size_t)HALF * KD * 2, TSTEP = 2 * HSTEP, KSTEP = (size_t)BK * 2;
__host__ __device__ __forceinline__ int lds_byte(int r, int c) { const int st = (r >> 4) * 2 + (c >> 5), rr = r & 15, cc = c & 31, ob = rr * 64 + cc * 2; return st * 1024 + (ob ^ (((ob >> 9) & 1) << 5)); }
__host__ __device__ __forceinline__ void stage_rc(int b, int& R, int& C) { const int st = b / 1024, sb = b % 1024, swz = sb ^ (((sb >> 9) & 1) << 5); R = (st >> 1) * 16 + swz / 64; C = (st & 1) * 32 + (swz % 64) / 2; }
__host__ __device__ __forceinline__ int perm32(int rho) { const int n = rho >> 4, i = rho & 15; return 8 * (i >> 2) + 4 * n + (i & 3); }
struct Unit { int pm, pn, e; };
struct Order {
    int nM, nN, nwg, G, c;
    __device__ void init(int nM_, int nN_, int G_, int c_) { nM = nM_; nN = nN_; nwg = nM * nN; G = G_; c = c_; }
    __device__ bool tile(int i, int& pm, int& pn) const {
        const long L = (long)i * G + c; if (L >= nwg) return false;
        int wgid = (int)L; { const int q = nwg / NXCD, r = nwg % NXCD, xcd = wgid % NXCD, off = wgid / NXCD; wgid = (xcd < r ? xcd * (q + 1) : r * (q + 1) + (xcd - r) * q) + off; }
        const int nig = WGM * nN, gid = wgid / nig, fm = gid * WGM, gsz = (nM - fm) < WGM ? (nM - fm) : WGM;
        pm = fm + ((wgid % nig) % gsz); pn = (wgid % nig) / gsz; return true;
    }
};
struct SchedDense {
    static constexpr bool GATHER = false, LA = false;
    Order o; const char* A; const char* B;
    __device__ __forceinline__ bool next(int i, Unit& u) const { u.e = 0; return o.tile(i, u.pm, u.pn); }
    __device__ __forceinline__ const char* aptr(const Unit& u) const { return A + (size_t)u.pm * TSTEP; }
    __device__ __forceinline__ const char* bptr(const Unit& u) const { return B + (size_t)u.pn * TSTEP; }
};
struct SchedDense8 {
    static constexpr bool GATHER = false, LA = false;
    Order o; const char* A; const char* B;
    __device__ __forceinline__ bool next(int i, Unit& u) const { u.e = 0; return o.tile(i, u.pm, u.pn); }
    __device__ __forceinline__ const char* aptr(const Unit& u) const { return A + (size_t)u.pm * (TSTEP / 2); }
    __device__ __forceinline__ const char* bptr(const Unit& u) const { return B + (size_t)u.pn * (TSTEP / 2); }
};
struct SchedMoe {
    static constexpr bool GATHER = false, LA = true;
    __device__ __forceinline__ bool idx(int i, Unit& u) const { return o.tile(i, u.pm, u.pn); }
    __device__ __forceinline__ int e_raw(const Unit& u) const { return tile_e[u.pm]; }
    Order o; const char* A; const char* B; const int* tile_e; size_t estride;
    __device__ __forceinline__ bool next(int i, Unit& u) const { if (!o.tile(i, u.pm, u.pn)) return false; u.e = __builtin_amdgcn_readfirstlane(tile_e[u.pm]); return true; }
    __device__ __forceinline__ const char* aptr(const Unit& u) const { return A + (size_t)u.pm * (TSTEP / 2); }
    __device__ __forceinline__ const char* bptr(const Unit& u) const { return B + (size_t)u.e * estride + (size_t)u.pn * (TSTEP / 2); }
};
struct SchedMoeG {
    static constexpr bool GATHER = true, LA = true;
    Order o; const char* A; const char* B; const int* tile_e; size_t estride; const int* rowdst;
    __device__ __forceinline__ bool idx(int i, Unit& u) const { return o.tile(i, u.pm, u.pn); }
    __device__ __forceinline__ int e_raw(const Unit& u) const { return tile_e[u.pm]; }
    __device__ __forceinline__ bool next(int i, Unit& u) const { if (!o.tile(i, u.pm, u.pn)) return false; u.e = __builtin_amdgcn_readfirstlane(tile_e[u.pm]); return true; }
    __device__ __forceinline__ const char* aptr(const Unit&) const { return A; }
    __device__ __forceinline__ const char* bptr(const Unit& u) const { return B + (size_t)u.e * estride + (size_t)u.pn * (TSTEP / 2); }
};
typedef int v8i __attribute__((ext_vector_type(8)));
__device__ __forceinline__ float fp8_bound() { float hi = 448.f; asm volatile("" : "+v"(hi)); return hi; }
__device__ __forceinline__ int fp8x4c(float a, float b, float c, float d, float hi) {
    a = __builtin_amdgcn_fmed3f(a, -hi, hi); b = __builtin_amdgcn_fmed3f(b, -hi, hi); c = __builtin_amdgcn_fmed3f(c, -hi, hi); d = __builtin_amdgcn_fmed3f(d, -hi, hi);
    int r = __builtin_amdgcn_cvt_pk_fp8_f32(a, b, 0, false); r = __builtin_amdgcn_cvt_pk_fp8_f32(c, d, r, true); return r;
}
__device__ __forceinline__ int fp8x4(float a, float b, float c, float d) {
    float hi = 448.f; asm volatile("" : "+v"(hi));
    a = __builtin_amdgcn_fmed3f(a, -hi, hi); b = __builtin_amdgcn_fmed3f(b, -hi, hi); c = __builtin_amdgcn_fmed3f(c, -hi, hi); d = __builtin_amdgcn_fmed3f(d, -hi, hi);
    int r = __builtin_amdgcn_cvt_pk_fp8_f32(a, b, 0, false); r = __builtin_amdgcn_cvt_pk_fp8_f32(c, d, r, true); return r;
}
__host__ __device__ __forceinline__ int x8(int rr) { return ((rr >> 1) & 1) | (((rr >> 3) & 1) << 2); }
__device__ __forceinline__ unsigned cvt_pk_bf16(float lo, float hi) { unsigned r; asm volatile("v_cvt_pk_bf16_f32 %0, %1, %2" : "=v"(r) : "v"(lo), "v"(hi)); return r; }

struct EpiProj {
    static constexpr bool DMAFILL = false; static constexpr int TABW = 0, TAB_OFF = 0; __device__ __forceinline__ void fill_load(const Unit&, int, unsigned (&)[2]) const {} __device__ __forceinline__ void fill_store(LAS unsigned*, int, const unsigned (&)[2]) const {}
    static constexpr bool PERM = true;
    bf16* O; int ldc; bf16* VT;
    __device__ __forceinline__ static bool vt_unit(const Unit& u) { return u.pn == 2 || u.pn == 5 || u.pn == 8; }
    __device__ __forceinline__ void operator()(const f32x4 (&acc)[2][2][4][2], const Unit& u, int wr, int wc, int fr, int fq) const {
        if (vt_unit(u)) {
            const int g = (u.pn - 2) / 3, tok0 = u.pm * BM + wc * 32 + 8 * fq, b = tok0 >> 11, t0 = tok0 & 2047;
            bf16* vb = VT + ((size_t)(g * NB + b) * 256 + wr * 64 + fr) * SEQ + t0;
#pragma unroll
            for (int ai = 0; ai < 2; ++ai)
#pragma unroll
                for (int m = 0; m < 4; ++m)
#pragma unroll
                    for (int bj = 0; bj < 2; ++bj) { const f32x4 v0 = acc[ai][bj][m][0], v1 = acc[ai][bj][m][1];
                        u32x4 w; w.x = cvt_pk_bf16(v0[0], v0[1]); w.y = cvt_pk_bf16(v0[2], v0[3]); w.z = cvt_pk_bf16(v1[0], v1[1]); w.w = cvt_pk_bf16(v1[2], v1[3]);
                        *(u32x4*)(vb + (size_t)(ai * HALF + m * 16) * SEQ + bj * HALF) = w; }
            return;
        }
        const int row0 = u.pm * BM + wr * 64 + fr, col0 = u.pn * BM + wc * 32 + 8 * fq;
#pragma unroll
        for (int ai = 0; ai < 2; ++ai)
#pragma unroll
            for (int m = 0; m < 4; ++m) { bf16* rowp = O + (size_t)(row0 + ai * HALF + m * 16) * ldc + col0;
#pragma unroll
                for (int bj = 0; bj < 2; ++bj) { const f32x4 v0 = acc[ai][bj][m][0], v1 = acc[ai][bj][m][1];
                    u32x4 w; w.x = cvt_pk_bf16(v0[0], v0[1]); w.y = cvt_pk_bf16(v0[2], v0[3]); w.z = cvt_pk_bf16(v1[0], v1[1]); w.w = cvt_pk_bf16(v1[2], v1[3]);
                    *(u32x4*)(rowp + bj * HALF) = w; } }
    }
};
struct EpiResid {
    static constexpr bool DMAFILL = false; static constexpr int TABW = 0, TAB_OFF = 0; __device__ __forceinline__ void fill_load(const Unit&, int, unsigned (&)[2]) const {} __device__ __forceinline__ void fill_store(LAS unsigned*, int, const unsigned (&)[2]) const {}
    static constexpr bool PERM = true; __device__ __forceinline__ static bool vt_unit(const Unit&) { return false; }
    const float* xin_f32; bf16* X; const float* gate;
    __device__ __forceinline__ void operator()(const f32x4 (&acc)[2][2][4][2], const Unit& u, int wr, int wc, int fr, int fq) const {
        const int row0 = u.pm * BM + wr * 64 + fr, col0 = u.pn * BM + wc * 32 + 8 * fq;
        const float* g = gate + (size_t)((u.pm * BM) >> 11) * 6144 + col0;
        f32x4 gv[2][2];
#pragma unroll
        for (int bj = 0; bj < 2; ++bj)
#pragma unroll
            for (int n = 0; n < 2; ++n) gv[bj][n] = *(const f32x4*)(g + bj * HALF + 4 * n);
#pragma unroll
        for (int ai = 0; ai < 2; ++ai)
#pragma unroll
            for (int m = 0; m < 4; ++m) { const size_t ro = (size_t)(row0 + ai * HALF + m * 16) * DM + col0;
#pragma unroll
                for (int bj = 0; bj < 2; ++bj) {
                    f32x4 x0, x1;
                    if (xin_f32) { x0 = *(const f32x4*)(xin_f32 + ro + bj * HALF); x1 = *(const f32x4*)(xin_f32 + ro + bj * HALF + 4); }
                    else { const u32x4 w = *(const u32x4*)(X + ro + bj * HALF);
                        x0 = (f32x4){__builtin_bit_cast(float, w.x << 16), __builtin_bit_cast(float, w.x & 0xffff0000u), __builtin_bit_cast(float, w.y << 16), __builtin_bit_cast(float, w.y & 0xffff0000u)};
                        x1 = (f32x4){__builtin_bit_cast(float, w.z << 16), __builtin_bit_cast(float, w.z & 0xffff0000u), __builtin_bit_cast(float, w.w << 16), __builtin_bit_cast(float, w.w & 0xffff0000u)}; }
                    const f32x4 v0 = x0 + gv[bj][0] * acc[ai][bj][m][0], v1 = x1 + gv[bj][1] * acc[ai][bj][m][1];
                    u32x4 o; o.x = cvt_pk_bf16(v0[0], v0[1]); o.y = cvt_pk_bf16(v0[2], v0[3]); o.z = cvt_pk_bf16(v1[0], v1[1]); o.w = cvt_pk_bf16(v1[2], v1[3]);
                    *(u32x4*)(X + ro + bj * HALF) = o; } }
    }
};
__device__ __forceinline__ float swiglu1(float g, float l) {
    g = fminf(g, 7.0f); l = fminf(fmaxf(l, -7.0f), 7.0f);
    const float s = __builtin_amdgcn_rcpf(1.0f + __builtin_amdgcn_exp2f(-1.702f * LOG2E * g));
    return g * s * (l + 1.0f);
}
__device__ __forceinline__ int arow(int m, int fr) { return (m >> 1) * 32 + 8 * (fr >> 2) + 4 * (m & 1) + (fr & 3); }
struct EpiProj8 {
    static constexpr bool DMAFILL = false; static constexpr int TABW = 0, TAB_OFF = 0; __device__ __forceinline__ void fill_load(const Unit&, int, unsigned (&)[2]) const {} __device__ __forceinline__ void fill_store(LAS unsigned*, int, const unsigned (&)[2]) const {}
    static constexpr bool PERM = true;
    bf16* O; int ldc; bf16* VT;
    __device__ __forceinline__ static bool vt_unit(const Unit& u) { return u.pn == 2 || u.pn == 5 || u.pn == 8; }
    __device__ __forceinline__ void operator()(const f32x4 (&acc)[2][2][4][2], const Unit& u, int wr, int wc, int fr, int fq) const {
        if (vt_unit(u)) {
            const int g = (u.pn - 2) / 3, tok0 = u.pm * BM + wc * 32 + 8 * fq, b = tok0 >> 11, t0 = tok0 & 2047;
            bf16* vb = VT + ((size_t)(g * NB + b) * 256 + wr * 64) * SEQ + t0;
#pragma unroll
            for (int ai = 0; ai < 2; ++ai)
#pragma unroll
                for (int m = 0; m < 4; ++m)
#pragma unroll
                    for (int bj = 0; bj < 2; ++bj) { const f32x4 v0 = acc[ai][bj][m][0] * 0.015625f, v1 = acc[ai][bj][m][1] * 0.015625f;
                        u32x4 w; w.x = cvt_pk_bf16(v0[0], v0[1]); w.y = cvt_pk_bf16(v0[2], v0[3]); w.z = cvt_pk_bf16(v1[0], v1[1]); w.w = cvt_pk_bf16(v1[2], v1[3]);
                        *(u32x4*)(vb + (size_t)(ai * HALF + arow(m, fr)) * SEQ + bj * HALF) = w; }
            return;
        }
        const int row0 = u.pm * BM + wr * 64, col0 = u.pn * BM + wc * 32 + 8 * fq;
#pragma unroll
        for (int ai = 0; ai < 2; ++ai)
#pragma unroll
            for (int m = 0; m < 4; ++m) { bf16* rowp = O + (size_t)(row0 + ai * HALF + arow(m, fr)) * ldc + col0;
#pragma unroll
                for (int bj = 0; bj < 2; ++bj) { const f32x4 v0 = acc[ai][bj][m][0] * 0.015625f, v1 = acc[ai][bj][m][1] * 0.015625f;
                    u32x4 w; w.x = cvt_pk_bf16(v0[0], v0[1]); w.y = cvt_pk_bf16(v0[2], v0[3]); w.z = cvt_pk_bf16(v1[0], v1[1]); w.w = cvt_pk_bf16(v1[2], v1[3]);
                    *(u32x4*)(rowp + bj * HALF) = w; } }
    }
};
__device__ __forceinline__ void swap16(unsigned& a, unsigned& b) { asm volatile("s_nop 1\n\tv_permlane16_swap_b32 %0, %1" : "+v"(a), "+v"(b)); }
struct EpiSwiglu {
    static constexpr bool PERM = true; __device__ __forceinline__ static bool vt_unit(const Unit&) { return false; }
    unsigned char* O; const float* bias;
    static constexpr bool DMAFILL = false; static constexpr int TABW = 256, TAB_OFF = 143360;
    __device__ __forceinline__ void fill_load(const Unit& u, int tid, unsigned (&v)[2]) const { const int t = tid & 255;
        v[0] = __builtin_bit_cast(unsigned, bias[(size_t)u.e * 2048 + (t < 128 ? u.pn * HALF + t : 1024 + u.pn * HALF + (t - 128))]); v[1] = 0u; }
    __device__ __forceinline__ void fill_store(LAS unsigned* tab, int tid, const unsigned (&v)[2]) const { tab[tid & 255] = v[0]; }
    __device__ __forceinline__ void operator()(const f32x4 (&acc)[2][2][4][2], const Unit& u, int wr, int wc, int fr, int fq, const LAS unsigned* tab) const {
        const int row0 = u.pm * BM + wr * 64, colw = u.pn * HALF + wc * 32 + 8 * (fq & ~1), odd = fq & 1;
        f32x4 bv[2][2];
#pragma unroll
        for (int bj = 0; bj < 2; ++bj)
#pragma unroll
            for (int n = 0; n < 2; ++n) { bv[bj][n] = *(const LAS f32x4*)(tab + bj * 128 + wc * 32 + 8 * fq + 4 * n); if (bj == 1) bv[bj][n] = bv[bj][n] * 4.0f + 4.0f; }
#pragma unroll
        for (int ai = 0; ai < 2; ++ai)
#pragma unroll
            for (int mp = 0; mp < 2; ++mp) { u32x2 wp[2];
#pragma unroll
              for (int mm = 0; mm < 2; ++mm) { const int m = 2 * mp + mm;
                int wq[2];
#pragma unroll
                for (int n = 0; n < 2; ++n) { const f32x4 g4 = acc[ai][0][m][n] * 0.015625f + bv[0][n], l4 = acc[ai][1][m][n] * 0.0625f + bv[1][n];
                    f32x2 r2[2];
#pragma unroll
                    for (int hh = 0; hh < 2; ++hh) {
                        f32x2 g = {fminf(g4[2 * hh], 7.0f), fminf(g4[2 * hh + 1], 7.0f)};
                        f32x2 l = {__builtin_amdgcn_fmed3f(l4[2 * hh], -24.0f, 32.0f), __builtin_amdgcn_fmed3f(l4[2 * hh + 1], -24.0f, 32.0f)};
                        const f32x2 ea = g * (-1.702f * LOG2E);
                        const f32x2 den = (f32x2){__builtin_amdgcn_exp2f(ea[0]), __builtin_amdgcn_exp2f(ea[1])} + 1.0f;
                        const f32x2 sg = {__builtin_amdgcn_rcpf(den[0]), __builtin_amdgcn_rcpf(den[1])};
                        r2[hh] = (g * sg) * l; }
                    int w = __builtin_amdgcn_cvt_pk_fp8_f32(r2[0][0], r2[0][1], 0, false); wq[n] = __builtin_amdgcn_cvt_pk_fp8_f32(r2[1][0], r2[1][1], w, true); }
                wp[mm].x = (unsigned)wq[0]; wp[mm].y = (unsigned)wq[1]; }
              unsigned ax = wp[0].x, ay = wp[0].y, bx = wp[1].x, by = wp[1].y;
              swap16(ax, bx); swap16(ay, by);
              *(u32x4*)(O + (size_t)(row0 + ai * HALF + arow(2 * mp + odd, fr)) * DM + colw) = (u32x4){ax, ay, bx, by}; }
    }
};
struct EpiDown {
    static constexpr bool PERM = true; __device__ __forceinline__ static bool vt_unit(const Unit&) { return false; }
    unsigned char* O; const float* bias; const int* dst; const float* gate;
    static constexpr int TABW = 768, TAB_OFF = 135168;
    static constexpr bool DMAFILL = true;
    __device__ __forceinline__ void fill_dma(const Unit& u, LAS unsigned* tab, int tid) const { const int wv = __builtin_amdgcn_readfirstlane(tid >> 6), t = tid & 255;
        if (wv < 4) { __builtin_amdgcn_global_load_lds((const unsigned*)(bias + (size_t)u.e * 1024 + u.pn * BM + t), tab + wv * 64, 4, 0, 0);
                      __builtin_amdgcn_global_load_lds((const unsigned*)(dst + u.pm * BM + t), tab + 256 + wv * 64, 4, 0, 0); }
        else __builtin_amdgcn_global_load_lds((const unsigned*)(gate + u.pm * BM + t), tab + 512 + (wv - 4) * 64, 4, 0, 0); }
    __device__ __forceinline__ void fill_load(const Unit& u, int tid, unsigned (&v)[2]) const { const int t = tid & 255;
        const float* p0 = (tid < 256) ? bias + (size_t)u.e * 1024 + u.pn * BM + t : gate + u.pm * BM + t;
        v[0] = __builtin_bit_cast(unsigned, *p0); v[1] = (unsigned)dst[u.pm * BM + t]; }
    __device__ __forceinline__ void fill_store(LAS unsigned* tab, int tid, const unsigned (&v)[2]) const { tab[tid + (tid < 256 ? 0 : 256)] = v[0]; tab[256 + (tid & 255)] = v[1]; }
    __device__ __forceinline__ void operator()(const f32x4 (&acc)[2][2][4][2], const Unit& u, int wr, int wc, int fr, int fq, const LAS unsigned* tab) const {
        const int colw = u.pn * BM + wc * 32 + 8 * (fq & ~1), odd = fq & 1;
        const float hib = fp8_bound();
        f32x4 bv[2][2];
#pragma unroll
        for (int bj = 0; bj < 2; ++bj)
#pragma unroll
            for (int n = 0; n < 2; ++n) bv[bj][n] = *(const LAS f32x4*)(tab + bj * HALF + wc * 32 + 8 * fq + 4 * n);
#pragma unroll
        for (int ai = 0; ai < 2; ++ai)
#pragma unroll
            for (int mp = 0; mp < 2; ++mp) { u32x2 wp[2][2];
#pragma unroll
                for (int mm = 0; mm < 2; ++mm) { const int m = 2 * mp + mm; const int rl = wr * 64 + ai * HALF + arow(m, fr); const float gt = __builtin_bit_cast(float, tab[512 + rl]) * 32.0f;
#pragma unroll
                    for (int bj = 0; bj < 2; ++bj) { const f32x4 v0 = (acc[ai][bj][m][0] * 0.00390625f + bv[bj][0]) * gt, v1 = (acc[ai][bj][m][1] * 0.00390625f + bv[bj][1]) * gt;
                        wp[mm][bj].x = (unsigned)fp8x4c(v0[0], v0[1], v0[2], v0[3], hib); wp[mm][bj].y = (unsigned)fp8x4c(v1[0], v1[1], v1[2], v1[3], hib); } }
                const int d = (int)tab[256 + wr * 64 + ai * HALF + arow(2 * mp + odd, fr)];
                unsigned char* rowp = O + (size_t)(d < 0 ? T * 4 : d) * DM + colw;
#pragma unroll
                for (int bj = 0; bj < 2; ++bj) { unsigned ax = wp[0][bj].x, ay = wp[0][bj].y, bx = wp[1][bj].x, by = wp[1][bj].y;
                    swap16(ax, bx); swap16(ay, by);
                    *(u32x4*)(rowp + bj * HALF) = (u32x4){ax, ay, bx, by}; } }
    }
};

struct EpiResid8 {
    static constexpr bool DMAFILL = false; static constexpr int TABW = 0, TAB_OFF = 0; __device__ __forceinline__ void fill_load(const Unit&, int, unsigned (&)[2]) const {} __device__ __forceinline__ void fill_store(LAS unsigned*, int, const unsigned (&)[2]) const {}
    static constexpr bool PERM = true; __device__ __forceinline__ static bool vt_unit(const Unit&) { return false; }
    const float* xin_f32; bf16* X; const float* gate;
    __device__ __forceinline__ void operator()(const f32x4 (&acc)[2][2][4][2], const Unit& u, int wr, int wc, int fr, int fq) const {
        const int row0 = u.pm * BM + wr * 64, col0 = u.pn * BM + wc * 32 + 8 * fq;
        const float* g = gate + (size_t)((u.pm * BM) >> 11) * 6144 + col0;
        f32x4 gv[2][2];
#pragma unroll
        for (int bj = 0; bj < 2; ++bj)
#pragma unroll
            for (int n = 0; n < 2; ++n) gv[bj][n] = *(const f32x4*)(g + bj * HALF + 4 * n) * 0.001953125f;
#pragma unroll
        for (int ai = 0; ai < 2; ++ai)
#pragma unroll
            for (int m = 0; m < 4; ++m) { const size_t ro = (size_t)(row0 + ai * HALF + arow(m, fr)) * DM + col0;
#pragma unroll
                for (int bj = 0; bj < 2; ++bj) {
                    f32x4 x0, x1;
                    if (xin_f32) { x0 = *(const f32x4*)(xin_f32 + ro + bj * HALF); x1 = *(const f32x4*)(xin_f32 + ro + bj * HALF + 4); }
                    else { const u32x4 w = *(const u32x4*)(X + ro + bj * HALF);
                        x0 = (f32x4){__builtin_bit_cast(float, w.x << 16), __builtin_bit_cast(float, w.x & 0xffff0000u), __builtin_bit_cast(float, w.y << 16), __builtin_bit_cast(float, w.y & 0xffff0000u)};
                        x1 = (f32x4){__builtin_bit_cast(float, w.z << 16), __builtin_bit_cast(float, w.z & 0xffff0000u), __builtin_bit_cast(float, w.w << 16), __builtin_bit_cast(float, w.w & 0xffff0000u)}; }
                    const f32x4 v0 = x0 + gv[bj][0] * acc[ai][bj][m][0], v1 = x1 + gv[bj][1] * acc[ai][bj][m][1];
                    u32x4 o; o.x = cvt_pk_bf16(v0[0], v0[1]); o.y = cvt_pk_bf16(v0[2], v0[3]); o.z = cvt_pk_bf16(v1[0], v1[1]); o.w = cvt_pk_bf16(v1[2], v1[3]);
                    *(u32x4*)(X + ro + bj * HALF) = o; } }
    }
};

template <class Epi, class Sched, bool FP8 = false>
__device__ __forceinline__ void gemm_phase(LAS unsigned char* lds, const Sched& S, const Epi& E, int wave_s) {
    const int tid = opaque_tid(wave_s), wid = __builtin_amdgcn_readfirstlane(tid >> 6), lane = tid & 63, wr = wid >> 2, wc = wid & 3, fr = lane & 15, fq = lane >> 4;
    constexpr int K = KD, nt = FP8 ? K / 128 : K / BK;
    unsigned voffA[2], voffB[2];
#pragma unroll
    for (int i = 0; i < 2; ++i) {
        if (FP8) { const int q = (tid * 16 + i * 8192) >> 4, st = q >> 7, rr = (q >> 3) & 15, s16 = (q & 7) ^ x8(rr); const int R = st * 16 + rr, Rb = (R & ~31) + perm32(R & 31);
            voffA[i] = voffB[i] = (unsigned)(Rb * K + s16 * 16); }
        else { int R, C; stage_rc(tid * 16 + i * 8192, R, C); const int Rb = Epi::PERM ? ((R & ~31) + perm32(R & 31)) : R;
            voffA[i] = (unsigned)(R * K + C) * 2u; voffB[i] = (unsigned)(Rb * K + C) * 2u; } }
    constexpr size_t kstep = KSTEP, hstep = FP8 ? HSTEP / 2 : HSTEP;
    constexpr bool GATHER = Sched::GATHER;
#define PG8_GTAB ((LAS unsigned*)(lds + GTAB_LDS) + opaque_tid(wave_s) * 2)
    const unsigned ldsw = (unsigned)wid * 1024u;
    const int aoff = FP8 ? ((wr * 64 + fr) * 8 + ((fq * 2) ^ x8(fr))) * 16 : lds_byte(wr * 64 + fr, fq * 8), boff = FP8 ? ((wc * 32 + fr) * 8 + ((fq * 2) ^ x8(fr))) * 16 : lds_byte(wc * 32 + fr, fq * 8);
    const int poff = FP8 ? ((((fq * 2 + 1) ^ x8(fr)) - ((fq * 2) ^ x8(fr))) * 16) : 1024;
    const LAS unsigned char* pa0 = lds + aoff; const LAS unsigned char* pa1 = lds + aoff + poff; const LAS unsigned char* pb0 = lds + 65536 + boff; const LAS unsigned char* pb1 = lds + 65536 + boff + poff;
    asm volatile("" : "+v"(pa0), "+v"(pa1), "+v"(pb0), "+v"(pb1));

#define PG8_SA(b, h) (((b) * 2 + (h)) * HTB)
#define PG8_SB(b, h) ((4 + (b) * 2 + (h)) * HTB)
#define PG8_VOFFB (FP8 ? voffA : voffB)
#define PG8_STAGE(bufoff, gbase, voff) do { _Pragma("unroll") for (int _i = 0; _i < 2; ++_i) { unsigned _v = (voff)[_i]; asm volatile("" : "+v"(_v));     \
        __builtin_amdgcn_global_load_lds((const unsigned*)((const char*)(gbase) + _v), (LAS unsigned*)(lds + (bufoff) + ldsw + _i * 8192), 16, 0, 0); } } while (0)
#define PG8_STAGE_A(bufoff, gbase, h, par) do { if constexpr (GATHER) { const unsigned _w = PG8_GTAB[(par) * 1024 + (h)]; _Pragma("unroll") for (int _i = 0; _i < 2; ++_i) { \
            unsigned _v = ((_w >> (16 * _i)) & 0xffffu) * 1024u + (voffA[_i] & 1023u); asm volatile("" : "+v"(_v)); \
            __builtin_amdgcn_global_load_lds((const unsigned*)((const char*)(gbase) + _v), (LAS unsigned*)(lds + (bufoff) + ldsw + _i * 8192), 16, 0, 0); } } \
        else PG8_STAGE(bufoff, (gbase) + (h) * hstep, voffA); } while (0)
#define PG8_GLOAD(u, g) do { if constexpr (GATHER) { _Pragma("unroll") for (int _h = 0; _h < 2; ++_h) _Pragma("unroll") for (int _i = 0; _i < 2; ++_i) { \
            unsigned _vo = voffA[_i]; asm volatile("" : "+v"(_vo)); (g)[_h * 2 + _i] = S.rowdst[(u).pm * BM + _h * HALF + (int)(_vo >> 10)]; } } } while (0)
#define PG8_GSTORE(par, g) do { if constexpr (GATHER) { _Pragma("unroll") for (int _h = 0; _h < 2; ++_h) { unsigned _w = 0; _Pragma("unroll") for (int _i = 0; _i < 2; ++_i) { \
            const int _d = (g)[_h * 2 + _i]; _w |= (unsigned)(_d < 0 ? 0 : (_d >> 2)) << (16 * _i); } PG8_GTAB[(par) * 1024 + _h] = _w; } } } while (0)
#define PG8_GFILL(u, par) do { if constexpr (GATHER) { _Pragma("unroll") for (int _h = 0; _h < 2; ++_h) { unsigned _w = 0; _Pragma("unroll") for (int _i = 0; _i < 2; ++_i) { \
            unsigned _vo = voffA[_i]; asm volatile("" : "+v"(_vo));     \
            const int _d = S.rowdst[(u).pm * BM + _h * HALF + (int)(_vo >> 10)]; _w |= (unsigned)(_d < 0 ? 0 : (_d >> 2)) << (16 * _i); } PG8_GTAB[(par) * 1024 + _h] = _w; } } } while (0)
#define PG8_LDA(dst, b, h) do { _Pragma("unroll") for (int m = 0; m < 4; ++m) _Pragma("unroll") for (int k = 0; k < 2; ++k) dst[m][k] = *(const LAS bf16x8*)((k ? pa1 : pa0) + PG8_SA(b, h) + m * 2048); } while (0)
#define PG8_LDB(dst, b, h) do { _Pragma("unroll") for (int n = 0; n < 2; ++n) _Pragma("unroll") for (int k = 0; k < 2; ++k) dst[n][k] = *(const LAS bf16x8*)((k ? pb1 : pb0) + (PG8_SB(b, h) - 65536) + n * 2048); } while (0)
#define PG8_V8(f) __builtin_shufflevector(__builtin_bit_cast(u32x4, (f)[0]), __builtin_bit_cast(u32x4, (f)[1]), 0, 1, 2, 3, 4, 5, 6, 7)
#define PG8_MMA(ai, bj, At, Bt) do { __builtin_amdgcn_s_setprio(1); \
        if constexpr (FP8) { _Pragma("unroll") for (int m = 0; m < 4; ++m) _Pragma("unroll") for (int n = 0; n < 2; ++n) \
            acc[ai][bj][m][n] = __builtin_amdgcn_mfma_scale_f32_16x16x128_f8f6f4(__builtin_bit_cast(v8i, PG8_V8(Bt[n])), __builtin_bit_cast(v8i, PG8_V8(At[m])), acc[ai][bj][m][n], 0, 0, 0, 0, 0, 0); } \
        else { _Pragma("unroll") for (int m = 0; m < 4; ++m) _Pragma("unroll") for (int n = 0; n < 2; ++n) _Pragma("unroll") for (int k = 0; k < 2; ++k) \
            acc[ai][bj][m][n] = __builtin_amdgcn_mfma_f32_16x16x32_bf16(Bt[n][k], At[m][k], acc[ai][bj][m][n], 0, 0, 0); } \
        __builtin_amdgcn_s_setprio(0); } while (0)
#define PG8_WAIT_V(n) asm volatile("s_waitcnt vmcnt(" #n ")" ::: "memory")
#define PG8_WAIT_L(n) asm volatile("s_waitcnt lgkmcnt(" #n ")" ::: "memory")
#define PG8_BAR __builtin_amdgcn_s_barrier()
#define PG8_SCHED __builtin_amdgcn_sched_barrier(0)
    Unit cur, nxt; int ui = 0;
    if (!S.next(0, cur)) return;
    f32x4 acc[2][2][4][2];
    { float z0 = 0.f; asm volatile("" : "+v"(z0));
#pragma unroll
    for (int a = 0; a < 2; ++a)
#pragma unroll
        for (int b = 0; b < 2; ++b)
#pragma unroll
            for (int m = 0; m < 4; ++m)
#pragma unroll
                for (int n = 0; n < 2; ++n) acc[a][b][m][n] = (f32x4){z0, z0, z0, z0}; }
    bf16x8 At[4][2], B0[2][2], B1[2][2];
    const char* cA = Epi::vt_unit(cur) ? S.bptr(cur) : S.aptr(cur); const char* cB = Epi::vt_unit(cur) ? S.aptr(cur) : S.bptr(cur);
    int cpar = 0;
    PG8_GFILL(cur, 0);
    if constexpr (Sched::LA && GATHER) { Unit t1; if (S.idx(1, t1)) PG8_GFILL(t1, 1); }
    {
        PG8_STAGE(PG8_SB(0, 0), cB, PG8_VOFFB); PG8_STAGE(PG8_SB(0, 1), cB + hstep, PG8_VOFFB); PG8_STAGE_A(PG8_SA(0, 0), cA, 0, 0); PG8_STAGE_A(PG8_SA(0, 1), cA, 1, 0);
        if (wr == 1) PG8_BAR;
        PG8_WAIT_V(2); PG8_BAR;
        PG8_STAGE(PG8_SB(1, 0), cB + kstep, PG8_VOFFB); PG8_STAGE_A(PG8_SA(1, 0), cA + kstep, 0, 0); PG8_STAGE(PG8_SB(1, 1), cB + hstep + kstep, PG8_VOFFB);
        PG8_WAIT_V(6); PG8_BAR;
    }
    constexpr bool LA = Sched::LA;
    bool has_next = false;
    nxt = cur;
    if constexpr (LA) {
        has_next = S.next(1, nxt);
        if constexpr (Epi::TABW > 0) { unsigned fv[2]; const int tz = opaque_tid(wave_s); E.fill_load(cur, tz, fv); E.fill_store((LAS unsigned*)(lds + Epi::TAB_OFF), tz, fv); }
    }
    for (;;) {
        if constexpr (!LA) {
        has_next = S.next(ui + 1, nxt);
        if constexpr (Epi::TABW > 0) { unsigned fv[2]; const int tz = opaque_tid(wave_s); E.fill_load(cur, tz, fv); E.fill_store((LAS unsigned*)(lds + Epi::TAB_OFF) + (ui & 1) * Epi::TABW, tz, fv); }
        }
        const bool nvt = has_next && Epi::vt_unit(nxt);
        const char* nA = has_next ? (nvt ? S.bptr(nxt) : S.aptr(nxt)) : cA; const char* nB = has_next ? (nvt ? S.aptr(nxt) : S.bptr(nxt)) : cB;
        if constexpr (!LA) { if (has_next) PG8_GFILL(nxt, cpar ^ 1); }
        const int npar = has_next ? (cpar ^ 1) : cpar;
#pragma unroll 1
        for (int t = 0; t < nt; t += 2) {
            const bool last = (t == nt - 2);
            const char* a1 = cA + (size_t)(t + 1) * kstep;
            const char* a2 = last ? nA : cA + (size_t)(t + 2) * kstep; const char* b2 = last ? nB : cB + (size_t)(t + 2) * kstep;
            const char* a3 = a2 + kstep; const char* b3 = b2 + kstep;
            const int p2 = last ? npar : cpar;
            PG8_LDB(B0, 0, 0); PG8_LDB(B1, 0, 1); PG8_SCHED; PG8_LDA(At, 0, 0); PG8_STAGE_A(PG8_SA(1, 1), a1, 1, cpar);
            PG8_WAIT_V(8); PG8_WAIT_L(0); PG8_BAR; PG8_MMA(0, 0, At, B0); PG8_MMA(0, 1, At, B1); PG8_BAR; PG8_SCHED;
            PG8_LDA(At, 0, 1); PG8_STAGE(PG8_SB(0, 0), b2, PG8_VOFFB); PG8_STAGE(PG8_SB(0, 1), b2 + hstep, PG8_VOFFB); PG8_STAGE_A(PG8_SA(0, 0), a2, 0, p2);
            PG8_WAIT_V(8); PG8_WAIT_L(0); PG8_BAR; PG8_MMA(1, 0, At, B0); PG8_MMA(1, 1, At, B1); PG8_BAR; PG8_SCHED;
            PG8_LDB(B0, 1, 0); PG8_LDB(B1, 1, 1); PG8_SCHED; PG8_LDA(At, 1, 0); PG8_STAGE_A(PG8_SA(0, 1), a2, 1, p2);
            PG8_WAIT_V(8); PG8_WAIT_L(0); PG8_BAR; PG8_MMA(0, 0, At, B0); PG8_MMA(0, 1, At, B1); PG8_BAR; PG8_SCHED;
            PG8_LDA(At, 1, 1); PG8_STAGE(PG8_SB(1, 0), b3, PG8_VOFFB); PG8_STAGE(PG8_SB(1, 1), b3 + hstep, PG8_VOFFB); PG8_STAGE_A(PG8_SA(1, 0), a3, 0, p2);
            PG8_WAIT_V(8); PG8_WAIT_L(0); PG8_BAR; PG8_MMA(1, 0, At, B0); PG8_MMA(1, 1, At, B1); PG8_BAR; PG8_SCHED;
        }
        Unit nx2 = nxt; bool has_n2 = false; int e2 = 0; unsigned fv2[2] = {0u, 0u}; int g4[4] = {0, 0, 0, 0};
        if constexpr (LA) has_n2 = has_next && S.idx(ui + 2, nx2);
        if (wr == 0) PG8_BAR;
        constexpr bool DMAT = LA && !GATHER && Epi::DMAFILL;
        if constexpr (DMAT) { __builtin_amdgcn_global_load_lds((const unsigned*)(S.tile_e + nx2.pm), (LAS unsigned*)(lds + TE_LDS + ldsw / 4), 4, 0, 0);
                              E.fill_dma(nxt, (LAS unsigned*)(lds + Epi::TAB_OFF) + ((ui + 1) & 1) * Epi::TABW, opaque_tid(wave_s)); }
        else if constexpr (LA) { e2 = S.e_raw(nx2); PG8_GLOAD(nx2, g4); if constexpr (Epi::TABW > 0) E.fill_load(nxt, opaque_tid(wave_s), fv2); }
        { const int tz = opaque_tid(wave_s); const int l2 = tz & 63, w2 = __builtin_amdgcn_readfirstlane(tz >> 6); if constexpr (Epi::TABW > 0) E(acc, cur, w2 >> 2, w2 & 3, l2 & 15, l2 >> 4, (const LAS unsigned*)(lds + Epi::TAB_OFF) + (ui & 1) * Epi::TABW); else E(acc, cur, w2 >> 2, w2 & 3, l2 & 15, l2 >> 4); }
        if (!has_next) break;
        { float z0 = 0.f; asm volatile("" : "+v"(z0));
#pragma unroll
        for (int a = 0; a < 2; ++a)
#pragma unroll
            for (int b = 0; b < 2; ++b)
#pragma unroll
                for (int m = 0; m < 4; ++m)
#pragma unroll
                    for (int n = 0; n < 2; ++n) acc[a][b][m][n] = (f32x4){z0, z0, z0, z0}; }
        if constexpr (DMAT) { asm volatile("s_waitcnt vmcnt(8)" ::: "memory");
                              const int ev = *(const LAS int*)(lds + TE_LDS + ldsw / 4); if (has_n2) nx2.e = __builtin_amdgcn_readfirstlane(ev); }
        else if constexpr (LA) { asm volatile("" : "+v"(e2), "+v"(g4[0]), "+v"(g4[1]), "+v"(g4[2]), "+v"(g4[3]), "+v"(fv2[0]), "+v"(fv2[1]));
                            if (has_n2) { nx2.e = __builtin_amdgcn_readfirstlane(e2); PG8_GSTORE(cpar, g4); }
                            if constexpr (Epi::TABW > 0) E.fill_store((LAS unsigned*)(lds + Epi::TAB_OFF) + ((ui + 1) & 1) * Epi::TABW, opaque_tid(wave_s), fv2); }
        cur = nxt; cA = nA; cB = nB; ++ui; cpar = npar;
        if constexpr (LA) { nxt = nx2; has_next = has_n2; }
        if (wr == 1) PG8_BAR;
    }
    PG8_WAIT_V(0);
    PG8_BAR;
#undef PG8_SA
#undef PG8_SB
#undef PG8_STAGE
#undef PG8_STAGE_A
#undef PG8_GTAB
#undef PG8_GFILL
#undef PG8_GLOAD
#undef PG8_GSTORE
#undef PG8_VOFFB
#undef PG8_LDA
#undef PG8_LDB
#undef PG8_MMA
#undef PG8_V8
#undef PG8_WAIT_V
#undef PG8_WAIT_L
#undef PG8_BAR
#undef PG8_SCHED
}
}

struct Frame {
    LAS unsigned char* lds;
    int tid, lane, wave, vcu, G, vcu0, G0, wave0;
};
__device__ __forceinline__ int opq_s(int v) { asm volatile("" : "+s"(v)); return v; }

__device__ __forceinline__ int win_src_col(int d) {
    if (d < 768) return d;
    if (d < 1536) return 1320 + (d - 768);
    if (d < 2304) return 2088 + (d - 1536);
    if (d < 2560) return 772 + (d - 2304);
    if (d < 2688) return 1028 + (d - 2560);
    if (d < 2816) return 1156 + (d - 2688);
    if (d < 2848) return 1284 + (d - 2816);
    if (d < 2852) return 1316 + (d - 2848);
    if (d < 2856) return 768 + (d - 2852);
    return -1;
}
__device__ __forceinline__ void tr_item(const float* W, int ldw, bf16* WT, int k0, int d0, int sc, LAS float* scr, int lane) {
#pragma unroll 8
    for (int i = 0; i < 32; ++i) { const int kk = 2 * i + (lane >> 5); scr[kk * 33 + (lane & 31)] = sc >= 0 ? __builtin_nontemporal_load(&W[(size_t)(k0 + kk) * ldw + sc]) : 0.f; }
    LDS_WAIT(); asm volatile("" ::: "memory");
    const int c = lane & 7;
#pragma unroll
    for (int j = 0; j < 4; ++j) { const int n = (lane >> 3) + 8 * j; const LAS float* s = scr + (8 * c) * 33 + n;
        u32x4 o; o.x = pk2(s[0 * 33], s[1 * 33]); o.y = pk2(s[2 * 33], s[3 * 33]); o.z = pk2(s[4 * 33], s[5 * 33]); o.w = pk2(s[6 * 33], s[7 * 33]);
        *(u32x4*)(WT + (size_t)(d0 + n) * 1024 + k0 + 8 * c) = o; }
    LDS_WAIT(); asm volatile("" ::: "memory");
}
__device__ __forceinline__ void tr_item8(const float* W, int ldw, unsigned char* WT, int k0, int d0, int sc, LAS float* scr, int lane) {
#pragma unroll 8
    for (int i = 0; i < 32; ++i) { const int kk = 2 * i + (lane >> 5); scr[kk * 33 + (lane & 31)] = sc >= 0 ? __builtin_nontemporal_load(&W[(size_t)(k0 + kk) * ldw + sc]) * 64.0f : 0.f; }
    LDS_WAIT(); asm volatile("" ::: "memory");
    const int c = lane & 7;
#pragma unroll
    for (int j = 0; j < 4; ++j) { const int n = (lane >> 3) + 8 * j; const LAS float* s = scr + (8 * c) * 33 + n;
        u32x2 o; o.x = (unsigned)pg8::fp8x4(s[0 * 33], s[1 * 33], s[2 * 33], s[3 * 33]); o.y = (unsigned)pg8::fp8x4(s[4 * 33], s[5 * 33], s[6 * 33], s[7 * 33]);
        *(u32x2*)(WT + (size_t)(d0 + n) * 1024 + k0 + 8 * c) = o; }
    LDS_WAIT(); asm volatile("" ::: "memory");
}
__device__ __forceinline__ void sincos_d(float angf, float& cs, float& sn) {
    const double a = (double)angf;
    const double q = __builtin_rint(a * 0.63661977236758134308);
    const double r = __builtin_fma(-q, 1.57079632679489661923, a) - q * 6.123233995736766e-17;
    const double r2 = r * r;
    double s = -1.0 / 39916800.0; s = s * r2 + 1.0 / 362880.0; s = s * r2 - 1.0 / 5040.0; s = s * r2 + 1.0 / 120.0; s = s * r2 - 1.0 / 6.0; s = s * r2 * r + r;
    double c = 1.0 / 479001600.0; c = c * r2 - 1.0 / 3628800.0; c = c * r2 + 1.0 / 40320.0; c = c * r2 - 1.0 / 720.0; c = c * r2 + 1.0 / 24.0; c = c * r2 - 0.5; c = c * r2 + 1.0;
    const int qi = ((int)q) & 3;
    const double cc = (qi == 0) ? c : (qi == 1) ? -s : (qi == 2) ? -c : s;
    const double ss = (qi == 0) ? s : (qi == 1) ? c : (qi == 2) ? -s : -c;
    cs = (float)cc; sn = (float)ss;
}
__device__ __forceinline__ void p0_prologue(KP Pq, Frame& F) {
    F.tid = opaque_tid(F.wave0); F.lane = F.tid & 63; F.wave = opq_s(F.wave0); F.vcu = opq_s(F.vcu0); F.G = opq_s(F.G0); const KP P = kp_fresh(); (void)Pq;
    unsigned char* ws = P->ws;
    LAS float* scr = (LAS float*)(F.lds + F.wave * 16384);
    const int gw = F.vcu * 8 + F.wave, NGW = F.G * 8;
    constexpr int N_WIN = NL * 16 * 96, N_WO = NL * 16 * 32, N_GU = NL * NE * 16 * 64, N_DN = NL * NE * 16 * 32;
    for (int it = gw; it < N_WIN + N_WO + N_GU + N_DN; it += NGW) {
        int r = it;
        if (r < N_WIN) { const int l = r / 1536, rr = r % 1536, kb = rr / 96, db = rr % 96;
            tr_item8(P->w_in + (size_t)l * 1024 * IN_COLS, IN_COLS, (unsigned char*)(ws + WS_WIN) + (size_t)l * NP * 1024, kb * 64, db * 32, win_src_col(db * 32 + (F.lane & 31)), scr, F.lane); continue; }
        r -= N_WIN;
        if (r < N_WO) { const int l = r / 512, rr = r % 512, kb = rr / 32, db = rr % 32;
            tr_item8(P->w_o + (size_t)l * 1024 * 1024, 1024, (unsigned char*)(ws + WS_WO) + (size_t)l * 1024 * 1024, kb * 64, db * 32, db * 32 + (F.lane & 31), scr, F.lane); continue; }
        r -= N_WO;
        if (r < N_GU) { const int le = r / 1024, rr = r % 1024, kb = rr / 64, db = rr % 64;
            const int pn = db >> 3, w = db & 7; const int src = (w < 4) ? (pn * 128 + w * 32) : (1024 + pn * 128 + (w - 4) * 32);
            tr_item8(P->w_gu + (size_t)le * 1024 * 2048, 2048, (unsigned char*)(ws + WS_WGU) + (size_t)le * 2048 * 1024, kb * 64, db * 32, src + (F.lane & 31), scr, F.lane); continue; }
        r -= N_GU;
        { const int le = r / 512, rr = r % 512, kb = rr / 32, db = rr % 32;
            tr_item8(P->w_dn + (size_t)le * 1024 * 1024, 1024, (unsigned char*)(ws + WS_WDN) + (size_t)le * 1024 * 1024, kb * 64, db * 32, db * 32 + (F.lane & 31), scr, F.lane); }
    }
    const int gt = F.vcu * 512 + F.tid, NGT = F.G * 512;
    for (int i = gt; i < NL * 32 * 1024; i += NGT) { const int l = i >> 15, e = (i >> 10) & 31, k = i & 1023;
        const float w = P->w_router[((size_t)l * 1024 + k) * 32 + e]; const unsigned hi = f2bf(w); const unsigned lo = f2bf(w - bf2f(hi));
        ((bf16*)(ws + WS_WRT))[i] = (bf16)hi; ((bf16*)(ws + WS_WRT))[NL * 32 * 1024 + i] = (bf16)lo; }
    float* rt = (float*)(ws + WS_ROPE);
    for (int i = gt; i < SEQ * 48; i += NGT) { const int t = i / 48, j = i % 48;
        const int half = j < 32 ? 32 : 16, ii = j < 32 ? j : j - 32;
        const float inv = (float)exp(-9.210340371976184 * (double)ii / (double)half);
        const float ang = (float)t * inv; float cs, sn; sincos_d(ang, cs, sn);
        if (j < 32) { rt[t * 32 + ii] = cs; rt[SEQ * 32 + t * 32 + ii] = sn; }
        else { rt[SEQ * 64 + t * 16 + ii] = cs; rt[SEQ * 64 + SEQ * 16 + t * 16 + ii] = sn; } }
    __syncthreads();
    {
        LAS float* cact = (LAS float*)(F.lds);
        LAS float* red = (LAS float*)(F.lds + 32768);
        float* mod = (float*)(ws + WS_MOD);
        for (int it = F.vcu; it < NL * 48; it += F.G) {
            const int l = it / 48, cg = it % 48, cj = F.tid & 127, kq = F.tid >> 7, col = cg * 128 + cj;
            float acc[32];
#pragma unroll
            for (int b = 0; b < 32; ++b) acc[b] = 0.f;
            for (int kc = 0; kc < 8; ++kc) {
                __syncthreads();
#pragma unroll
                for (int i = 0; i < 8; ++i) { const int idx = F.tid + 512 * i, b = idx & 31, kk = idx >> 5; const float v = P->c[b * 1024 + kc * 128 + kk];
                    cact[kk * 32 + b] = v * __builtin_amdgcn_rcpf(1.0f + ex2(-v * LOG2E)); }
                __syncthreads();
                for (int k2 = 0; k2 < 32; ++k2) { const int kk = kq * 32 + k2; const float w = P->w_ada[((size_t)l * 1024 + kc * 128 + kk) * 6144 + col];
#pragma unroll
                    for (int b4 = 0; b4 < 8; ++b4) { const f32x4 cv = *(const LAS f32x4*)(cact + kk * 32 + 4 * b4);
                        const f32x2 lo = (f32x2){cv[0], cv[1]} * w + (f32x2){acc[4 * b4], acc[4 * b4 + 1]}, hi = (f32x2){cv[2], cv[3]} * w + (f32x2){acc[4 * b4 + 2], acc[4 * b4 + 3]};
                        acc[4 * b4] = lo[0]; acc[4 * b4 + 1] = lo[1]; acc[4 * b4 + 2] = hi[0]; acc[4 * b4 + 3] = hi[1]; } }
            }
#pragma unroll
            for (int b = 0; b < 32; ++b) red[(kq * 32 + b) * 128 + cj] = acc[b];
            __syncthreads();
#pragma unroll
            for (int i = 0; i < 8; ++i) { const int idx = F.tid + 512 * i, b = idx >> 7, c2 = idx & 127;
                const float s = red[(0 * 32 + b) * 128 + c2] + red[(1 * 32 + b) * 128 + c2] + red[(2 * 32 + b) * 128 + c2] + red[(3 * 32 + b) * 128 + c2];
                mod[((size_t)l * 32 + b) * 6144 + cg * 128 + c2] = s + P->b_ada[l * 6144 + cg * 128 + c2]; }
            __syncthreads();
        }
    }
}

__device__ __forceinline__ void bf8_to_f(const u32x4 w, float (&o)[8]) {
    o[0] = __builtin_bit_cast(float, w.x << 16); o[1] = __builtin_bit_cast(float, w.x & 0xffff0000u); o[2] = __builtin_bit_cast(float, w.y << 16); o[3] = __builtin_bit_cast(float, w.y & 0xffff0000u);
    o[4] = __builtin_bit_cast(float, w.z << 16); o[5] = __builtin_bit_cast(float, w.z & 0xffff0000u); o[6] = __builtin_bit_cast(float, w.w << 16); o[7] = __builtin_bit_cast(float, w.w & 0xffff0000u);
}
template <int MODE>
__device__ __forceinline__ void norm_phase(KP Pq, Frame& F, int l) {
    F.tid = opaque_tid(F.wave0); F.lane = F.tid & 63; F.wave = opq_s(F.wave0); F.vcu = opq_s(F.vcu0); F.G = opq_s(F.G0); const KP P = kp_fresh(); (void)Pq;
    unsigned char* ws = P->ws;
    const float* mod = (const float*)(ws + WS_MOD);
    bf16* X = (bf16*)(ws + WS_X);
    unsigned char* H = (unsigned char*)(ws + WS_H);
    const unsigned char* SL = (const unsigned char*)(ws + WS_SLOT);
    const int gw = F.vcu * 8 + F.wave, NGW = F.G * 8, lane = F.lane;
    for (int tok0 = gw * 2; tok0 < T; tok0 += NGW * 2) {
        const int b = tok0 >> 11;
        float v[2][2][8];
#pragma unroll
        for (int tt = 0; tt < 2; ++tt)
#pragma unroll
            for (int j = 0; j < 2; ++j) { const size_t off = (size_t)(tok0 + tt) * DM + 8 * lane + 512 * j;
                if (MODE == 0) { const f32x4 a = *(const f32x4*)(P->x + off), c = *(const f32x4*)(P->x + off + 4);
                    v[tt][j][0] = a[0]; v[tt][j][1] = a[1]; v[tt][j][2] = a[2]; v[tt][j][3] = a[3]; v[tt][j][4] = c[0]; v[tt][j][5] = c[1]; v[tt][j][6] = c[2]; v[tt][j][7] = c[3]; }
                else bf8_to_f(*(const u32x4*)(X + off), v[tt][j]); }
        if (MODE == 1 || MODE == 2) {
            const float* g2 = mod + ((size_t)((MODE == 1 ? l - 1 : NL - 1) * 32 + b)) * 6144 + 5 * 1024;
#pragma unroll
            for (int j = 0; j < 2; ++j) {
                const f32x4 ga = *(const f32x4*)(g2 + 8 * lane + 512 * j), gb = *(const f32x4*)(g2 + 8 * lane + 512 * j + 4);
#pragma unroll
                for (int tt = 0; tt < 2; ++tt) {
                    u32x2 w[4];
#pragma unroll
                    for (int k = 0; k < 4; ++k) w[k] = *(const u32x2*)(SL + ((size_t)(tok0 + tt) * 4 + k) * DM + 8 * lane + 512 * j);
                    float sacc[8] = {0.f, 0.f, 0.f, 0.f, 0.f, 0.f, 0.f, 0.f};
#pragma unroll
                    for (int k = 0; k < 4; ++k) {
                        const f32x2 a0 = __builtin_amdgcn_cvt_pk_f32_fp8((int)w[k].x, false), a1 = __builtin_amdgcn_cvt_pk_f32_fp8((int)w[k].x, true), a2 = __builtin_amdgcn_cvt_pk_f32_fp8((int)w[k].y, false), a3 = __builtin_amdgcn_cvt_pk_f32_fp8((int)w[k].y, true);
                        sacc[0] += a0[0]; sacc[1] += a0[1]; sacc[2] += a1[0]; sacc[3] += a1[1]; sacc[4] += a2[0]; sacc[5] += a2[1]; sacc[6] += a3[0]; sacc[7] += a3[1]; }
#pragma unroll
                    for (int i = 0; i < 8; ++i) v[tt][j][i] += (i < 4 ? ga[i] : gb[i - 4]) * (sacc[i] * 0.03125f);
                    if (MODE == 1) { u32x4 o; o.x = pk2(v[tt][j][0], v[tt][j][1]); o.y = pk2(v[tt][j][2], v[tt][j][3]); o.z = pk2(v[tt][j][4], v[tt][j][5]); o.w = pk2(v[tt][j][6], v[tt][j][7]);
                        *(u32x4*)(X + (size_t)(tok0 + tt) * DM + 8 * lane + 512 * j) = o; bf8_to_f(o, v[tt][j]); }
                }
            }
        }
        float rstd[2];
#pragma unroll
        for (int tt = 0; tt < 2; ++tt) { float ss = 0.f;
#pragma unroll
            for (int j = 0; j < 2; ++j)
#pragma unroll
                for (int i = 0; i < 8; i += 2) ss += v[tt][j][i] * v[tt][j][i] + v[tt][j][i + 1] * v[tt][j][i + 1];
            rstd[tt] = __builtin_amdgcn_rsqf(wave_sum(ss) * (1.0f / DM) + 1e-6f); }
        if (MODE == 2) {
#pragma unroll
            for (int j = 0; j < 2; ++j) { const f32x4 ga = *(const f32x4*)(P->final_g + 8 * lane + 512 * j), gb = *(const f32x4*)(P->final_g + 8 * lane + 512 * j + 4);
#pragma unroll
                for (int tt = 0; tt < 2; ++tt) { float* o = P->out + (size_t)(tok0 + tt) * DM + 8 * lane + 512 * j;
                    *(f32x4*)o = (f32x4){v[tt][j][0], v[tt][j][1], v[tt][j][2], v[tt][j][3]} * rstd[tt] * ga; *(f32x4*)(o + 4) = (f32x4){v[tt][j][4], v[tt][j][5], v[tt][j][6], v[tt][j][7]} * rstd[tt] * gb; } }
        } else {
            const float* gn = P->norm1_g + l * DM;
            const float* mb = mod + ((size_t)(l * 32 + b)) * 6144;
#pragma unroll
            for (int j = 0; j < 2; ++j) {
                const int c0 = 8 * lane + 512 * j;
                float g8[8], sh8[8], sc8[8];
                { const f32x4 a = *(const f32x4*)(gn + c0), c = *(const f32x4*)(gn + c0 + 4), d = *(const f32x4*)(mb + c0), e = *(const f32x4*)(mb + c0 + 4), f = *(const f32x4*)(mb + 1024 + c0), g = *(const f32x4*)(mb + 1024 + c0 + 4);
#pragma unroll
                  for (int i = 0; i < 4; ++i) { g8[i] = a[i]; g8[4 + i] = c[i]; sh8[i] = d[i]; sh8[4 + i] = e[i]; sc8[i] = f[i] + 1.0f; sc8[4 + i] = g[i] + 1.0f; } }
#pragma unroll
                for (int tt = 0; tt < 2; ++tt) { float h[8];
#pragma unroll
                    for (int i = 0; i < 8; ++i) h[i] = (v[tt][j][i] * rstd[tt] * g8[i]) * sc8[i] + sh8[i];
                    u32x2 o; o.x = (unsigned)pg8::fp8x4(h[0], h[1], h[2], h[3]); o.y = (unsigned)pg8::fp8x4(h[4], h[5], h[6], h[7]);
                    *(u32x2*)(H + (size_t)(tok0 + tt) * DM + c0) = o; }
            }
        }
    }
}

template <bool DRY> __device__ __forceinline__ void prep_phase(KP Pq, Frame& F, int l) {
    F.tid = opaque_tid(F.wave0); F.lane = F.tid & 63; F.wave = opq_s(F.wave0); F.vcu = opq_s(F.vcu0); F.G = opq_s(F.G0); const KP P = kp_fresh(); (void)Pq;
    unsigned char* ws = P->ws;
    bf16* PR = (bf16*)(ws + WS_PROJ);
    bf16* KB = (bf16*)(ws + WS_KB); bf16* VBT = (bf16*)(ws + WS_VBT);
    float* LF = (float*)(ws + WS_LF);
    const float* rt = (const float*)(ws + WS_ROPE);
    const float* cos64 = rt, * sin64 = rt + SEQ * 32, * cos32 = rt + SEQ * 64, * sin32 = rt + SEQ * 64 + SEQ * 16;
    LAS bf16* ltile = (LAS bf16*)(F.lds);
    LAS bf16* vst = (LAS bf16*)(F.lds + 32768);
    const int tid = F.tid, lane = F.lane, wv = F.wave, fr = lane & 15, fq = lane >> 4;
    const int half = wv >> 2, p = wv & 1, th = (wv >> 1) & 1;
    bf16x8 wf[2][4];
    { const float* W = (half ? P->w_uv : P->w_uk) + l * 8192;
#pragma unroll
      for (int dd = 0; dd < 2; ++dd)
#pragma unroll
          for (int ks = 0; ks < 4; ++ks) { float f[8];
#pragma unroll
              for (int j = 0; j < 8; ++j) f[j] = W[(ks * 32 + fq * 8 + j) * 64 + (p + 2 * dd) * 16 + fr];
              u32x4 w; w.x = pk2(f[0], f[1]); w.y = pk2(f[2], f[3]); w.z = pk2(f[4], f[5]); w.w = pk2(f[6], f[7]); wf[dd][ks] = __builtin_bit_cast(bf16x8, w); } }
    const f32x2 kg = *(const f32x2*)(P->kv_norm_g + l * 128 + 2 * lane);
    for (int u = F.vcu; u < T / 64; u += F.G) {
        const int tok0 = u * 64, b = u >> 5, t0 = (u & 31) * 64;
        __syncthreads();
        {
            const int tl = tid >> 3, sub = tid & 7, t = t0 + tl;
            bf16* row = PR + (size_t)(tok0 + tl) * NP;
            {
                const f32x4 cs = *(const f32x4*)(cos64 + t * 32 + sub * 4), sn = *(const f32x4*)(sin64 + t * 32 + sub * 4);
                u32x2 a[4], c[4];
#pragma unroll
                for (int hh = 0; hh < 4; ++hh) { a[hh] = *(const u32x2*)(row + C_QB + hh * 64 + sub * 4); c[hh] = *(const u32x2*)(row + C_QB + hh * 64 + 32 + sub * 4); }
#pragma unroll
                for (int hh = 0; hh < 4; ++hh) {
                    const float x10 = bf2f(a[hh].x & 0xffffu), x11 = bf2f(a[hh].x >> 16), x12 = bf2f(a[hh].y & 0xffffu), x13 = bf2f(a[hh].y >> 16);
                    const float x20 = bf2f(c[hh].x & 0xffffu), x21 = bf2f(c[hh].x >> 16), x22 = bf2f(c[hh].y & 0xffffu), x23 = bf2f(c[hh].y >> 16);
                    u32x2 o1, o2;
                    o1.x = pk2(x10 * cs[0] - x20 * sn[0], x11 * cs[1] - x21 * sn[1]); o1.y = pk2(x12 * cs[2] - x22 * sn[2], x13 * cs[3] - x23 * sn[3]);
                    o2.x = pk2(x10 * sn[0] + x20 * cs[0], x11 * sn[1] + x21 * cs[1]); o2.y = pk2(x12 * sn[2] + x22 * cs[2], x13 * sn[3] + x23 * cs[3]);
                    if (!DRY) { *(u32x2*)(row + C_QB + hh * 64 + sub * 4) = o1; *(u32x2*)(row + C_QB + hh * 64 + 32 + sub * 4) = o2; }
                    else if (o1.x == 0x12345678u && o2.y == 0x9abcdef0u) LF[0] = 0.f;
                }
            }
            {
                const int ih = sub >> 1, i8 = (sub & 1) * 8;
                const f32x4 cs0 = *(const f32x4*)(cos32 + t * 16 + i8), cs1 = *(const f32x4*)(cos32 + t * 16 + i8 + 4), sn0 = *(const f32x4*)(sin32 + t * 16 + i8), sn1 = *(const f32x4*)(sin32 + t * 16 + i8 + 4);
                bf16* bq = row + C_QI + ih * 32 + i8; bf16* bk = row + C_KI + i8;
                const u32x4 qa = *(const u32x4*)bq, qc = *(const u32x4*)(bq + 16);
                u32x4 ka = qa, kc = qc;
                if (sub < 2) { ka = *(const u32x4*)bk; kc = *(const u32x4*)(bk + 16); }
#pragma unroll
                for (int which = 0; which < 2; ++which) {
                    float x1[8], x2[8]; bf8_to_f(which ? ka : qa, x1); bf8_to_f(which ? kc : qc, x2);
                    float o1[8], o2[8];
#pragma unroll
                    for (int i = 0; i < 8; ++i) { const float cc = (i < 4) ? cs0[i & 3] : cs1[i & 3], ss = (i < 4) ? sn0[i & 3] : sn1[i & 3]; o1[i] = x1[i] * cc - x2[i] * ss; o2[i] = x1[i] * ss + x2[i] * cc; }
                    u32x4 w1, w2; w1.x = pk2(o1[0], o1[1]); w1.y = pk2(o1[2], o1[3]); w1.z = pk2(o1[4], o1[5]); w1.w = pk2(o1[6], o1[7]);
                    w2.x = pk2(o2[0], o2[1]); w2.y = pk2(o2[2], o2[3]); w2.z = pk2(o2[4], o2[5]); w2.w = pk2(o2[6], o2[7]);
                    if (!DRY) { if (which == 0) { *(u32x4*)bq = w1; *(u32x4*)(bq + 16) = w2; } else if (sub < 2) { *(u32x4*)bk = w1; *(u32x4*)(bk + 16) = w2; } }
                    else if (w1.x == 0x12345678u && w2.y == 0x9abcdef0u) LF[0] = 0.f;
                }
            }
            if (sub == 2) {
                const u32x2 w = *(const u32x2*)(row + C_FA);
                const float fa[4] = {bf2f(w.x & 0xffffu), bf2f(w.x >> 16), bf2f(w.y & 0xffffu), bf2f(w.y >> 16)};
#pragma unroll
                for (int hh = 0; hh < 4; ++hh) { const float z = fa[hh] + P->b_forget[l * 4 + hh];
                    LF[((size_t)(b * 4 + hh)) * SEQ + t] = fminf(z, 0.f) - 0.6931471805599453f * lg2(1.0f + ex2(-fabsf(z) * LOG2E)); }
            }
        }
        {
            unsigned lw[8];
#pragma unroll
            for (int i = 0; i < 8; ++i) lw[i] = *(const unsigned*)(PR + (size_t)(tok0 + wv * 8 + i) * NP + C_LAT + 2 * lane);
#pragma unroll
            for (int i = 0; i < 8; ++i) { const float a0 = bf2f(lw[i] & 0xffffu), a1 = bf2f(lw[i] >> 16);
                const float rstd = __builtin_amdgcn_rsqf(wave_sum(a0 * a0 + a1 * a1) * (1.0f / 128.0f) + 1e-6f);
                *(LAS unsigned*)(ltile + (wv * 8 + i) * 136 + 2 * lane) = pk2(a0 * rstd * kg[0], a1 * rstd * kg[1]); }
        }
        __syncthreads();
        {
            f32x4 acc[2][2];
#pragma unroll
            for (int dd = 0; dd < 2; ++dd)
#pragma unroll
                for (int tt = 0; tt < 2; ++tt) acc[dd][tt] = zero4();
#pragma unroll
            for (int tt = 0; tt < 2; ++tt)
#pragma unroll
                for (int ks = 0; ks < 4; ++ks) { const bf16x8 bfr = *(const LAS bf16x8*)(ltile + ((2 * th + tt) * 16 + fr) * 136 + ks * 32 + fq * 8);
#pragma unroll
                    for (int dd = 0; dd < 2; ++dd) acc[dd][tt] = __builtin_amdgcn_mfma_f32_16x16x32_bf16(wf[dd][ks], bfr, acc[dd][tt], 0, 0, 0); }
#pragma unroll
            for (int tt = 0; tt < 2; ++tt) { const int tl = (2 * th + tt) * 16 + fr, t = t0 + tl;
                if (half == 0) {
                    const int d1 = p * 16 + fq * 4;
                    const f32x4 cs = *(const f32x4*)(cos64 + t * 32 + d1), sn = *(const f32x4*)(sin64 + t * 32 + d1);
                    const f32x4 x1 = acc[0][tt], x2 = acc[1][tt];
                    const f32x4 o1 = x1 * cs - x2 * sn, o2 = x1 * sn + x2 * cs;
                    u32x2 w1, w2; w1.x = pk2(o1[0], o1[1]); w1.y = pk2(o1[2], o1[3]); w2.x = pk2(o2[0], o2[1]); w2.y = pk2(o2[2], o2[3]);
                    *(u32x2*)(KB + (size_t)(tok0 + tl) * 64 + d1) = w1; *(u32x2*)(KB + (size_t)(tok0 + tl) * 64 + 32 + d1) = w2;
                } else {
#pragma unroll
                    for (int dd = 0; dd < 2; ++dd)
#pragma unroll
                        for (int j = 0; j < 4; ++j) vst[((p + 2 * dd) * 16 + fq * 4 + j) * 72 + tl] = (bf16)f2bf(acc[dd][tt][j]);
                }
            }
        }
        __syncthreads();
        { const int d = tid >> 3, oct = tid & 7;
          *(u32x4*)(VBT + ((size_t)(b * 64 + d)) * SEQ + t0 + oct * 8) = *(const LAS u32x4*)(vst + d * 72 + oct * 8); }
    }
    __syncthreads();
}

__device__ __forceinline__ void idx_scores(const bf16x8 (&kif)[2], const bf16x8 (&qif)[4], const float (&wq)[4], unsigned (&sk)[8]) {
#pragma unroll
    for (int t = 0; t < 2; ++t) {
        const f32x4 z = {0.f, 0.f, 0.f, 0.f};
        const f32x4 a0 = __builtin_amdgcn_mfma_f32_16x16x32_bf16(kif[t], qif[0], z, 0, 0, 0);
        const f32x4 a1 = __builtin_amdgcn_mfma_f32_16x16x32_bf16(kif[t], qif[1], z, 0, 0, 0);
        const f32x4 a2 = __builtin_amdgcn_mfma_f32_16x16x32_bf16(kif[t], qif[2], z, 0, 0, 0);
        const f32x4 a3 = __builtin_amdgcn_mfma_f32_16x16x32_bf16(kif[t], qif[3], z, 0, 0, 0);
#pragma unroll
        for (int j = 0; j < 4; ++j) {
            const float r0 = fmaxf(a0[j], 0.f), r1 = fmaxf(a1[j], 0.f), r2 = fmaxf(a2[j], 0.f), r3 = fmaxf(a3[j], 0.f);
            float v = wq[0] * r0; v = __builtin_fmaf(wq[1], r1, v); v = __builtin_fmaf(wq[2], r2, v); v = __builtin_fmaf(wq[3], r3, v);
            const unsigned u = __builtin_bit_cast(unsigned, v + 0.0f);
            sk[t * 4 + j] = u ^ ((unsigned)((int)u >> 31) | 0x80000000u);
        }
    }
}

__device__ __forceinline__ unsigned wave_total(unsigned c) {
    c += (unsigned)__builtin_amdgcn_update_dpp(0, (int)c, 0x111, 0xf, 0xf, true);
    c += (unsigned)__builtin_amdgcn_update_dpp(0, (int)c, 0x112, 0xf, 0xf, true);
    c += (unsigned)__builtin_amdgcn_update_dpp(0, (int)c, 0x114, 0xf, 0xf, true);
    c += (unsigned)__builtin_amdgcn_update_dpp(0, (int)c, 0x118, 0xf, 0xf, true);
    return (unsigned)__builtin_amdgcn_readlane((int)c, 15) + (unsigned)__builtin_amdgcn_readlane((int)c, 31) + (unsigned)__builtin_amdgcn_readlane((int)c, 47) + (unsigned)__builtin_amdgcn_readlane((int)c, 63);
}
__device__ __forceinline__ unsigned bfi32(unsigned m, unsigned a, unsigned b) { return (m & a) | (~m & b); }
__device__ __forceinline__ void bit_transpose32(unsigned (&a)[32]) {
#pragma unroll
    for (int i = 0; i < 32; ++i) if (!(i & 16)) { const unsigned lo = a[i], hi = a[i + 16]; a[i] = __builtin_amdgcn_perm(hi, lo, 0x05040100u); a[i + 16] = __builtin_amdgcn_perm(hi, lo, 0x07060302u); }
#pragma unroll
    for (int i = 0; i < 32; ++i) if (!(i & 8)) { const unsigned lo = a[i], hi = a[i + 8]; a[i] = __builtin_amdgcn_perm(hi, lo, 0x06020400u); a[i + 8] = __builtin_amdgcn_perm(hi, lo, 0x07030501u); }
#pragma unroll
    for (int i = 0; i < 32; ++i) if (!(i & 4)) { const unsigned lo = a[i], hi = a[i + 4]; a[i] = bfi32(0x0f0f0f0fu, lo, hi << 4); a[i + 4] = bfi32(0x0f0f0f0fu, lo >> 4, hi); }
#pragma unroll
    for (int i = 0; i < 32; ++i) if (!(i & 2)) { const unsigned lo = a[i], hi = a[i + 2]; a[i] = bfi32(0x33333333u, lo, hi << 2); a[i + 2] = bfi32(0x33333333u, lo >> 2, hi); }
#pragma unroll
    for (int i = 0; i < 32; ++i) if (!(i & 1)) { const unsigned lo = a[i], hi = a[i + 1]; a[i] = bfi32(0x55555555u, lo, hi << 1); a[i + 1] = bfi32(0x55555555u, lo >> 1, hi); }
}
__device__ __forceinline__ unsigned low_n_set(unsigned eq, int n) {
    unsigned I = 0u;
#pragma unroll
    for (int bit = 16; bit >= 1; bit >>= 1) { const unsigned cand = I + (unsigned)bit; if ((int)__builtin_popcount(eq & ((1u << cand) - 1u)) < n) I = cand; }
    const unsigned r = eq & (I >= 31u ? 0xffffffffu : ((2u << I) - 1u));
    return (n <= 0) ? 0u : (n >= (int)__builtin_popcount(eq)) ? eq : r;
}
__device__ __forceinline__ unsigned tie_take(unsigned eq, unsigned need, int lane) {
    const unsigned e = (unsigned)__builtin_popcount(eq);
    unsigned c = e;
    c += (unsigned)__builtin_amdgcn_update_dpp(0, (int)c, 0x111, 0xf, 0xf, true);
    c += (unsigned)__builtin_amdgcn_update_dpp(0, (int)c, 0x112, 0xf, 0xf, true);
    c += (unsigned)__builtin_amdgcn_update_dpp(0, (int)c, 0x114, 0xf, 0xf, true);
    c += (unsigned)__builtin_amdgcn_update_dpp(0, (int)c, 0x118, 0xf, 0xf, true);
    const unsigned t0 = (unsigned)__builtin_amdgcn_readlane((int)c, 15), t1 = (unsigned)__builtin_amdgcn_readlane((int)c, 31), t2 = (unsigned)__builtin_amdgcn_readlane((int)c, 47);
    const unsigned pre = c - e + (lane >= 16 ? t0 : 0u) + (lane >= 32 ? t1 : 0u) + (lane >= 48 ? t2 : 0u);
    return low_n_set(eq, (int)need - (int)pre);
}
template <int VAR> __device__ __forceinline__ void sel_phase(KP Pq, Frame& F) {
    F.tid = opaque_tid(F.wave0); F.lane = F.tid & 63; F.wave = opq_s(F.wave0); F.vcu = opq_s(F.vcu0); F.G = opq_s(F.G0); const KP P = kp_fresh(); (void)Pq;
    unsigned char* ws = P->ws;
    const bf16* PR = (const bf16*)(ws + WS_PROJ);
    unsigned long long* MASK = (unsigned long long*)(ws + WS_MASK);
    LAS unsigned* keys = (LAS unsigned*)(F.lds);
    constexpr int KST = 2052;
    const int lane = F.lane, fr = lane & 15, fq = lane >> 4, wv = F.wave;
    bf16x8 pq[4], pk[2]; unsigned pw[2];
    auto sel_fetch = [&](int u2) {
        const int c2 = 31 - (u2 >> 7), b2 = (u2 >> 2) & 31, q2 = u2 & 3;
        const bf16* qr = PR + ((size_t)b2 * SEQ + c2 * 64 + q2 * 16 + fr) * NP;
#pragma unroll
        for (int ih = 0; ih < 4; ++ih) pq[ih] = *(const bf16x8*)(qr + C_QI + ih * 32 + fq * 8);
        pw[0] = *(const unsigned*)(qr + C_WI); pw[1] = *(const unsigned*)(qr + C_WI + 2);
        const bf16* kb2 = PR + ((size_t)b2 * SEQ + (fr >> 2) * 8 + (fr & 3)) * NP + C_KI + fq * 8;
        pk[0] = *(const bf16x8*)(kb2 + (size_t)(wv * 32) * NP); pk[1] = *(const bf16x8*)(kb2 + (size_t)(wv * 32 + 4) * NP);
    };
    if (F.vcu < NB * 28 * 4) sel_fetch(F.vcu);
    for (int u = F.vcu; u < NB * 28 * 4; u += F.G) {
        const int c = 31 - (u >> 7), b = (u >> 2) & 31, qt0 = u & 3;
        const int L = (c + 1) * 64, nsteps = L / 32, nr = c + 1;
        const size_t rowb = (size_t)b * SEQ;
        for (int qt = qt0; qt == qt0; ++qt) {
            __syncthreads();
            {
                bf16x8 qif[4]; float wq[4];
#pragma unroll
                for (int ih = 0; ih < 4; ++ih) { qif[ih] = pq[ih]; wq[ih] = bf2f((pw[ih >> 1] >> (16 * (ih & 1))) & 0xffffu) * (0.5f * RS32); }
                const bf16* kbase = PR + (rowb + (fr >> 2) * 8 + (fr & 3)) * NP + C_KI + fq * 8;
                bf16x8 kif[2], kin[2];
                int s = wv;
                kif[0] = pk[0]; kif[1] = pk[1];
                for (; s < (VAR == 2 ? 0 : nsteps); s += 8) {
                    const int sn = s + 8;
                    if (sn < nsteps) { kin[0] = *(const bf16x8*)(kbase + (size_t)(sn * 32) * NP); kin[1] = *(const bf16x8*)(kbase + (size_t)(sn * 32 + 4) * NP); }
                    unsigned sk[8]; idx_scores(kif, qif, wq, sk);
                    LAS unsigned* dst = keys + fr * KST + s * 32; const int x = (s >> 1) & 7;
                    *(LAS u32x4*)(dst + 4 * ((2 * fq) ^ x)) = (u32x4){sk[0], sk[1], sk[2], sk[3]}; *(LAS u32x4*)(dst + 4 * ((2 * fq + 1) ^ x)) = (u32x4){sk[4], sk[5], sk[6], sk[7]};
                    kif[0] = kin[0]; kif[1] = kin[1];
                }
            }
            __syncthreads();
            if (u + F.G < NB * 28 * 4) sel_fetch(u + F.G);
            {
                unsigned pA[32], pB[32];
                const int sw = (lane >> 1) & 7;
                const LAS unsigned* krA = keys + (wv * 2) * KST + 32 * lane; const LAS unsigned* krB = krA + KST;
#pragma unroll
                for (int cc = 0; cc < 8; ++cc) { const u32x4 v = *(const LAS u32x4*)(krA + 4 * (cc ^ sw)); pA[4 * cc] = v.x; pA[4 * cc + 1] = v.y; pA[4 * cc + 2] = v.z; pA[4 * cc + 3] = v.w; }
#pragma unroll
                for (int cc = 0; cc < 8; ++cc) { const u32x4 v = *(const LAS u32x4*)(krB + 4 * (cc ^ sw)); pB[4 * cc] = v.x; pB[4 * cc + 1] = v.y; pB[4 * cc + 2] = v.z; pB[4 * cc + 3] = v.w; }
                bit_transpose32(pA); bit_transpose32(pB);
                unsigned eqA = (lane < nsteps) ? 0xffffffffu : 0u, eqB = eqA, gtA = 0u, gtB = 0u;
                unsigned GA = 0u, GB = 0u;
#define SEL_BIT(b) if (!done) { \
                    const unsigned xA = eqA & pA[b], xB = eqB & pB[b]; \
                    const unsigned tot = wave_total((unsigned)__builtin_popcount(xA) | ((unsigned)__builtin_popcount(xB) << 16)); \
                    const unsigned nA = GA + (tot & 0xffffu), nB = GB + (tot >> 16); \
                    const unsigned kA = (nA > 256u) ? 0u : 0xffffffffu, kB = (nB > 256u) ? 0u : 0xffffffffu; \
                    gtA |= xA & kA; eqA = xA ^ (eqA & kA); GA = (nA > 256u) ? GA : nA; \
                    gtB |= xB & kB; eqB = xB ^ (eqB & kB); GB = (nB > 256u) ? GB : nB; \
                    if (((b) & 1) == 0) done = (GA == 256u) && (GB == 256u); }
                bool done = false;
                SEL_BIT(31) SEL_BIT(30) SEL_BIT(29) SEL_BIT(28) SEL_BIT(27) SEL_BIT(26) SEL_BIT(25) SEL_BIT(24) SEL_BIT(23) SEL_BIT(22) SEL_BIT(21) SEL_BIT(20) SEL_BIT(19) SEL_BIT(18) SEL_BIT(17) SEL_BIT(16)
                SEL_BIT(15) SEL_BIT(14) SEL_BIT(13) SEL_BIT(12) SEL_BIT(11) SEL_BIT(10) SEL_BIT(9) SEL_BIT(8) SEL_BIT(7) SEL_BIT(6) SEL_BIT(5) SEL_BIT(4) SEL_BIT(3) SEL_BIT(2) SEL_BIT(1) SEL_BIT(0)
#undef SEL_BIT
                const bool exA = (GA == 256u), exB = (GB == 256u);
                if (!exA) gtA |= tie_take(eqA, 256u - GA, lane);
                if (!exB) gtB |= tie_take(eqB, 256u - GB, lane);
                unsigned* M32 = (unsigned*)MASK + (rowb + c * 64 + qt * 16 + wv * 2) * 64 + lane;
                { u32x4 q0 = __builtin_bit_cast(u32x4, pq[0]), q1 = __builtin_bit_cast(u32x4, pq[1]), q2 = __builtin_bit_cast(u32x4, pq[2]), q3 = __builtin_bit_cast(u32x4, pq[3]), k0 = __builtin_bit_cast(u32x4, pk[0]), k1 = __builtin_bit_cast(u32x4, pk[1]);
                  asm volatile("" : "+v"(q0), "+v"(q1), "+v"(q2), "+v"(q3), "+v"(k0), "+v"(k1), "+v"(pw[0]), "+v"(pw[1]));
                  pq[0] = __builtin_bit_cast(bf16x8, q0); pq[1] = __builtin_bit_cast(bf16x8, q1); pq[2] = __builtin_bit_cast(bf16x8, q2); pq[3] = __builtin_bit_cast(bf16x8, q3); pk[0] = __builtin_bit_cast(bf16x8, k0); pk[1] = __builtin_bit_cast(bf16x8, k1); }
                M32[0] = gtA; M32[64] = gtB;
            }
        }
    }
    __syncthreads();
}

constexpr int ATT_KBUF = 0, ATT_VBUF = 16384, ATT_NF = 32768, ATT_FLAG = 40960, ATT_RELT = 49152, RELW = 768, RELO = 640;
__device__ __forceinline__ int kswz(int row) { return ((row >> 3) & 3) * 2 + ((row >> 1) & 1); }
__device__ __forceinline__ int vswz(int row) { return (row >> 1) & 7; }
struct AttnPre { bf16x8 qf[2][2]; u32x4 k0, v0, k1, v1; };
template <int KIND>
__device__ __forceinline__ void attn_fetch(unsigned char* ws, int b, int h, int blk, int tid, AttnPre& R) {
    const int lane = tid & 63, wv = __builtin_amdgcn_readfirstlane(tid >> 6), fr = lane & 15, fq = lane >> 4;
    const size_t rowb = (size_t)b * SEQ;
    constexpr int QCOL = (KIND == 0) ? C_QA : (KIND == 1) ? C_QB : (KIND == 2) ? C_QC : C_QD;
    constexpr int KCOL = (KIND == 0) ? C_KA : (KIND == 2) ? C_KC : C_KD;
    constexpr int VG = (KIND == 0) ? 0 : (KIND == 2) ? 1 : 2;
    constexpr unsigned KPB = (KIND == 1) ? 128u : (unsigned)NP * 2u;
    const char* PRb = (const char*)(ws + WS_PROJ) + rowb * NP * 2;
    const int qw = (KIND == 1) ? blk * 64 + (wv & 3) * 16 : blk * 256 + wv * 32;
    const int hw = (KIND == 1) ? (wv >> 2) * 2 : h;
#pragma unroll
    for (int qi = 0; qi < 2; ++qi)
#pragma unroll
        for (int ks = 0; ks < 2; ++ks) {
            if (KIND == 1) R.qf[qi][ks] = *(const bf16x8*)(PRb + (unsigned)((qw + fr) * NP + QCOL + (hw + qi) * 64 + ks * 32 + fq * 8) * 2u);
            else R.qf[qi][ks] = *(const bf16x8*)(PRb + (unsigned)((qw + 16 * qi + fr) * NP + QCOL + hw * 64 + ks * 32 + fq * 8) * 2u);
        }
    const char* Kb; const char* Vtb;
    if (KIND == 1) { Kb = (const char*)(ws + WS_KB) + rowb * 128; Vtb = (const char*)(ws + WS_VBT) + (size_t)b * 64 * SEQ * 2; }
    else { Kb = PRb + (KCOL + h * 64) * 2; Vtb = (const char*)(ws + WS_VT) + ((size_t)((VG * NB + b) * 4 + h) * 64) * SEQ * 2; }
    const int srow = tid >> 3, ssl = tid & 7;
    const unsigned kgoff = (unsigned)srow * KPB + (unsigned)((ssl ^ kswz(srow)) * 16);
    const unsigned vgoff = (unsigned)(srow * SEQ * 2) + (unsigned)((ssl ^ vswz(srow)) * 16);
    int s_first, s_last, s_dir;
    if (KIND == 0) { s_first = 0; s_last = blk * 4 + 3; s_dir = 1; }
    else if (KIND == 1) { s_first = 0; s_last = blk; s_dir = 1; }
    else if (KIND == 2) { s_first = blk * 4 + 3; s_last = 0; s_dir = -1; }
    else { s_first = blk * 4 - 8 < 0 ? 0 : blk * 4 - 8; s_last = blk * 4 + 3; s_dir = 1; }
    R.k0 = *(const u32x4*)(Kb + (size_t)(s_first * 64) * KPB + kgoff); R.v0 = *(const u32x4*)(Vtb + (size_t)(s_first * 128) + vgoff);
    R.k1 = R.k0; R.v1 = R.v0;
    if (s_first != s_last) { R.k1 = *(const u32x4*)(Kb + (size_t)((s_first + s_dir) * 64) * KPB + kgoff); R.v1 = *(const u32x4*)(Vtb + (size_t)((s_first + s_dir) * 128) + vgoff); }
}
template <int KIND>
__device__ __forceinline__ void attn_wg(unsigned char* ws, int b, int h, int blk, LAS unsigned char* lds, int wave_s, AttnPre& pre, bool hn, int nb, int nh, int nblk) {
    const int tid = opaque_tid(wave_s), lane = tid & 63, wv = __builtin_amdgcn_readfirstlane(tid >> 6);
    const int fr = lane & 15, fq = lane >> 4;
    const size_t rowb = (size_t)b * SEQ;
    constexpr int QCOL = (KIND == 0) ? C_QA : (KIND == 1) ? C_QB : (KIND == 2) ? C_QC : C_QD;
    constexpr int KCOL = (KIND == 0) ? C_KA : (KIND == 2) ? C_KC : C_KD;
    constexpr int YCOL = (KIND == 0) ? 0 : (KIND == 1) ? 256 : (KIND == 2) ? 512 : 768;
    constexpr int VG = (KIND == 0) ? 0 : (KIND == 2) ? 1 : 2;
    constexpr unsigned KPB = (KIND == 1) ? 128u : (unsigned)NP * 2u;
    const char* PRb = (const char*)(ws + WS_PROJ) + rowb * NP * 2;
    const int qw = (KIND == 1) ? blk * 64 + (wv & 3) * 16 : blk * 256 + wv * 32;
    const int hw = (KIND == 1) ? (wv >> 2) * 2 : h;
    bf16x8 qf[2][2];
#pragma unroll
    for (int qi = 0; qi < 2; ++qi)
#pragma unroll
        for (int ks = 0; ks < 2; ++ks) qf[qi][ks] = pre.qf[qi][ks];
    const char* Kb; const char* Vtb;
    if (KIND == 1) { Kb = (const char*)(ws + WS_KB) + rowb * 128; Vtb = (const char*)(ws + WS_VBT) + (size_t)b * 64 * SEQ * 2; }
    else { Kb = PRb + (KCOL + h * 64) * 2; Vtb = (const char*)(ws + WS_VT) + ((size_t)((VG * NB + b) * 4 + h) * 64) * SEQ * 2; }
    const int srow = tid >> 3, ssl = tid & 7;
    const unsigned kgoff = (unsigned)srow * KPB + (unsigned)((ssl ^ kswz(srow)) * 16);
    const unsigned vgoff = (unsigned)(srow * SEQ * 2) + (unsigned)((ssl ^ vswz(srow)) * 16);
    LAS unsigned char* kst = lds + ATT_KBUF + tid * 16; LAS unsigned char* vst = lds + ATT_VBUF + tid * 16;
    const int krow0 = (fr >> 2) * 8 + (fr & 3);
    const int kro0 = krow0 * 128 + ((fq ^ kswz(krow0)) * 16), kro1 = krow0 * 128 + (((4 + fq) ^ kswz(krow0)) * 16);
    const int vro0 = fr * 128 + ((fq ^ vswz(fr)) * 16), vro1 = fr * 128 + (((4 + fq) ^ vswz(fr)) * 16);
    const unsigned char* mrow = (const unsigned char*)(ws + WS_MASK) + (rowb + qw + fr) * 256;
    const bool sel_all = (KIND != 1) || (blk < 4);
    LAS float* nf = (LAS float*)(lds + ATT_NF);
    const LAS float* relt = (const LAS float*)(lds + ATT_RELT);
    LAS unsigned* flags = (LAS unsigned*)(lds + ATT_FLAG);
    int s_first, s_last, s_dir;
    if (KIND == 0) { s_first = 0; s_last = blk * 4 + 3; s_dir = 1; }
    else if (KIND == 1) { s_first = 0; s_last = blk; s_dir = 1; }
    else if (KIND == 2) { s_first = blk * 4 + 3; s_last = 0; s_dir = -1; }
    else { s_first = blk * 4 - 8 < 0 ? 0 : blk * 4 - 8; s_last = blk * 4 + 3; s_dir = 1; }
    u32x4 kreg = pre.k1, vreg = pre.v1;
    __syncthreads();
    { const u32x4 k0 = pre.k0, v0 = pre.v0; *(LAS u32x4*)(kst) = k0; *(LAS u32x4*)(vst) = v0; }
    bool fetched = false;
    f32x4 O[2][4];
#pragma unroll
    for (int qi = 0; qi < 2; ++qi)
#pragma unroll
        for (int dt = 0; dt < 4; ++dt) O[qi][dt] = zero4();
    float NINF = -INFINITY; unsigned ONE2 = 0x3f803f80u; asm volatile("" : "+v"(NINF), "+v"(ONE2));
    float mrun[2], mref[2]; f32x4 Ol[2];
#pragma unroll
    for (int qi = 0; qi < 2; ++qi) { mrun[qi] = (KIND == 2) ? 0.f : NINF; mref[qi] = 0.f; Ol[qi] = zero4(); }
    bf16x8 ones8;
    { u32x4 o1; o1.x = ONE2; o1.y = ONE2; o1.z = ONE2; o1.w = ONE2; ones8 = __builtin_bit_cast(bf16x8, o1); }
    const bool hi1 = (fq & 1) == 0, hi2 = (fq & 2) == 0;
    bool wdone = false;
    __syncthreads();
    int s = s_first, cur = 0;
    for (;;) {
        const bool has_next = (s != s_last);
        if (!has_next && hn) { attn_fetch<(KIND + 1) & 3>(ws, nb, nh, nblk, tid, pre); fetched = true; }
        unsigned long long mbits = ~0ull;
        if (KIND == 1 && !sel_all) mbits = *(const unsigned long long*)(mrow + s * 8);
        const LAS unsigned char* kbuf = lds + ATT_KBUF + cur * 8192; const LAS unsigned char* vbuf = lds + ATT_VBUF + cur * 8192;
#pragma unroll
        for (int jj2 = 0; jj2 < 2; ++jj2) {
            const int j = (KIND == 2) ? 1 - jj2 : jj2;
            const int kb0 = s * 64 + j * 32;
            bool active;
            if (KIND == 0) active = (kb0 <= qw + 31);
            else if (KIND == 1) active = true;
            else if (KIND == 2) active = (kb0 <= qw + 30) && !wdone;
            else { const int c0 = qw & ~63; active = (kb0 >= c0 - 512) && (kb0 < c0 + 64); }
            if (active) {
                bf16x8 kf[2][2], vf[4];
#pragma unroll
                for (int t = 0; t < 2; ++t) { kf[t][0] = *(const LAS bf16x8*)(kbuf + j * 4096 + t * 512 + kro0); kf[t][1] = *(const LAS bf16x8*)(kbuf + j * 4096 + t * 512 + kro1); }
#pragma unroll
                for (int dt = 0; dt < 4; ++dt) vf[dt] = *(const LAS bf16x8*)(vbuf + dt * 2048 + (j ? vro1 : vro0));
                const unsigned selmask = (unsigned)(mbits >> (j * 32 + fq * 8)) & 0xffu;
                unsigned pmask[4];
                if (KIND == 1) {
#pragma unroll
                    for (int i = 0; i < 4; ++i) { const unsigned lo = (unsigned)((int)(selmask << (31 - 2 * i)) >> 31), hi = (unsigned)((int)(selmask << (30 - 2 * i)) >> 31); pmask[i] = bfi32(0x0000ffffu, lo, hi); }
                }
                float bias[8];
                if (KIND == 0) { const f32x4 b0 = *(const LAS f32x4*)(nf + kb0 + fq * 8), b1 = *(const LAS f32x4*)(nf + kb0 + fq * 8 + 4);
#pragma unroll
                    for (int jx = 0; jx < 4; ++jx) { bias[jx] = b0[jx]; bias[4 + jx] = b1[jx]; } }
                const bool diag = (KIND == 0 || KIND == 2) && (kb0 + 31 >= qw);
#pragma unroll
                for (int qi = 0; qi < 2; ++qi) {
                    f32x4 st[2];
#pragma unroll
                    for (int t = 0; t < 2; ++t) { st[t] = __builtin_amdgcn_mfma_f32_16x16x32_bf16(kf[t][0], qf[qi][0], (f32x4){0.f, 0.f, 0.f, 0.f}, 0, 0, 0);
                        st[t] = __builtin_amdgcn_mfma_f32_16x16x32_bf16(kf[t][1], qf[qi][1], st[t], 0, 0, 0); }
                    const int q = (KIND == 1) ? (qw + fr) : (qw + 16 * qi + fr);
                    bf16x8 pb;
                    if (KIND == 2) {
                        float w[8], sg[8], qv[8];
                        const float carry = mrun[qi];
#pragma unroll
                        for (int jj = 0; jj < 8; ++jj) { const bool valid = !diag || (kb0 + fq * 8 + jj < q);
                            const float a = ex2(fminf(st[jj >> 2][jj & 3] * (-SC2), 120.0f));
                            const float s1 = __builtin_amdgcn_rcpf(1.0f + a);
                            sg[jj] = valid ? s1 : 0.f; qv[jj] = valid ? a * s1 : 1.0f; }
                        float suf[8]; suf[7] = 1.0f;
#pragma unroll
                        for (int jj = 6; jj >= 0; --jj) suf[jj] = suf[jj + 1] * qv[jj + 1];
                        const float tot = lg2(suf[0] * qv[0]);
                        const float t1 = xor16_f(tot, lane), t2 = xor32_f(tot, lane), t3 = xor16_f(t2, lane);
                        const float hi = (hi1 ? t1 : 0.f) + (hi2 ? t2 : 0.f) + (hi2 ? t3 : 0.f);
                        const float eb = ex2(carry + hi);
#pragma unroll
                        for (int jj = 0; jj < 8; ++jj) w[jj] = (sg[jj] * suf[jj]) * eb;
                        mrun[qi] = carry + ((tot + t1) + (t2 + t3));
                        u32x4 pw; pw.x = pk2(w[0], w[1]); pw.y = pk2(w[2], w[3]); pw.z = pk2(w[4], w[5]); pw.w = pk2(w[6], w[7]);
                        pb = __builtin_bit_cast(bf16x8, pw);
                    } else {
                        f32x2 xv[4];
                        const f32x2 r0 = {st[0][0], st[0][1]}, r1 = {st[0][2], st[0][3]}, r2 = {st[1][0], st[1][1]}, r3 = {st[1][2], st[1][3]};
                        const bool farb = (KIND == 3) && (kb0 + 31 + 128 <= qw);
                        const bool rawp = (KIND == 1) || farb;
                        const float cb = farb ? relt[h * RELW] : 0.f;
                        float p[8];
                        if (rawp) {
                            const float ms0 = (KIND == 3) ? mref[qi] - cb : mref[qi];
                            xv[0] = r0 * SC2 - ms0; xv[1] = r1 * SC2 - ms0; xv[2] = r2 * SC2 - ms0; xv[3] = r3 * SC2 - ms0;
                            const float dmx = max3f(max3f(xv[0][0], xv[0][1], xv[1][0]), max3f(xv[1][1], xv[2][0], xv[2][1]), max3f(xv[3][0], xv[3][1], xv[3][1]));
                            if (__any(dmx > ((mrun[qi] == NINF) ? NINF : 16.0f))) {
                                const float mx = max_x16x32(dmx + mref[qi]);
                                const float mnew = fmaxf(mrun[qi], mx);
                                const float mns = (mnew == NINF) ? 0.f : mnew;
                                const float alpha = ex2(mrun[qi] - mns);
                                const float dm = mns - mref[qi];
                                xv[0] = xv[0] - dm; xv[1] = xv[1] - dm; xv[2] = xv[2] - dm; xv[3] = xv[3] - dm;
                                mrun[qi] = mnew; mref[qi] = mns; Ol[qi] = Ol[qi] * alpha;
#pragma unroll
                                for (int dt = 0; dt < 4; ++dt) O[qi][dt] = O[qi][dt] * alpha;
                            }
#pragma unroll
                            for (int i = 0; i < 4; ++i) { p[2 * i] = ex2(xv[i][0]); p[2 * i + 1] = ex2(xv[i][1]); }
                        } else {
                            if (KIND == 0) {
                                xv[0] = r0 * SC2 + (f32x2){bias[0], bias[1]}; xv[1] = r1 * SC2 + (f32x2){bias[2], bias[3]}; xv[2] = r2 * SC2 + (f32x2){bias[4], bias[5]}; xv[3] = r3 * SC2 + (f32x2){bias[6], bias[7]};
                                if (diag) {
#pragma unroll
                                    for (int jj = 0; jj < 8; ++jj) if (kb0 + fq * 8 + jj > q) xv[jj >> 1][jj & 1] = NINF;
                                }
                            } else {
                                float bt[8];
#pragma unroll
                                for (int jj = 0; jj < 8; ++jj) bt[jj] = relt[h * RELW + RELO + (kb0 + fq * 8 - q) + jj];
                                xv[0] = r0 * SC2 + (f32x2){bt[0], bt[1]}; xv[1] = r1 * SC2 + (f32x2){bt[2], bt[3]}; xv[2] = r2 * SC2 + (f32x2){bt[4], bt[5]}; xv[3] = r3 * SC2 + (f32x2){bt[6], bt[7]};
                            }
                            const float mxl = max3f(max3f(xv[0][0], xv[0][1], xv[1][0]), max3f(xv[1][1], xv[2][0], xv[2][1]), max3f(xv[3][0], xv[3][1], xv[3][1]));
                            if (__any(mxl > mrun[qi] + ((KIND == 0) ? 96.0f : 16.0f))) {
                                const float mx = max_x16x32(mxl);
                                const float mnew = fmaxf(mrun[qi], mx);
                                const float mns = (mnew == NINF) ? 0.f : mnew;
                                const float alpha = ex2(mrun[qi] - mns);
                                mrun[qi] = mnew; mref[qi] = mns; Ol[qi] = Ol[qi] * alpha;
#pragma unroll
                                for (int dt = 0; dt < 4; ++dt) O[qi][dt] = O[qi][dt] * alpha;
                            }
                            const float msafe = mref[qi];
#pragma unroll
                            for (int i = 0; i < 4; ++i) { const f32x2 d = xv[i] - msafe; p[2 * i] = ex2(d[0]); p[2 * i + 1] = ex2(d[1]); }
                        }
                        u32x4 pw; pw.x = pk2(p[0], p[1]); pw.y = pk2(p[2], p[3]); pw.z = pk2(p[4], p[5]); pw.w = pk2(p[6], p[7]);
                        if (KIND == 1) { pw.x &= pmask[0]; pw.y &= pmask[1]; pw.z &= pmask[2]; pw.w &= pmask[3]; }
                        pb = __builtin_bit_cast(bf16x8, pw);
                        Ol[qi] = __builtin_amdgcn_mfma_f32_16x16x32_bf16(ones8, pb, Ol[qi], 0, 0, 0);
                    }
#pragma unroll
                    for (int dt = 0; dt < 4; ++dt) O[qi][dt] = __builtin_amdgcn_mfma_f32_16x16x32_bf16(vf[dt], pb, O[qi][dt], 0, 0, 0);
                }
                if (KIND == 2) { const bool dn = (mrun[0] < -151.f) && (mrun[1] < -151.f); if (__all(dn)) wdone = true; }
            }
        }
        if (!has_next) break;
        if (KIND == 2) { if (lane == 0) flags[cur * 8 + wv] = wdone ? 1u : 0u; }
        *(LAS u32x4*)(kst + (cur ^ 1) * 8192) = kreg; *(LAS u32x4*)(vst + (cur ^ 1) * 8192) = vreg;
        if (s + s_dir != s_last) { kreg = *(const u32x4*)(Kb + (size_t)((s + 2 * s_dir) * 64) * KPB + kgoff); vreg = *(const u32x4*)(Vtb + (size_t)((s + 2 * s_dir) * 128) + vgoff); }
        __syncthreads();
        if (KIND == 2) {
            const unsigned f = flags[cur * 8 + (lane & 7)];
            if (__all(f != 0u)) break;
        }
        s += s_dir; cur ^= 1;
    }
    if (hn && !fetched) attn_fetch<(KIND + 1) & 3>(ws, nb, nh, nblk, tid, pre);
    if (hn) { u32x4 q0 = __builtin_bit_cast(u32x4, pre.qf[0][0]), q1 = __builtin_bit_cast(u32x4, pre.qf[0][1]), q2 = __builtin_bit_cast(u32x4, pre.qf[1][0]), q3 = __builtin_bit_cast(u32x4, pre.qf[1][1]);
        asm volatile("" : "+v"(q0), "+v"(q1), "+v"(q2), "+v"(q3), "+v"(pre.k0), "+v"(pre.v0), "+v"(pre.k1), "+v"(pre.v1));
        pre.qf[0][0] = __builtin_bit_cast(bf16x8, q0); pre.qf[0][1] = __builtin_bit_cast(bf16x8, q1); pre.qf[1][0] = __builtin_bit_cast(bf16x8, q2); pre.qf[1][1] = __builtin_bit_cast(bf16x8, q3); }
    unsigned char* Y = (unsigned char*)(ws + WS_Y);
#pragma unroll
    for (int qi = 0; qi < 2; ++qi) {
        float inv = 1.0f;
        if (KIND != 2) inv = __builtin_amdgcn_rcpf(Ol[qi][0]);
        const int q = (KIND == 1) ? (qw + fr) : (qw + 16 * qi + fr);
        const int hh = (KIND == 1) ? hw + qi : h;
        inv *= 8.0f;
        const float hib = pg8::fp8_bound();
        unsigned w[4];
#pragma unroll
        for (int dt = 0; dt < 4; ++dt) { const f32x4 o = O[qi][dt] * inv; w[dt] = (unsigned)pg8::fp8x4c(o[0], o[1], o[2], o[3], hib); }
        asm volatile("s_nop 1\n\tv_permlane16_swap_b32 %0, %1\n\tv_permlane16_swap_b32 %2, %3\n\ts_nop 1\n\tv_permlane32_swap_b32 %0, %2\n\tv_permlane32_swap_b32 %1, %3"
                     : "+v"(w[0]), "+v"(w[1]), "+v"(w[2]), "+v"(w[3]));
        *(u32x4*)(Y + (rowb + q) * DM + YCOL + hh * 64 + fq * 16) = (u32x4){w[0], w[1], w[2], w[3]};
    }
}

__device__ __forceinline__ void attn_phase(KP Pq, Frame& F, int l) {
    F.tid = opaque_tid(F.wave0); F.lane = F.tid & 63; F.wave = opq_s(F.wave0); F.vcu = opq_s(F.vcu0); F.G = opq_s(F.G0); const KP P = kp_fresh(); (void)Pq;
    LAS float* relt = (LAS float*)(F.lds + ATT_RELT);
    unsigned char* ws = P->ws;
    __syncthreads();
    for (int i = F.tid; i < 4 * RELW; i += 512) { const int hh = i / RELW; int rel = i % RELW - RELO; rel = rel < -128 ? -128 : (rel > 128 ? 128 : rel); relt[i] = P->rel_bias[(l * 4 + hh) * 257 + rel + 128] * LOG2E; }
    __syncthreads();
    for (int vu = F.vcu; vu < 256; vu += F.G) {
        {
            LAS float* nf = (LAS float*)(F.lds + ATT_NF); LAS float* wsum = (LAS float*)(F.lds + ATT_FLAG + 256);
            __syncthreads();
            const f32x4 x = *(const f32x4*)((const float*)(ws + WS_LF) + (size_t)(vu >> 1) * SEQ + 4 * F.tid);
            const float s4 = (x[0] + x[1]) + (x[2] + x[3]);
            float incl = row_scan(s4);
            { const float T0 = rdl_f(incl, 15), T1 = rdl_f(incl, 31), T2 = rdl_f(incl, 47), T3 = rdl_f(incl, 63);
              incl += ((F.lane >= 16) ? T0 : 0.f) + ((F.lane >= 32) ? T1 : 0.f) + ((F.lane >= 48) ? T2 : 0.f);
              if (F.lane == 0) wsum[F.wave] = ((T0 + T1) + (T2 + T3)); }
            __syncthreads();
            float off = 0.f;
            for (int w2 = 0; w2 < F.wave; ++w2) off += wsum[w2];
            float pref = off + (incl - s4); f32x4 o;
            pref += x[0]; o[0] = -pref * LOG2E; pref += x[1]; o[1] = -pref * LOG2E; pref += x[2]; o[2] = -pref * LOG2E; pref += x[3]; o[3] = -pref * LOG2E;
            *(LAS f32x4*)(nf + 4 * F.tid) = o;
            __syncthreads();
        }
        auto unit_of = [&](int s2, int& kb, int& kh, int& kblk) { const int kind2 = (s2 + vu) & 3, j2 = s2 >> 2;
            if (kind2 == 1) { const int r = vu & 7; kb = vu >> 3; kh = 0; kblk = (j2 == 0) ? r : (j2 == 1) ? 31 - r : (j2 == 2) ? 15 - r : 16 + r; }
            else { const int bh = vu >> 1, o = vu & 1; kb = bh >> 2; kh = bh & 3; kblk = (j2 == 0) ? o : (j2 == 1) ? 7 - o : (j2 == 2) ? 2 + o : 5 - o; } };
        AttnPre A;
        { int b0, h0, k0; unit_of(0, b0, h0, k0); const int kind0 = vu & 3, tid0 = opaque_tid(F.wave0);
          if (kind0 == 0) attn_fetch<0>(ws, b0, h0, k0, tid0, A); else if (kind0 == 1) attn_fetch<1>(ws, b0, h0, k0, tid0, A); else if (kind0 == 2) attn_fetch<2>(ws, b0, h0, k0, tid0, A); else attn_fetch<3>(ws, b0, h0, k0, tid0, A); }
        for (int s = 0; s < 16; ++s) {
            const int kind = (s + vu) & 3;
            int b, h, blk, nb = 0, nh = 0, nblk = 0; unit_of(s, b, h, blk);
            const bool hn = s < 15; if (hn) unit_of(s + 1, nb, nh, nblk);
            if (kind == 0) attn_wg<0>(ws, b, h, blk, F.lds, F.wave0, A, hn, nb, nh, nblk);
            else if (kind == 1) attn_wg<1>(ws, b, h, blk, F.lds, F.wave0, A, hn, nb, nh, nblk);
            else if (kind == 2) attn_wg<2>(ws, b, h, blk, F.lds, F.wave0, A, hn, nb, nh, nblk);
            else attn_wg<3>(ws, b, h, blk, F.lds, F.wave0, A, hn, nb, nh, nblk);
        }
    }
    __syncthreads();
}

__device__ __forceinline__ void norm2_router_phase(KP Pq, Frame& F, int l) {
    F.tid = opaque_tid(F.wave0); F.lane = F.tid & 63; F.wave = opq_s(F.wave0); F.vcu = opq_s(F.vcu0); F.G = opq_s(F.G0); const KP P = kp_fresh(); (void)Pq;
    unsigned char* ws = P->ws;
    const bf16* X = (const bf16*)(ws + WS_X);
    const float* mod = (const float*)(ws + WS_MOD);
    unsigned char* H8 = (unsigned char*)(ws + WS_H8);
    const bf16* WH = (const bf16*)(ws + WS_WRT) + (size_t)l * 32 * 1024; const bf16* WL = WH + NL * 32 * 1024;
    int* TOKE = (int*)(ws + WS_TOKE); float* TOKG = (float*)(ws + WS_TOKG); int* COUNTS = (int*)(ws + WS_COUNTS);
    LAS float* lg = (LAS float*)(F.lds) + F.wave * (32 * 33);
    LAS unsigned* cnt = (LAS unsigned*)(F.lds + 40960);
    LAS float* GS = (LAS float*)(F.lds + 49152);
    LAS float* SH = GS + 1024;
    const int lane = F.lane, fr = lane & 15, fq = lane >> 4;
    const float* gn = P->norm2_g + l * DM;
    for (int tb = F.vcu; tb < NTB / 2; tb += F.G) {
        const int bb = (tb * 256) >> 11;
        __syncthreads();
        if (F.tid < 64) cnt[F.tid] = 0u;
        { const float* mb = mod + ((size_t)(l * 32 + bb)) * 6144 + 3 * 1024;
          for (int i = F.tid; i < 1024; i += 512) { GS[i] = gn[i] * (1.0f + mb[1024 + i]); SH[i] = mb[i]; } }
        __syncthreads();
        const int tok0 = tb * 256 + F.wave * 32;
        const bf16* xr0 = X + (size_t)(tok0 + fr) * DM + fq * 8; const bf16* xr1 = xr0 + 16 * DM;
        float ss0 = 0.f, ss1 = 0.f;
#pragma unroll 8
        for (int ks = 0; ks < 32; ++ks) { const u32x4 a = *(const u32x4*)(xr0 + ks * 32), c = *(const u32x4*)(xr1 + ks * 32);
            ss0 = dot2bf(a.x, ss0); ss0 = dot2bf(a.y, ss0); ss0 = dot2bf(a.z, ss0); ss0 = dot2bf(a.w, ss0);
            ss1 = dot2bf(c.x, ss1); ss1 = dot2bf(c.y, ss1); ss1 = dot2bf(c.z, ss1); ss1 = dot2bf(c.w, ss1); }
        const float rstd0 = __builtin_amdgcn_rsqf(sum_x16x32(ss0) * (1.0f / DM) + 1e-6f), rstd1 = __builtin_amdgcn_rsqf(sum_x16x32(ss1) * (1.0f / DM) + 1e-6f);
        f32x4 acc[2][2] = {{zero4(), zero4()}, {zero4(), zero4()}};
        unsigned char* h8w = H8 + (size_t)(tok0 + (fq & 1) * 16 + fr) * DM + (fq & ~1) * 8;
        const float hib = pg8::fp8_bound();
        u32x4 cx[2]; bf16x8 ah[2], al[2];
        cx[0] = *(const u32x4*)xr0; cx[1] = *(const u32x4*)xr1;
#pragma unroll
        for (int nt = 0; nt < 2; ++nt) { ah[nt] = *(const bf16x8*)(WH + (size_t)(nt * 16 + fr) * 1024 + fq * 8); al[nt] = *(const bf16x8*)(WL + (size_t)(nt * 16 + fr) * 1024 + fq * 8); }
#pragma unroll 2
        for (int ks = 0; ks < 32; ++ks) {
            const int kn = (ks + 1) & 31;
            u32x4 nx[2]; bf16x8 nah[2], nal[2];
            nx[0] = *(const u32x4*)(xr0 + kn * 32); nx[1] = *(const u32x4*)(xr1 + kn * 32);
#pragma unroll
            for (int nt = 0; nt < 2; ++nt) { nah[nt] = *(const bf16x8*)(WH + (size_t)(nt * 16 + fr) * 1024 + kn * 32 + fq * 8); nal[nt] = *(const bf16x8*)(WL + (size_t)(nt * 16 + fr) * 1024 + kn * 32 + fq * 8); }
            const f32x4 g0 = *(const LAS f32x4*)(GS + ks * 32 + fq * 8), g1 = *(const LAS f32x4*)(GS + ks * 32 + fq * 8 + 4), s0 = *(const LAS f32x4*)(SH + ks * 32 + fq * 8), s1 = *(const LAS f32x4*)(SH + ks * 32 + fq * 8 + 4);
            u32x2 f8p[2];
#pragma unroll
            for (int tt = 0; tt < 2; ++tt) {
                float xv[8]; bf8_to_f(cx[tt], xv);
                const float rs = tt ? rstd1 : rstd0;
                float hv[8];
#pragma unroll
                for (int i = 0; i < 8; ++i) hv[i] = (xv[i] * rs) * (i < 4 ? g0[i] : g1[i - 4]) + (i < 4 ? s0[i] : s1[i - 4]);
                u32x4 hi, lo;
                hi.x = pk2(hv[0], hv[1]); hi.y = pk2(hv[2], hv[3]); hi.z = pk2(hv[4], hv[5]); hi.w = pk2(hv[6], hv[7]);
                lo.x = pk2(hv[0] - bf2f(hi.x & 0xffffu), hv[1] - bf2f(hi.x >> 16)); lo.y = pk2(hv[2] - bf2f(hi.y & 0xffffu), hv[3] - bf2f(hi.y >> 16));
                lo.z = pk2(hv[4] - bf2f(hi.z & 0xffffu), hv[5] - bf2f(hi.z >> 16)); lo.w = pk2(hv[6] - bf2f(hi.w & 0xffffu), hv[7] - bf2f(hi.w >> 16));
                f8p[tt].x = (unsigned)pg8::fp8x4c(hv[0], hv[1], hv[2], hv[3], hib); f8p[tt].y = (unsigned)pg8::fp8x4c(hv[4], hv[5], hv[6], hv[7], hib);
                const bf16x8 bh = __builtin_bit_cast(bf16x8, hi), bl = __builtin_bit_cast(bf16x8, lo);
#pragma unroll
                for (int nt = 0; nt < 2; ++nt) {
                    acc[tt][nt] = __builtin_amdgcn_mfma_f32_16x16x32_bf16(ah[nt], bh, acc[tt][nt], 0, 0, 0);
                    acc[tt][nt] = __builtin_amdgcn_mfma_f32_16x16x32_bf16(al[nt], bh, acc[tt][nt], 0, 0, 0);
                    acc[tt][nt] = __builtin_amdgcn_mfma_f32_16x16x32_bf16(ah[nt], bl, acc[tt][nt], 0, 0, 0);
                }
            }
            { unsigned ax = f8p[0].x, ay = f8p[0].y, bx = f8p[1].x, by = f8p[1].y; pg8::swap16(ax, bx); pg8::swap16(ay, by);
              *(u32x4*)(h8w + ks * 32) = (u32x4){ax, ay, bx, by}; }
            cx[0] = nx[0]; cx[1] = nx[1]; ah[0] = nah[0]; ah[1] = nah[1]; al[0] = nal[0]; al[1] = nal[1];
        }
#pragma unroll
        for (int tt = 0; tt < 2; ++tt)
#pragma unroll
            for (int nt = 0; nt < 2; ++nt)
#pragma unroll
                for (int j = 0; j < 4; ++j) { const int e = nt * 16 + fq * 4 + j; lg[(tt * 16 + fr) * 33 + e] = acc[tt][nt][j] + P->b_router[l * 32 + e]; }
        LDS_WAIT(); asm volatile("" ::: "memory");
        if (lane < 32) {
            float v0 = -INFINITY, v1 = -INFINITY, v2 = -INFINITY, v3 = -INFINITY; int i0 = 0, i1 = 0, i2 = 0, i3 = 0;
            for (int e = 0; e < 32; ++e) { const float v = lg[lane * 33 + e];
                if (v > v0) { v3 = v2; i3 = i2; v2 = v1; i2 = i1; v1 = v0; i1 = i0; v0 = v; i0 = e; }
                else if (v > v1) { v3 = v2; i3 = i2; v2 = v1; i2 = i1; v1 = v; i1 = e; }
                else if (v > v2) { v3 = v2; i3 = i2; v2 = v; i2 = e; }
                else if (v > v3) { v3 = v; i3 = e; } }
            const float e1 = ex2((v1 - v0) * LOG2E), e2 = ex2((v2 - v0) * LOG2E), e3 = ex2((v3 - v0) * LOG2E); const float inv = __builtin_amdgcn_rcpf(1.0f + e1 + e2 + e3);
            const int tok = tok0 + lane;
            *(int4*)(TOKE + (size_t)tok * 4) = make_int4(i0, i1, i2, i3);
            *(f32x4*)(TOKG + (size_t)tok * 4) = (f32x4){inv, e1 * inv, e2 * inv, e3 * inv};
            LAS unsigned* cb = cnt + (F.wave >> 2) * 32;
            lds_add(cb + i0, 1u); lds_add(cb + i1, 1u); lds_add(cb + i2, 1u); lds_add(cb + i3, 1u);
        }
        LDS_WAIT();
        __syncthreads();
        if (F.tid < 64) COUNTS[(tb * 2 + (F.tid >> 5)) * 32 + (F.tid & 31)] = (int)cnt[F.tid];
    }
}

__device__ __forceinline__ void gather_phase(KP Pq, Frame& F) {
    F.tid = opaque_tid(F.wave0); F.lane = F.tid & 63; F.wave = opq_s(F.wave0); F.vcu = opq_s(F.vcu0); F.G = opq_s(F.G0); const KP P = kp_fresh(); (void)Pq;
    unsigned char* ws = P->ws;
    const unsigned char* H8 = (const unsigned char*)(ws + WS_H8); unsigned char* XS = (unsigned char*)(ws + WS_XS);
    const int* TOKE = (const int*)(ws + WS_TOKE); const float* TOKG = (const float*)(ws + WS_TOKG); const int* COUNTS = (const int*)(ws + WS_COUNTS);
    int* ROWDST = (int*)(ws + WS_ROWDST); float* ROWGATE = (float*)(ws + WS_ROWGATE); int* TILEE = (int*)(ws + WS_TILEE);
    LAS int* lp = (LAS int*)(F.lds);
    LAS int* part = lp + 512 * 32;
    LAS int* tot = part + 512;
    LAS int* pst = tot + 32;
    LAS unsigned* cur = (LAS unsigned*)(pst + 40);
    LAS int* posl = (LAS int*)(cur + 32);
    const int tid = F.tid;
    __syncthreads();
    { const int e = tid & 31, seg = tid >> 5; int c[32];
#pragma unroll
      for (int i = 0; i < 32; ++i) c[i] = COUNTS[(seg * 32 + i) * 32 + e];
      int run = 0;
#pragma unroll
      for (int i = 0; i < 32; ++i) { lp[(seg * 32 + i) * 32 + e] = run; run += c[i]; }
      part[seg * 32 + e] = run; }
    __syncthreads();
    if (tid < 32) { int s = 0; for (int g = 0; g < 16; ++g) { const int v = part[g * 32 + tid]; part[g * 32 + tid] = s; s += v; } tot[tid] = s; }
    __syncthreads();
    if (tid == 0) { int p = 0; for (int e = 0; e < 32; ++e) { pst[e] = p; p += (tot[e] + 255) & ~255; } pst[32] = p; }
    __syncthreads();
    if (F.vcu == 0) {
        for (int i = tid; i < MAXRT; i += 512) { int e = 0; for (int k = 1; k < 32; ++k) if (i * 256 >= pst[k]) e = k; TILEE[i] = e; }
        if (tid == 0) TILEE[MAXRT] = pst[32] / 256;
    }
    for (int e = F.vcu; e < 32; e += F.G) {
        for (int p = pst[e] + tot[e] + tid; p < pst[e + 1]; p += 512) { ROWDST[p] = -1; ROWGATE[p] = 0.f; }
    }
    for (int tb = F.vcu; tb < NTB; tb += F.G) {
        __syncthreads();
        if (tid < 32) cur[tid] = 0u;
        __syncthreads();
        { const int tok = tb * 128 + (tid >> 2), k = tid & 3; const int e = TOKE[(size_t)tok * 4 + k];
          const int pos = pst[e] + part[(tb >> 5) * 32 + e] + lp[tb * 32 + e] + (int)lds_add(cur + e, 1u);
          posl[tid] = pos; ROWDST[pos] = tok * 4 + k; ROWGATE[pos] = TOKG[(size_t)tok * 4 + k]; }
        __syncthreads();
    }
    __syncthreads();
}

__global__ void __launch_bounds__(512, 2) mk_fwd(Params Pval) {
    extern __shared__ __attribute__((aligned(16))) unsigned char lds_raw[];
    Frame F;
    F.lds = (LAS unsigned char*)lds_raw;
    F.tid = threadIdx.x; F.lane = F.tid & 63; F.wave = __builtin_amdgcn_readfirstlane(F.tid >> 6); F.wave0 = F.wave;
    F.G0 = gridDim.x; { const int bx = blockIdx.x; F.vcu0 = (F.G0 % 8 == 0) ? (bx % 8) * (F.G0 / 8) + bx / 8 : bx; } F.G = F.G0; F.vcu = F.vcu0;
    volatile LAS unsigned* MISC = (volatile LAS unsigned*)(F.lds + MISC_OFF);
    for (int u = F.tid; u < (LDS_BYTES - LDSCTL_OFF) / 4; u += 512) ((LAS unsigned*)(F.lds + LDSCTL_OFF))[u] = 0u;
    __syncthreads();
    const KP P = kp_fresh(); (void)Pval;
    unsigned char* ws = P->ws;
    XcdBarrier bar = xcd_barrier_post((unsigned*)(ws + WS_CTL) + CW_BAR, MISC + 8); bar.wv = F.wave0;
#define GRID_BAR() xcd_barrier(bar)

#ifndef PH_MASK
#define PH_MASK 0xFFFF
#endif
#define PH(k) ((PH_MASK >> (k)) & 1)
#ifndef DUP_MASK
#define DUP_MASK 0
#endif
#define DUP(k) ((DUP_MASK >> (k)) & 1)
#ifndef SELVAR
#define SELVAR 0
#endif
    if (PH(0)) p0_prologue(P, F);
    GRID_BAR();
    if (DUP(0)) { p0_prologue(P, F); GRID_BAR(); }
    for (int l = 0; l < NL; ++l) {
        if (DUP(1) && l > 0) { norm_phase<2>(P, F, NL); GRID_BAR(); }
        if (PH(1)) { if (l == 0) norm_phase<0>(P, F, 0); else norm_phase<1>(P, F, l); }
        GRID_BAR();
        if (PH(2)) { unsigned char* ws = kp_fresh()->ws; pg8::SchedDense8 S; S.o.init(T / 256, NP / 256, opq_s(F.G0), opq_s((int)blockIdx.x)); S.A = (const char*)(ws + WS_H); S.B = (const char*)(ws + WS_WIN) + (size_t)l * NP * 1024;
          pg8::EpiProj8 E{(bf16*)(ws + WS_PROJ), NP, (bf16*)(ws + WS_VT)};
          pg8::gemm_phase<pg8::EpiProj8, pg8::SchedDense8, true>(F.lds, S, E, F.wave0); }
        GRID_BAR();
        if (DUP(3)) { prep_phase<true>(P, F, l); GRID_BAR(); }
        if (PH(3)) prep_phase<false>(P, F, l);
        GRID_BAR();
        if (DUP(4)) { sel_phase<SELVAR>(P, F); GRID_BAR(); }
        if (PH(4)) sel_phase<0>(P, F);
        GRID_BAR();
        if (PH(5)) attn_phase(P, F, l);
        if (DUP(5)) { GRID_BAR(); attn_phase(P, F, l); }
        GRID_BAR();
        if (PH(6)) { unsigned char* ws = kp_fresh()->ws; const float* mod = (const float*)(ws + WS_MOD); pg8::SchedDense8 S; S.o.init(T / 256, DM / 256, opq_s(F.G0), opq_s((int)blockIdx.x)); S.A = (const char*)(ws + WS_Y); S.B = (const char*)(ws + WS_WO) + (size_t)l * 1024 * 1024;
          pg8::EpiResid8 E{l == 0 ? kp_fresh()->x : (const float*)nullptr, (bf16*)(ws + WS_X), mod + (size_t)l * 32 * 6144 + 2 * 1024};
          pg8::gemm_phase<pg8::EpiResid8, pg8::SchedDense8, true>(F.lds, S, E, F.wave0); }
        GRID_BAR();
        if (PH(7)) norm2_router_phase(P, F, l);
        GRID_BAR();
        if (DUP(7)) { norm2_router_phase(P, F, l); GRID_BAR(); }
        if (PH(9)) gather_phase(P, F);
        if (DUP(9)) { GRID_BAR(); gather_phase(P, F); }
        GRID_BAR();
        for (int rep = 0; rep < 1 + DUP(10); ++rep) {
        if (PH(10)) { unsigned char* ws = kp_fresh()->ws; const int* tile_e = (const int*)(ws + WS_TILEE); const int nrt = __builtin_amdgcn_readfirstlane(tile_e[MAXRT]);
          pg8::SchedMoeG S; S.o.init(nrt, 8, opq_s(F.G0), opq_s((int)blockIdx.x)); S.A = (const char*)(ws + WS_H8); S.B = (const char*)(ws + WS_WGU) + (size_t)l * NE * 2048 * 1024; S.tile_e = tile_e; S.estride = (size_t)2048 * 1024; S.rowdst = (const int*)(ws + WS_ROWDST);
          pg8::EpiSwiglu E{(unsigned char*)(ws + WS_ACT), kp_fresh()->b_gu + (size_t)l * NE * 2048};
          pg8::gemm_phase<pg8::EpiSwiglu, pg8::SchedMoeG, true>(F.lds, S, E, F.wave0); }
        GRID_BAR();
        if (PH(11)) { unsigned char* ws = kp_fresh()->ws; const int* tile_e = (const int*)(ws + WS_TILEE); const int nrt = __builtin_amdgcn_readfirstlane(tile_e[MAXRT]);
          pg8::SchedMoe S; S.o.init(nrt, 4, opq_s(F.G0), opq_s((int)blockIdx.x)); S.A = (const char*)(ws + WS_ACT); S.B = (const char*)(ws + WS_WDN) + (size_t)l * NE * 1024 * 1024; S.tile_e = tile_e; S.estride = (size_t)1024 * 1024;
          pg8::EpiDown E{(unsigned char*)(ws + WS_SLOT), kp_fresh()->b_dn + (size_t)l * NE * 1024, (const int*)(ws + WS_ROWDST), (const float*)(ws + WS_ROWGATE)};
          pg8::gemm_phase<pg8::EpiDown, pg8::SchedMoe, true>(F.lds, S, E, F.wave0); }
        GRID_BAR();
        }
    }
    if (PH(12)) norm_phase<2>(P, F, NL);
}

extern "C" void kernel_launch(void* const* d_in, const int* in_sizes, int n_in, void* d_out, int out_size, void* d_ws, size_t ws_size, hipStream_t stream) {
    static int grid = 0;
    if (grid == 0) {
        if (n_in != 20 || in_sizes[0] != T * DM || out_size != T * DM || ws_size < WS_END) { fprintf(stderr, "kernel_launch: unexpected shapes / workspace (%d inputs, ws %zu)\n", n_in, ws_size); grid = -1; return; }
        int dev = 0, cus = 0, per_cu = 0;
        if (hipGetDevice(&dev) != hipSuccess || hipDeviceGetAttribute(&cus, hipDeviceAttributeMultiprocessorCount, dev) != hipSuccess) { grid = -1; return; }
        if (hipFuncSetAttribute((const void*)mk_fwd, hipFuncAttributeMaxDynamicSharedMemorySize, LDS_BYTES) != hipSuccess) { fprintf(stderr, "kernel_launch: hipFuncSetAttribute failed\n"); grid = -1; return; }
        if (hipOccupancyMaxActiveBlocksPerMultiprocessor(&per_cu, (const void*)mk_fwd, 512, LDS_BYTES) != hipSuccess || per_cu < 1) { fprintf(stderr, "kernel_launch: occupancy query says %d\n", per_cu); }
        (void)hipGetLastError();
        grid = cus;
    }
    if (grid < 0) return;
    if (hipMemsetAsync((char*)d_ws + WS_CTL, 0, CTL_ZERO_BYTES, stream) != hipSuccess) return;
    Params p{};
    const float** pp = (const float**)&p;
    for (int i = 0; i < 20; ++i) pp[i] = (const float*)d_in[i];
    p.out = (float*)d_out; p.ws = (unsigned char*)d_ws;
    hipLaunchKernelGGL(mk_fwd, dim3(grid), dim3(512), LDS_BYTES, stream, p);
    const hipError_t le = hipPeekAtLastError();
    if (le != hipSuccess) fprintf(stderr, "kernel_launch: launch failed: %s\n", hipGetErrorName(le));
}
```
